# Optimizing an MI355X kernel written in HIP

```python
import numpy as np
import jax, jax.numpy as jnp
from jax import lax

D_MODEL = 1024
BATCH = 8
SEQ = 4096
DEPTH = 2

N_MIXERS = 2
N_HEADS = 16
HEAD_DIM = D_MODEL // N_HEADS
Q_BLOCK = 128
NSA_KV_GROUPS = 2
NSA_HPG = N_HEADS // NSA_KV_GROUPS
NSA_KV_W = NSA_KV_GROUPS * HEAD_DIM
CMP_LEN = 32
CMP_STRIDE = 16
CMP_HIDDEN = 2 * HEAD_DIM
SLC_LEN = 64
SLC_TOP_N = 16
WINDOW = 512
NSA_IN_W = D_MODEL + 6 * NSA_KV_W + 3 * N_HEADS
ROPE_THETA = 10000.0
D_FF = 2816
CONV_W = 3
RMS_EPS = 1e-6
NEG = -1e30
FORCE_BONUS = 1e4

kernel_name = "hybrid_stickbreak_nsa_convffn"


def rmsnorm(x, g):
    xf = x.astype(jnp.float32)
    y = xf * lax.rsqrt(jnp.mean(xf * xf, axis=-1, keepdims=True) + RMS_EPS)
    return (y * g.astype(jnp.float32)).astype(x.dtype)


def rope(x, pos):
    half = HEAD_DIM // 2
    inv = ROPE_THETA ** (-jnp.arange(half, dtype=jnp.float32) / half)
    ang = pos.astype(jnp.float32)[..., None] * inv
    cos = jnp.cos(ang)[:, :, None, :]
    sin = jnp.sin(ang)[:, :, None, :]
    xf = x.astype(jnp.float32)
    x1, x2 = xf[..., :half], xf[..., half:]
    return jnp.concatenate([x1 * cos - x2 * sin, x2 * cos + x1 * sin], axis=-1).astype(x.dtype)


def stick_breaking_attention(h, w_in, w_out):
    B, S, _ = h.shape
    nb = S // Q_BLOCK
    scale = HEAD_DIM ** -0.5
    q, k, v = jnp.split(h @ w_in, 3, axis=-1)
    q, k, v = [t.reshape(B, S, N_HEADS, HEAD_DIM).transpose(0, 2, 1, 3) for t in (q, k, v)]
    q_blocks = q.reshape(B, N_HEADS, nb, Q_BLOCK, HEAD_DIM).transpose(2, 0, 1, 3, 4)
    key_pos = jnp.arange(S)

    def block(args):
        qb, q0 = args
        z = jnp.einsum('bhqd,bhkd->bhqk', qb, k).astype(jnp.float32) * scale
        qpos = q0 + jnp.arange(Q_BLOCK)
        strict = key_pos[None, :] < qpos[:, None]
        log_beta = jax.nn.log_sigmoid(z)
        log_1m = jnp.where(strict, jax.nn.log_sigmoid(-z), 0.0)
        after = lax.cumsum(log_1m, axis=3, reverse=True) - log_1m
        a = jnp.where(strict, jnp.exp(log_beta + after), 0.0)
        return jnp.einsum('bhqk,bhkd->bhqd', a.astype(v.dtype), v)

    o = lax.map(block, (q_blocks, jnp.arange(nb, dtype=jnp.int32) * Q_BLOCK))
    o = o.transpose(1, 0, 3, 2, 4).reshape(B, S, D_MODEL)
    return o @ w_out


def native_sparse_attention(h, pos, w_in, cmp_pos_k, cmp_pos_v, cmp_k_w1, cmp_k_w2,
                            cmp_v_w1, cmp_v_w2, w_out):
    B, S, _ = h.shape
    G, HG, dh = NSA_KV_GROUPS, NSA_HPG, HEAD_DIM
    nb = S // Q_BLOCK
    n_cmp = (S - CMP_LEN) // CMP_STRIDE + 1
    n_slc = S // SLC_LEN
    top_n = min(SLC_TOP_N, n_slc)
    scale = dh ** -0.5

    splits = np.cumsum([D_MODEL] + [NSA_KV_W] * 6).tolist()
    q, kc, vc, ks, vs, kw, vw, gates = jnp.split(h @ w_in, splits, axis=-1)
    q = rope(q.reshape(B, S, N_HEADS, dh), pos)
    kvh = lambda t: t.reshape(B, S, G, dh)
    ks = rope(kvh(ks), pos)
    kw = rope(kvh(kw), pos)
    vs, vw = kvh(vs), kvh(vw)

    idx = np.arange(n_cmp)[:, None] * CMP_STRIDE + np.arange(CMP_LEN)[None, :]
    cmp_end = idx[:, -1]

    def compress(t, pe, w1, w2):
        blk = kvh(t)[:, idx] + pe[None, None, :, None, :]
        blk = blk.transpose(0, 1, 3, 2, 4).reshape(B, n_cmp, G, CMP_LEN * dh)
        return jax.nn.gelu(blk @ w1) @ w2

    kc = rope(compress(kc, cmp_pos_k, cmp_k_w1, cmp_k_w2), pos[:, cmp_end]).transpose(0, 2, 1, 3)
    vc = compress(vc, cmp_pos_v, cmp_v_w1, cmp_v_w2).transpose(0, 2, 1, 3)
    cmp_end_j = jnp.asarray(cmp_end)

    c0 = np.arange(n_cmp)[:, None] * CMP_STRIDE
    s0 = np.arange(n_slc)[None, :] * SLC_LEN
    overlap = np.clip(np.minimum(c0 + CMP_LEN, s0 + SLC_LEN) - np.maximum(c0, s0), 0, None) / CMP_LEN
    overlap = jnp.asarray(overlap, jnp.float32)

    ks_blocks = ks.transpose(0, 2, 1, 3).reshape(B, G, n_slc, SLC_LEN, dh)
    vs_blocks = vs.transpose(0, 2, 1, 3).reshape(B, G, n_slc, SLC_LEN, dh)
    pad = ((0, 0), (0, 0), (WINDOW, 0), (0, 0))
    kw_pad = jnp.pad(kw.transpose(0, 2, 1, 3), pad)
    vw_pad = jnp.pad(vw.transpose(0, 2, 1, 3), pad)

    q_blocks = q.reshape(B, nb, Q_BLOCK, G, HG, dh).transpose(1, 0, 3, 4, 2, 5)
    g_all = jax.nn.sigmoid(gates.astype(jnp.float32)).reshape(B, nb, Q_BLOCK, G, HG, 3)
    g_blocks = g_all.transpose(1, 0, 3, 4, 2, 5)
    bi = jnp.arange(B)[:, None, None, None]
    gi = jnp.arange(G)[None, :, None, None]
    blk_ids = jnp.arange(n_slc)

    def block(args):
        qb, gb, q0 = args
        qpos = q0 + jnp.arange(Q_BLOCK)
        s_c = jnp.einsum('bghqd,bgcd->bghqc', qb, kc).astype(jnp.float32) * scale
        m_c = cmp_end_j[None, :] <= qpos[:, None]
        p_c = jax.nn.softmax(jnp.where(m_c, s_c, NEG), axis=-1) * m_c
        o_c = jnp.einsum('bghqc,bgcd->bghqd', p_c.astype(vc.dtype), vc)
        imp = jnp.einsum('bghqc,cn->bgqn', p_c, overlap)
        cur = qpos // SLC_LEN
        forced = (blk_ids[None] == 0) | (blk_ids[None] == cur[:, None]) | (blk_ids[None] == cur[:, None] - 1)
        causal_blk = blk_ids[None] * SLC_LEN <= qpos[:, None]
        score = jnp.where(causal_blk, imp + FORCE_BONUS * forced, NEG)
        _, sel = lax.top_k(score, top_n)
        k_sel = ks_blocks[bi, gi, sel]
        v_sel = vs_blocks[bi, gi, sel]
        tok = sel[..., None] * SLC_LEN + jnp.arange(SLC_LEN)
        m_s = tok <= qpos[None, None, :, None, None]
        s_s = jnp.einsum('bghqd,bgqnld->bghqnl', qb, k_sel).astype(jnp.float32) * scale
        p_s = jax.nn.softmax(jnp.where(m_s[:, :, None], s_s, NEG), axis=(-2, -1))
        o_s = jnp.einsum('bghqnl,bgqnld->bghqd', p_s.astype(v_sel.dtype), v_sel)
        k_win = lax.dynamic_slice_in_dim(kw_pad, q0, WINDOW + Q_BLOCK, axis=2)
        v_win = lax.dynamic_slice_in_dim(vw_pad, q0, WINDOW + Q_BLOCK, axis=2)
        kpos = q0 - WINDOW + jnp.arange(WINDOW + Q_BLOCK)
        diff = qpos[:, None] - kpos[None, :]
        m_w = (diff >= 0) & (diff < WINDOW) & (kpos[None, :] >= 0)
        s_w = jnp.einsum('bghqd,bgkd->bghqk', qb, k_win).astype(jnp.float32) * scale
        p_w = jax.nn.softmax(jnp.where(m_w, s_w, NEG), axis=-1)
        o_w = jnp.einsum('bghqk,bgkd->bghqd', p_w.astype(v_win.dtype), v_win)
        out = gb[..., 0:1] * o_c + gb[..., 1:2] * o_s + gb[..., 2:3] * o_w
        return out.astype(qb.dtype)

    o = lax.map(block, (q_blocks, g_blocks, jnp.arange(nb, dtype=jnp.int32) * Q_BLOCK))
    o = o.transpose(1, 0, 4, 2, 3, 5).reshape(B, S, D_MODEL)
    return o @ w_out


def conv_ffn(h, w_up, conv_w, conv_b, w_down):
    S = h.shape[1]
    u = h @ w_up
    up = jnp.pad(u, ((0, 0), (CONV_W - 1, 0), (0, 0)))
    c = conv_b
    for j in range(CONV_W):
        c = c + up[:, j:j + S] * conv_w[j]
    gate, val = jnp.split(c, 2, axis=-1)
    return (jax.nn.silu(gate) * val) @ w_down


def setup_inputs(seed: int = 0) -> dict:
    key = jax.random.key(seed)
    ks = jax.random.split(key, 24)
    n_sba = len(range(0, DEPTH, N_MIXERS))
    n_nsa = len(range(1, DEPTH, N_MIXERS))
    f32 = jnp.float32
    nrm = lambda k, shape, fan_in: jax.random.normal(k, shape, f32) * fan_in ** -0.5
    gain = lambda k, shape: 1.0 + 0.05 * jax.random.normal(k, shape, f32)
    x = jax.random.normal(ks[0], (BATCH, SEQ, D_MODEL), f32)
    offs = jax.random.randint(ks[1], (BATCH, 1), 0, 1024, dtype=jnp.int32)
    positions = (jnp.arange(SEQ, dtype=jnp.int32)[None, :] + offs).astype(jnp.int32)
    return {
        "x": x,
        "positions": positions,
        "norm_mix": gain(ks[2], (DEPTH, D_MODEL)),
        "sba_w_in": nrm(ks[3], (n_sba, D_MODEL, 3 * D_MODEL), D_MODEL),
        "sba_w_out": nrm(ks[4], (n_sba, D_MODEL, D_MODEL), D_MODEL),
        "nsa_w_in": nrm(ks[5], (n_nsa, D_MODEL, NSA_IN_W), D_MODEL),
        "nsa_cmp_pos_k": 0.1 * jax.random.normal(ks[6], (n_nsa, CMP_LEN, HEAD_DIM), f32),
        "nsa_cmp_pos_v": 0.1 * jax.random.normal(ks[7], (n_nsa, CMP_LEN, HEAD_DIM), f32),
        "nsa_cmp_k_w1": nrm(ks[8], (n_nsa, CMP_LEN * HEAD_DIM, CMP_HIDDEN), CMP_LEN * HEAD_DIM),
        "nsa_cmp_k_w2": nrm(ks[9], (n_nsa, CMP_HIDDEN, HEAD_DIM), CMP_HIDDEN),
        "nsa_cmp_v_w1": nrm(ks[10], (n_nsa, CMP_LEN * HEAD_DIM, CMP_HIDDEN), CMP_LEN * HEAD_DIM),
        "nsa_cmp_v_w2": nrm(ks[11], (n_nsa, CMP_HIDDEN, HEAD_DIM), CMP_HIDDEN),
        "nsa_w_out": nrm(ks[12], (n_nsa, D_MODEL, D_MODEL), D_MODEL),
        "norm_ffn": gain(ks[13], (DEPTH, D_MODEL)),
        "ffn_w_up": nrm(ks[14], (DEPTH, D_MODEL, 2 * D_FF), D_MODEL),
        "ffn_conv_w": nrm(ks[15], (DEPTH, CONV_W, 2 * D_FF), CONV_W),
        "ffn_conv_b": 0.02 * jax.random.normal(ks[16], (DEPTH, 2 * D_FF), f32),
        "ffn_w_down": nrm(ks[17], (DEPTH, D_FF, D_MODEL), D_FF),
        "norm_final": gain(ks[18], (D_MODEL,)),
    }


def reference(x, positions, norm_mix, sba_w_in, sba_w_out, nsa_w_in, nsa_cmp_pos_k,
              nsa_cmp_pos_v, nsa_cmp_k_w1, nsa_cmp_k_w2, nsa_cmp_v_w1, nsa_cmp_v_w2,
              nsa_w_out, norm_ffn, ffn_w_up, ffn_conv_w, ffn_conv_b, ffn_w_down, norm_final):
    for i in range(DEPTH):
        hn = rmsnorm(x, norm_mix[i])
        j = i // N_MIXERS
        if i % N_MIXERS == 0:
            mix = stick_breaking_attention(hn, sba_w_in[j], sba_w_out[j])
        else:
            mix = native_sparse_attention(hn, positions, nsa_w_in[j], nsa_cmp_pos_k[j],
                                          nsa_cmp_pos_v[j], nsa_cmp_k_w1[j], nsa_cmp_k_w2[j],
                                          nsa_cmp_v_w1[j], nsa_cmp_v_w2[j], nsa_w_out[j])
        x = x + mix
        x = x + conv_ffn(rmsnorm(x, norm_ffn[i]), ffn_w_up[i], ffn_conv_w[i],
                         ffn_conv_b[i], ffn_w_down[i])
    return rmsnorm(x, norm_final)
```

```cpp
#include <hip/hip_runtime.h>
#include <hip/hip_cooperative_groups.h>
#include <stdint.h>
#include <string.h>
#include <stdio.h>
namespace cg = cooperative_groups;

#ifndef ONE_LAUNCH
#define ONE_LAUNCH 0
#endif

typedef unsigned short u16;
typedef __attribute__((ext_vector_type(8))) short bf16x8;
typedef __attribute__((ext_vector_type(4))) float f32x4;

constexpr int SEQ = 4096, DM = 1024, NTOK = 8 * 4096, DFF = 2816, NUP = 5632;
constexpr int NSAWP = 1920;
constexpr int HALF_TOK = NTOK / 2;
constexpr int LDSP = 72;
constexpr int NPHASE = 25;
constexpr int SMEM_BYTES = 2 * 2 * 128 * LDSP * 2;


struct Params {
  const float* x; const int* pos; const float* norm_mix; const float* sba_w_in; const float* sba_w_out;
  const float* nsa_w_in; const float* pe_k; const float* pe_v; const float* ck_w1; const float* ck_w2;
  const float* cv_w1; const float* cv_w2; const float* nsa_w_out; const float* norm_ffn; const float* w_up;
  const float* conv_w; const float* conv_b; const float* w_down; const float* norm_final;
  float* out;
  u16 *wt_sba_in, *wt_sba_out, *wt_nsa_in, *wt_nsa_out, *wt_up0, *wt_up1, *wt_down0, *wt_down1, *wt_ck1, *wt_cv1, *wt_ck2, *wt_cv2;
  float *bias1k, *bias1v; float2* rope;
  u16* hn;
  u16 *qb, *kb, *vT;
  u16 *qn, *cbuf, *ksb, *kwb, *vsT, *vwT, *kc, *vcT; float* gbuf; unsigned long long* msk; u16* ocp;
  u16* u;
  u16* ob;
  u16* act;
  int phase_lo, phase_hi;
  int pad_;
};

__device__ __forceinline__ u16 f2bf(float f) {
  uint32_t u = __float_as_uint(f);
  u += 0x7fffu + ((u >> 16) & 1u);
  return (u16)(u >> 16);
}
__device__ __forceinline__ uint32_t pack2(float a, float b) { return (uint32_t)f2bf(a) | ((uint32_t)f2bf(b) << 16); }
__device__ __forceinline__ float bf2f(u16 h) { return __uint_as_float(((uint32_t)h) << 16); }
__device__ __forceinline__ uint2 pack4(f32x4 v) { return make_uint2(pack2(v[0], v[1]), pack2(v[2], v[3])); }
__device__ __forceinline__ f32x4 mfma16(bf16x8 a, bf16x8 b, f32x4 c) {
  return __builtin_amdgcn_mfma_f32_16x16x32_bf16(a, b, c, 0, 0, 0);
}
__device__ __forceinline__ bf16x8 mk_frag(uint32_t a, uint32_t b, uint32_t c, uint32_t d) {
  union { uint4 u; bf16x8 v; } t; t.u = make_uint4(a, b, c, d); return t.v;
}

constexpr size_t al256(size_t x) { return (x + 255) & ~(size_t)255; }
constexpr size_t MB = 1024 * 1024;
constexpr size_t O_WT_SBA_IN = 0;
constexpr size_t O_WT_SBA_OUT = O_WT_SBA_IN + al256((size_t)3072 * 1024 * 2);
constexpr size_t O_WT_NSA_IN = O_WT_SBA_OUT + al256((size_t)1024 * 1024 * 2);
constexpr size_t O_WT_NSA_OUT = O_WT_NSA_IN + al256((size_t)NSAWP * 1024 * 2);
constexpr size_t O_WT_UP0 = O_WT_NSA_OUT + al256((size_t)1024 * 1024 * 2);
constexpr size_t O_WT_UP1 = O_WT_UP0 + al256((size_t)NUP * 1024 * 2);
constexpr size_t O_WT_DOWN0 = O_WT_UP1 + al256((size_t)NUP * 1024 * 2);
constexpr size_t O_WT_DOWN1 = O_WT_DOWN0 + al256((size_t)1024 * DFF * 2);
constexpr size_t O_WT_CK1 = O_WT_DOWN1 + al256((size_t)1024 * DFF * 2);
constexpr size_t O_WT_CV1 = O_WT_CK1 + al256((size_t)128 * 2048 * 2);
constexpr size_t O_WT_CK2 = O_WT_CV1 + al256((size_t)128 * 2048 * 2);
constexpr size_t O_WT_CV2 = O_WT_CK2 + al256((size_t)64 * 128 * 2);
constexpr size_t O_BIAS1K = O_WT_CV2 + al256((size_t)64 * 128 * 2);
constexpr size_t O_BIAS1V = O_BIAS1K + 512;
constexpr size_t O_ROPE = O_BIAS1V + 512;
constexpr size_t O_HN = O_ROPE + al256((size_t)NTOK * 32 * 8);
constexpr size_t O_BIG = O_HN + al256((size_t)NTOK * DM * 2);
constexpr size_t O_R2 = O_BIG + 192 * MB;
constexpr size_t WS_NEEDED = O_R2 + al256((size_t)HALF_TOK * DFF * 2);
constexpr size_t O_QN = O_BIG;
constexpr size_t O_CBUF = O_QN + al256((size_t)NTOK * DM * 2);
constexpr size_t O_KSB = O_CBUF + al256((size_t)NTOK * 256 * 2);
constexpr size_t O_KWB = O_KSB + al256((size_t)NTOK * 128 * 2);
constexpr size_t O_VST = O_KWB + al256((size_t)NTOK * 128 * 2);
constexpr size_t O_VWT = O_VST + al256((size_t)16 * 64 * SEQ * 2);
constexpr size_t O_KC = O_VWT + al256((size_t)16 * 64 * SEQ * 2);
constexpr size_t O_VCT = O_KC + al256((size_t)16 * 256 * 64 * 2);
constexpr size_t O_GBUF = O_VCT + al256((size_t)16 * 64 * 256 * 2);
constexpr size_t O_MSK = O_GBUF + al256((size_t)NTOK * 48 * 4);
static_assert(O_MSK + (size_t)16 * SEQ * 8 <= O_R2, "NSA buffers overflow BIG");
static_assert((size_t)HALF_TOK * NUP * 2 <= 192 * MB, "u overflow");

struct KArgs {
  const void* in[19];
  float* out;
  char* ws;
  int phase_lo, phase_hi;
};

__device__ __forceinline__ Params make_params(const KArgs& k) {
  Params p;
  p.x = (const float*)k.in[0]; p.pos = (const int*)k.in[1]; p.norm_mix = (const float*)k.in[2];
  p.sba_w_in = (const float*)k.in[3]; p.sba_w_out = (const float*)k.in[4]; p.nsa_w_in = (const float*)k.in[5];
  p.pe_k = (const float*)k.in[6]; p.pe_v = (const float*)k.in[7]; p.ck_w1 = (const float*)k.in[8];
  p.ck_w2 = (const float*)k.in[9]; p.cv_w1 = (const float*)k.in[10]; p.cv_w2 = (const float*)k.in[11];
  p.nsa_w_out = (const float*)k.in[12]; p.norm_ffn = (const float*)k.in[13]; p.w_up = (const float*)k.in[14];
  p.conv_w = (const float*)k.in[15]; p.conv_b = (const float*)k.in[16]; p.w_down = (const float*)k.in[17];
  p.norm_final = (const float*)k.in[18];
  p.out = k.out;
  char* ws = k.ws;
  p.wt_sba_in = (u16*)(ws + O_WT_SBA_IN); p.wt_sba_out = (u16*)(ws + O_WT_SBA_OUT);
  p.wt_nsa_in = (u16*)(ws + O_WT_NSA_IN); p.wt_nsa_out = (u16*)(ws + O_WT_NSA_OUT);
  p.wt_up0 = (u16*)(ws + O_WT_UP0); p.wt_up1 = (u16*)(ws + O_WT_UP1);
  p.wt_down0 = (u16*)(ws + O_WT_DOWN0); p.wt_down1 = (u16*)(ws + O_WT_DOWN1);
  p.wt_ck1 = (u16*)(ws + O_WT_CK1); p.wt_cv1 = (u16*)(ws + O_WT_CV1);
  p.wt_ck2 = (u16*)(ws + O_WT_CK2); p.wt_cv2 = (u16*)(ws + O_WT_CV2);
  p.bias1k = (float*)(ws + O_BIAS1K); p.bias1v = (float*)(ws + O_BIAS1V);
  p.rope = (float2*)(ws + O_ROPE);
  p.hn = (u16*)(ws + O_HN);
  p.qb = (u16*)(ws + O_BIG); p.kb = (u16*)(ws + O_BIG + 64 * MB); p.vT = (u16*)(ws + O_BIG + 128 * MB);
  p.qn = (u16*)(ws + O_QN); p.cbuf = (u16*)(ws + O_CBUF); p.ksb = (u16*)(ws + O_KSB); p.kwb = (u16*)(ws + O_KWB);
  p.vsT = (u16*)(ws + O_VST); p.vwT = (u16*)(ws + O_VWT); p.kc = (u16*)(ws + O_KC); p.vcT = (u16*)(ws + O_VCT);
  p.gbuf = (float*)(ws + O_GBUF); p.msk = (unsigned long long*)(ws + O_MSK);
  p.ocp = p.hn;
  p.u = (u16*)(ws + O_BIG);
  p.ob = (u16*)(ws + O_R2); p.act = (u16*)(ws + O_R2);
  p.phase_lo = k.phase_lo; p.phase_hi = k.phase_hi; p.pad_ = 0;
  return p;
}

__device__ __forceinline__ void transpose_tile(const float* tsrc, u16* tdst, int tK, int tN, int tNpad, int tile, u16* sm) {
  const int nNt = tNpad >> 6;
  const int kt = tile / nNt, nt = tile - kt * nNt;
  const int k0 = kt * 64, n0 = nt * 64;
  const int tid = threadIdx.x;
  const int c4 = tid & 15, r = tid >> 4;
#pragma unroll
  for (int i = 0; i < 4; ++i) {
    int k = r + 16 * i, n = n0 + c4 * 4;
    float4 v = make_float4(0.f, 0.f, 0.f, 0.f);
    if (n < tN) v = *(const float4*)(tsrc + (size_t)(k0 + k) * tN + n);
    sm[(c4 * 4 + 0) * LDSP + k] = f2bf(v.x);
    sm[(c4 * 4 + 1) * LDSP + k] = f2bf(v.y);
    sm[(c4 * 4 + 2) * LDSP + k] = f2bf(v.z);
    sm[(c4 * 4 + 3) * LDSP + k] = f2bf(v.w);
  }
  __syncthreads();
  const int c8 = tid & 7, rn = tid >> 3;
#pragma unroll
  for (int i = 0; i < 2; ++i) {
    int n = rn + 32 * i;
    uint4 v = *(const uint4*)(sm + n * LDSP + c8 * 8);
    *(uint4*)(tdst + (size_t)(n0 + n) * tK + k0 + c8 * 8) = v;
  }
  __syncthreads();
}

__device__ __forceinline__ void rmsnorm_row_bf16(const float* x, const float* g, u16* out, int row, int lane) {
  const float4* xr = (const float4*)(x + (size_t)row * DM);
  float4 v[4]; float ss = 0.f;
#pragma unroll
  for (int i = 0; i < 4; ++i) { v[i] = xr[lane + 64 * i]; ss += v[i].x * v[i].x + v[i].y * v[i].y + v[i].z * v[i].z + v[i].w * v[i].w; }
#pragma unroll
  for (int off = 32; off >= 1; off >>= 1) ss += __shfl_xor(ss, off);
  const float rs = rsqrtf(ss * (1.f / DM) + 1e-6f);
#pragma unroll
  for (int i = 0; i < 4; ++i) {
    float4 gg = ((const float4*)g)[lane + 64 * i];
    uint2 pk = make_uint2(pack2(v[i].x * rs * gg.x, v[i].y * rs * gg.y), pack2(v[i].z * rs * gg.z, v[i].w * rs * gg.w));
    *(uint2*)(out + (size_t)row * DM + (lane + 64 * i) * 4) = pk;
  }
}

__device__ void phase_rmsnorm(const float* x, const float* g, u16* out) {
  const int lane = threadIdx.x & 63, wave = threadIdx.x >> 6;
  for (int it = blockIdx.x; it < NTOK / 4; it += gridDim.x) rmsnorm_row_bf16(x, g, out, it * 4 + wave, lane);
}

__device__ void phase_final_norm(float* x, const float* g) {
  const int lane = threadIdx.x & 63, wave = threadIdx.x >> 6;
  for (int it = blockIdx.x; it < NTOK / 4; it += gridDim.x) {
    int row = it * 4 + wave;
    float4* xr = (float4*)(x + (size_t)row * DM);
    float4 v[4]; float ss = 0.f;
#pragma unroll
    for (int i = 0; i < 4; ++i) { v[i] = xr[lane + 64 * i]; ss += v[i].x * v[i].x + v[i].y * v[i].y + v[i].z * v[i].z + v[i].w * v[i].w; }
#pragma unroll
    for (int off = 32; off >= 1; off >>= 1) ss += __shfl_xor(ss, off);
    const float rs = rsqrtf(ss * (1.f / DM) + 1e-6f);
#pragma unroll
    for (int i = 0; i < 4; ++i) {
      float4 gg = ((const float4*)g)[lane + 64 * i];
      xr[lane + 64 * i] = make_float4(v[i].x * rs * gg.x, v[i].y * rs * gg.y, v[i].z * rs * gg.z, v[i].w * rs * gg.w);
    }
  }
}

__device__ void phase_prep(const Params& p, u16* sm) {
  const int tid = threadIdx.x;
  const int n_tr = 768 + 256 + 480 + 256 + 1408 * 2 + 704 * 2 + 64 * 2 + 2 * 2;
  const int n_rope = NTOK * 32 / 256;
  const int n_bias = 2;
  const int n_norm = NTOK / 4;
  const int total = n_tr + n_rope + n_bias + n_norm;
  for (int it = blockIdx.x; it < total; it += gridDim.x) {
    if (it < n_tr) {
      constexpr int T1 = 768, T2 = T1 + 256, T3 = T2 + 480, T4 = T3 + 256, T5 = T4 + 1408, T6 = T5 + 1408,
                    T7 = T6 + 704, T8 = T7 + 704, T9 = T8 + 64, T10 = T9 + 64, T11 = T10 + 2;
      if (it < T1) { transpose_tile(p.sba_w_in, p.wt_sba_in, 1024, 3072, 3072, it - (0), sm); }
      else if (it < T2) { transpose_tile(p.sba_w_out, p.wt_sba_out, 1024, 1024, 1024, it - (T1), sm); }
      else if (it < T3) { transpose_tile(p.nsa_w_in, p.wt_nsa_in, 1024, 1840, NSAWP, it - (T2), sm); }
      else if (it < T4) { transpose_tile(p.nsa_w_out, p.wt_nsa_out, 1024, 1024, 1024, it - (T3), sm); }
      else if (it < T5) { transpose_tile(p.w_up, p.wt_up0, 1024, NUP, NUP, it - (T4), sm); }
      else if (it < T6) { transpose_tile(p.w_up + (size_t)1024 * NUP, p.wt_up1, 1024, NUP, NUP, it - (T5), sm); }
      else if (it < T7) { transpose_tile(p.w_down, p.wt_down0, DFF, 1024, 1024, it - (T6), sm); }
      else if (it < T8) { transpose_tile(p.w_down + (size_t)DFF * 1024, p.wt_down1, DFF, 1024, 1024, it - (T7), sm); }
      else if (it < T9) { transpose_tile(p.ck_w1, p.wt_ck1, 2048, 128, 128, it - (T8), sm); }
      else if (it < T10) { transpose_tile(p.cv_w1, p.wt_cv1, 2048, 128, 128, it - (T9), sm); }
      else if (it < T11) { transpose_tile(p.ck_w2, p.wt_ck2, 128, 64, 64, it - (T10), sm); }
      else { transpose_tile(p.cv_w2, p.wt_cv2, 128, 64, 64, it - (T11), sm); }

    } else if (it < n_tr + n_rope) {
      int idx = (it - n_tr) * 256 + tid;
      int tok = idx >> 5, f = idx & 31;
      float inv = powf(10000.f, -(float)f / 32.f);
      float ang = (float)p.pos[tok] * inv;
      p.rope[idx] = make_float2(cosf(ang), sinf(ang));
    } else if (it < n_tr + n_rope + n_bias) {
      int which = it - n_tr - n_rope;
      const float* pe = which ? p.pe_v : p.pe_k;
      const float* w1 = which ? p.cv_w1 : p.ck_w1;
      float* dst = which ? p.bias1v : p.bias1k;
      if (tid < 128) {
        float s = 0.f;
        for (int kk = 0; kk < 2048; ++kk) s += pe[kk] * w1[kk * 128 + tid];
        dst[tid] = s;
      }
    } else {
      int r = (it - n_tr - n_rope - n_bias) * 4 + (tid >> 6);
      rmsnorm_row_bf16(p.x, p.norm_mix, p.hn, r, tid & 63);
    }
  }
}

template <class ARowF>
__device__ __forceinline__ void gemm_mainloop(f32x4 (&acc)[4][4], ARowF arow, int a_kstep, const u16* bt, int ldb, int nk, u16* sm) {
  const int tid = threadIdx.x, lane = tid & 63, wave = tid >> 6;
  const int wm = wave >> 1, wn = wave & 1;
  const int lc = tid & 7, lr = tid >> 3;
  const u16* pa[4]; const u16* pb[4];
#pragma unroll
  for (int i = 0; i < 4; ++i) { pa[i] = arow(lr + 32 * i) + lc * 8; pb[i] = bt + (size_t)(lr + 32 * i) * ldb + lc * 8; }
  u16* sA = sm; u16* sB = sm + 2 * 128 * LDSP;
  uint4 ra[4], rb[4];
#pragma unroll
  for (int i = 0; i < 4; ++i) { ra[i] = *(const uint4*)pa[i]; rb[i] = *(const uint4*)pb[i]; }
#pragma unroll
  for (int i = 0; i < 4; ++i) {
    *(uint4*)(sA + (lr + 32 * i) * LDSP + lc * 8) = ra[i];
    *(uint4*)(sB + (lr + 32 * i) * LDSP + lc * 8) = rb[i];
  }
  __syncthreads();
  const int fr = lane & 15, fq = lane >> 4;
  for (int kt = 0; kt < nk; ++kt) {
    const bool more = (kt + 1 < nk);
    if (more) {
#pragma unroll
      for (int i = 0; i < 4; ++i) {
        ra[i] = *(const uint4*)(pa[i] + (size_t)(kt + 1) * a_kstep);
        rb[i] = *(const uint4*)(pb[i] + (size_t)(kt + 1) * 64);
      }
    }
    const u16* cA = sA + (kt & 1) * 128 * LDSP + (wm * 64 + fr) * LDSP + fq * 8;
    const u16* cB = sB + (kt & 1) * 128 * LDSP + (wn * 64 + fr) * LDSP + fq * 8;
#pragma unroll
    for (int ks = 0; ks < 2; ++ks) {
      bf16x8 wf[4], xf[4];
#pragma unroll
      for (int i = 0; i < 4; ++i) {
        wf[i] = *(const bf16x8*)(cB + i * 16 * LDSP + ks * 32);
        xf[i] = *(const bf16x8*)(cA + i * 16 * LDSP + ks * 32);
      }
#pragma unroll
      for (int i = 0; i < 4; ++i)
#pragma unroll
        for (int j = 0; j < 4; ++j) acc[i][j] = mfma16(wf[i], xf[j], acc[i][j]);
    }
    if (more) {
      u16* dA = sA + ((kt + 1) & 1) * 128 * LDSP; u16* dB = sB + ((kt + 1) & 1) * 128 * LDSP;
#pragma unroll
      for (int i = 0; i < 4; ++i) {
        *(uint4*)(dA + (lr + 32 * i) * LDSP + lc * 8) = ra[i];
        *(uint4*)(dB + (lr + 32 * i) * LDSP + lc * 8) = rb[i];
      }
    }
    __syncthreads();
  }
}

__device__ __forceinline__ void zero_acc(f32x4 (&acc)[4][4]) {
#pragma unroll
  for (int i = 0; i < 4; ++i)
#pragma unroll
    for (int j = 0; j < 4; ++j) acc[i][j] = (f32x4){0.f, 0.f, 0.f, 0.f};
}

__device__ void phase_sba_qkv(const Params& p, u16* sm) {
  const int lane = threadIdx.x & 63, wave = threadIdx.x >> 6, wm = wave >> 1, wn = wave & 1, fr = lane & 15, fq = lane >> 4;
  const int nN = 24, ntiles = (NTOK / 128) * nN;
  for (int tile = blockIdx.x; tile < ntiles; tile += gridDim.x) {
    const int mt = tile / nN, nt = tile - mt * nN;
    const int m0 = mt * 128, n0 = nt * 128;
    f32x4 acc[4][4]; zero_acc(acc);
    const u16* A = p.hn + (size_t)m0 * DM;
    gemm_mainloop(acc, [&](int r) { return A + (size_t)r * DM; }, 64, p.wt_sba_in + (size_t)n0 * DM, DM, DM / 64, sm);
    if (n0 < 2048) {
      u16* dst = (n0 < 1024) ? p.qb : p.kb;
      const int nn0 = (n0 & 1023) + wn * 64 + fq * 4;
#pragma unroll
      for (int j = 0; j < 4; ++j) {
        const int tok = m0 + wm * 64 + j * 16 + fr;
#pragma unroll
        for (int i = 0; i < 4; ++i) *(uint2*)(dst + (size_t)tok * DM + nn0 + i * 16) = pack4(acc[i][j]);
      }
    } else {
      const int h = (n0 - 2048) / 64 + wn;
#pragma unroll
      for (int j = 0; j < 4; ++j) {
        const int tok = m0 + wm * 64 + j * 16 + fr;
        const int b = tok >> 12, t = tok & 4095;
#pragma unroll
        for (int i = 0; i < 4; ++i)
#pragma unroll
          for (int r = 0; r < 4; ++r) {
            const int d = i * 16 + fq * 4 + r;
            p.vT[((size_t)(b * 16 + h) * 64 + d) * SEQ + t] = f2bf(acc[i][j][r]);
          }
      }
    }
  }
}

__device__ void phase_proj_resid(const u16* A, int lda, int K, const u16* wt, const float* resid, float* out, int tok0, int ntok, u16* sm) {
  const int lane = threadIdx.x & 63, wave = threadIdx.x >> 6, wm = wave >> 1, wn = wave & 1, fr = lane & 15, fq = lane >> 4;
  const int nN = 8, ntiles = (ntok / 128) * nN;
  for (int tile = blockIdx.x; tile < ntiles; tile += gridDim.x) {
    const int mt = tile / nN, nt = tile - mt * nN;
    const int m0 = mt * 128, n0 = nt * 128;
    f32x4 acc[4][4]; zero_acc(acc);
    const u16* Ab = A + (size_t)m0 * lda;
    gemm_mainloop(acc, [&](int r) { return Ab + (size_t)r * lda; }, 64, wt + (size_t)n0 * K, K, K / 64, sm);
#pragma unroll
    for (int j = 0; j < 4; ++j) {
      const size_t tok = (size_t)tok0 + m0 + wm * 64 + j * 16 + fr;
#pragma unroll
      for (int i = 0; i < 4; ++i) {
        const int n = n0 + wn * 64 + i * 16 + fq * 4;
        float4 rv = *(const float4*)(resid + tok * DM + n);
        *(float4*)(out + tok * DM + n) = make_float4(rv.x + acc[i][j][0], rv.y + acc[i][j][1], rv.z + acc[i][j][2], rv.w + acc[i][j][3]);
      }
    }
  }
}

__device__ void phase_ffn_up(const Params& p, int layer, int half, u16* sm) {
  const int lane = threadIdx.x & 63, wave = threadIdx.x >> 6, wm = wave >> 1, wn = wave & 1, fr = lane & 15, fq = lane >> 4;
  const int nN = NUP / 128, ntiles = (HALF_TOK / 128) * nN;
  const u16* wt = layer ? p.wt_up1 : p.wt_up0;
  for (int tile = blockIdx.x; tile < ntiles; tile += gridDim.x) {
    const int mt = tile / nN, nt = tile - mt * nN;
    const int m0 = mt * 128, n0 = nt * 128;
    f32x4 acc[4][4]; zero_acc(acc);
    const u16* Ab = p.hn + ((size_t)half * HALF_TOK + m0) * DM;
    gemm_mainloop(acc, [&](int r) { return Ab + (size_t)r * DM; }, 64, wt + (size_t)n0 * DM, DM, DM / 64, sm);
#pragma unroll
    for (int j = 0; j < 4; ++j) {
      const size_t tl = (size_t)m0 + wm * 64 + j * 16 + fr;
#pragma unroll
      for (int i = 0; i < 4; ++i) *(uint2*)(p.u + tl * NUP + n0 + wn * 64 + i * 16 + fq * 4) = pack4(acc[i][j]);
    }
  }
}

__device__ void phase_conv_act(const Params& p, int layer) {
  const float* cw = p.conv_w + (size_t)layer * 3 * NUP;
  const float* cb = p.conv_b + (size_t)layer * NUP;
  const int nunits = (HALF_TOK / 8) * (DFF / 8);
  for (int unit = blockIdx.x * 256 + threadIdx.x; unit < nunits; unit += gridDim.x * 256) {
    const int fch = unit % (DFF / 8), tch = unit / (DFF / 8);
    const int f0 = fch * 8, tl0 = tch * 8;
    float wg[3][8], wv[3][8], bg[8], bv[8];
#pragma unroll
    for (int j = 0; j < 3; ++j)
#pragma unroll
      for (int e = 0; e < 8; ++e) { wg[j][e] = cw[j * NUP + f0 + e]; wv[j][e] = cw[j * NUP + DFF + f0 + e]; }
#pragma unroll
    for (int e = 0; e < 8; ++e) { bg[e] = cb[f0 + e]; bv[e] = cb[DFF + f0 + e]; }
    float g2[8], g1[8], v2[8], v1[8];
    const bool first = ((tl0 & 4095) == 0);
    if (first) {
#pragma unroll
      for (int e = 0; e < 8; ++e) { g2[e] = g1[e] = v2[e] = v1[e] = 0.f; }
    } else {
      union { uint4 q; u16 h[8]; } a, b, c, d;
      a.q = *(const uint4*)(p.u + (size_t)(tl0 - 2) * NUP + f0);
      b.q = *(const uint4*)(p.u + (size_t)(tl0 - 1) * NUP + f0);
      c.q = *(const uint4*)(p.u + (size_t)(tl0 - 2) * NUP + DFF + f0);
      d.q = *(const uint4*)(p.u + (size_t)(tl0 - 1) * NUP + DFF + f0);
#pragma unroll
      for (int e = 0; e < 8; ++e) { g2[e] = bf2f(a.h[e]); g1[e] = bf2f(b.h[e]); v2[e] = bf2f(c.h[e]); v1[e] = bf2f(d.h[e]); }
    }
#pragma unroll
    for (int tt = 0; tt < 8; ++tt) {
      union { uint4 q; u16 h[8]; } a, c;
      a.q = *(const uint4*)(p.u + (size_t)(tl0 + tt) * NUP + f0);
      c.q = *(const uint4*)(p.u + (size_t)(tl0 + tt) * NUP + DFF + f0);
      float res[8];
#pragma unroll
      for (int e = 0; e < 8; ++e) {
        float g0 = bf2f(a.h[e]), v0 = bf2f(c.h[e]);
        float cg_ = bg[e] + g2[e] * wg[0][e] + g1[e] * wg[1][e] + g0 * wg[2][e];
        float cv_ = bv[e] + v2[e] * wv[0][e] + v1[e] * wv[1][e] + v0 * wv[2][e];
        res[e] = cg_ / (1.f + __expf(-cg_)) * cv_;
        g2[e] = g1[e]; g1[e] = g0; v2[e] = v1[e]; v1[e] = v0;
      }
      uint4 o = make_uint4(pack2(res[0], res[1]), pack2(res[2], res[3]), pack2(res[4], res[5]), pack2(res[6], res[7]));
      *(uint4*)(p.act + (size_t)(tl0 + tt) * DFF + f0) = o;
    }
  }
}

__device__ void phase_nsa_in(const Params& p, u16* sm) {
  const int lane = threadIdx.x & 63, wave = threadIdx.x >> 6, wm = wave >> 1, wn = wave & 1, fr = lane & 15, fq = lane >> 4;
  const int nN = NSAWP / 128, ntiles = (NTOK / 128) * nN;
  for (int tile = blockIdx.x; tile < ntiles; tile += gridDim.x) {
    const int mt = tile / nN, nt = tile - mt * nN;
    const int m0 = mt * 128, n0 = nt * 128;
    f32x4 acc[4][4]; zero_acc(acc);
    const u16* A = p.hn + (size_t)m0 * DM;
    gemm_mainloop(acc, [&](int r) { return A + (size_t)r * DM; }, 64, p.wt_nsa_in + (size_t)n0 * DM, DM, DM / 64, sm);
    const bool is_rope = (n0 < 1024) || (n0 == 1280) || (n0 == 1536);
    const bool is_vt = (n0 == 1408) || (n0 == 1664);
#pragma unroll
    for (int j = 0; j < 4; ++j) {
      const int tok = m0 + wm * 64 + j * 16 + fr;
      if (is_rope) {
        u16* dst; int ld, col0;
        if (n0 < 1024) { dst = p.qn; ld = DM; col0 = n0 + wn * 64; }
        else if (n0 == 1280) { dst = p.ksb; ld = 128; col0 = wn * 64; }
        else { dst = p.kwb; ld = 128; col0 = wn * 64; }
#pragma unroll
        for (int i = 0; i < 2; ++i) {
          const int d = i * 16 + fq * 4;
          const float4 cs01 = *(const float4*)(p.rope + (size_t)tok * 32 + d);
          const float4 cs23 = *(const float4*)(p.rope + (size_t)tok * 32 + d + 2);
          const float cc[4] = {cs01.x, cs01.z, cs23.x, cs23.z};
          const float ss[4] = {cs01.y, cs01.w, cs23.y, cs23.w};
          f32x4 o1, o2;
#pragma unroll
          for (int r = 0; r < 4; ++r) {
            float x1 = acc[i][j][r], x2 = acc[i + 2][j][r];
            o1[r] = x1 * cc[r] - x2 * ss[r];
            o2[r] = x2 * cc[r] + x1 * ss[r];
          }
          *(uint2*)(dst + (size_t)tok * ld + col0 + d) = pack4(o1);
          *(uint2*)(dst + (size_t)tok * ld + col0 + d + 32) = pack4(o2);
        }
      } else if (is_vt) {
        u16* dst = (n0 == 1408) ? p.vsT : p.vwT;
        const int b = tok >> 12, t = tok & 4095;
#pragma unroll
        for (int i = 0; i < 4; ++i)
#pragma unroll
          for (int r = 0; r < 4; ++r) {
            const int d = i * 16 + fq * 4 + r;
            dst[((size_t)(b * 2 + wn) * 64 + d) * SEQ + t] = f2bf(acc[i][j][r]);
          }
      } else if (n0 == 1024 || n0 == 1152) {
        const int col0 = (n0 == 1024 ? 0 : 128) + wn * 64 + fq * 4;
#pragma unroll
        for (int i = 0; i < 4; ++i) *(uint2*)(p.cbuf + (size_t)tok * 256 + col0 + i * 16) = pack4(acc[i][j]);
      } else {
        if (wn == 0) {
#pragma unroll
          for (int i = 0; i < 3; ++i) {
            const int c = i * 16 + fq * 4;
            float4 gv;
            gv.x = 1.f / (1.f + __expf(-acc[i][j][0])); gv.y = 1.f / (1.f + __expf(-acc[i][j][1]));
            gv.z = 1.f / (1.f + __expf(-acc[i][j][2])); gv.w = 1.f / (1.f + __expf(-acc[i][j][3]));
            *(float4*)(p.gbuf + (size_t)tok * 48 + c) = gv;
          }
        }
      }
    }
  }
}

__device__ void phase_compress(const Params& p, u16* sm) {
  const int tid = threadIdx.x, lane = tid & 63, wave = tid >> 6, wm = wave >> 1, wn = wave & 1, fr = lane & 15, fq = lane >> 4;
  for (int tile = blockIdx.x; tile < 64; tile += gridDim.x) {
    const int which = tile & 1, mt = tile >> 1;
    const int m0 = mt * 128;
    const u16* w1t = which ? p.wt_cv1 : p.wt_ck1;
    const u16* w2t = which ? p.wt_cv2 : p.wt_ck2;
    const float* bias = which ? p.bias1v : p.bias1k;
    f32x4 acc[4][4]; zero_acc(acc);
    const u16* cb = p.cbuf + which * 128;
    gemm_mainloop(acc, [&](int r) {
      int row = m0 + r; int g = row & 1; int bc = row >> 1; int c = bc & 255; int b = bc >> 8;
      if (c > 254) c = 254;
      return cb + ((size_t)b * SEQ + c * 16) * 256 + g * 64;
    }, 256, w1t, 2048, 32, sm);
    u16* sH = sm; u16* sW = sm + 128 * 136;
#pragma unroll
    for (int i = 0; i < 4; ++i) {
      const int n = wn * 64 + i * 16 + fq * 4;
      const float4 bv = *(const float4*)(bias + n);
      const float bb[4] = {bv.x, bv.y, bv.z, bv.w};
#pragma unroll
      for (int j = 0; j < 4; ++j) {
        const int rl = wm * 64 + j * 16 + fr;
        f32x4 hv;
#pragma unroll
        for (int r = 0; r < 4; ++r) {
          float xv = acc[i][j][r] + bb[r];
          float inner = 0.7978845608028654f * (xv + 0.044715f * xv * xv * xv);
          hv[r] = 0.5f * xv * (1.f + tanhf(inner));
        }
        *(uint2*)(sH + rl * 136 + n) = pack4(hv);
      }
    }
    {
#pragma unroll
      for (int i = 0; i < 4; ++i) {
        int idx = tid + 256 * i; int r = idx >> 4, c = idx & 15;
        *(uint4*)(sW + r * 136 + c * 8) = *(const uint4*)(w2t + r * 128 + c * 8);
      }
    }
    __syncthreads();
    f32x4 o2[4][2];
#pragma unroll
    for (int dm = 0; dm < 4; ++dm) { o2[dm][0] = (f32x4){0.f, 0.f, 0.f, 0.f}; o2[dm][1] = (f32x4){0.f, 0.f, 0.f, 0.f}; }
#pragma unroll
    for (int ks = 0; ks < 4; ++ks) {
      bf16x8 hf[2];
#pragma unroll
      for (int j = 0; j < 2; ++j) hf[j] = *(const bf16x8*)(sH + (wave * 32 + j * 16 + fr) * 136 + ks * 32 + fq * 8);
#pragma unroll
      for (int dm = 0; dm < 4; ++dm) {
        bf16x8 wf = *(const bf16x8*)(sW + (dm * 16 + fr) * 136 + ks * 32 + fq * 8);
#pragma unroll
        for (int j = 0; j < 2; ++j) o2[dm][j] = mfma16(wf, hf[j], o2[dm][j]);
      }
    }
#pragma unroll
    for (int j = 0; j < 2; ++j) {
      const int row = m0 + wave * 32 + j * 16 + fr;
      const int g = row & 1, bc = row >> 1, c = bc & 255, b = bc >> 8;
      const bool valid = (c < 255);
      if (which == 0) {
        const int tok = b * SEQ + (valid ? c : 254) * 16 + 31;
        u16* dst = p.kc + ((size_t)(b * 2 + g) * 256 + c) * 64;
#pragma unroll
        for (int i = 0; i < 2; ++i) {
          const int d = i * 16 + fq * 4;
          const float4 cs01 = *(const float4*)(p.rope + (size_t)tok * 32 + d);
          const float4 cs23 = *(const float4*)(p.rope + (size_t)tok * 32 + d + 2);
          const float cc[4] = {cs01.x, cs01.z, cs23.x, cs23.z};
          const float ss[4] = {cs01.y, cs01.w, cs23.y, cs23.w};
          f32x4 o1, o2v;
#pragma unroll
          for (int r = 0; r < 4; ++r) {
            float x1 = o2[i][j][r], x2 = o2[i + 2][j][r];
            o1[r] = valid ? x1 * cc[r] - x2 * ss[r] : 0.f;
            o2v[r] = valid ? x2 * cc[r] + x1 * ss[r] : 0.f;
          }
          *(uint2*)(dst + d) = pack4(o1);
          *(uint2*)(dst + d + 32) = pack4(o2v);
        }
      } else {
#pragma unroll
        for (int dm = 0; dm < 4; ++dm)
#pragma unroll
          for (int r = 0; r < 4; ++r) {
            const int d = dm * 16 + fq * 4 + r;
            p.vcT[((size_t)(b * 2 + g) * 64 + d) * 256 + c] = valid ? f2bf(o2[dm][j][r]) : (u16)0;
          }
      }
    }
    __syncthreads();
  }
}

__device__ __forceinline__ int rho_row(int k) { return (k & 32) | ((k & 4) << 2) | ((k & 24) >> 1) | (k & 3); }

__device__ __forceinline__ void load_tile64(u16* s, const u16* src, size_t ld, bool perm) {
  const int c = threadIdx.x & 7, r0 = threadIdx.x >> 3;
  uint4 v0 = *(const uint4*)(src + (size_t)r0 * ld + c * 8);
  uint4 v1 = *(const uint4*)(src + (size_t)(r0 + 32) * ld + c * 8);
  const int l0 = perm ? rho_row(r0) : r0, l1 = perm ? rho_row(r0 + 32) : (r0 + 32);
  *(uint4*)(s + l0 * LDSP + c * 8) = v0;
  *(uint4*)(s + l1 * LDSP + c * 8) = v1;
}

__device__ void phase_sba_attn(const Params& p, u16* sm) {
  const int tid = threadIdx.x, lane = tid & 63, wave = tid >> 6, fr = lane & 15, fq = lane >> 4;
  u16* sK = sm; u16* sV = sm + 64 * LDSP;
  bf16x8 tri[2], ones;
#pragma unroll
  for (int bb = 0; bb < 2; ++bb) {
    uint32_t w[4];
#pragma unroll
    for (int i2 = 0; i2 < 4; ++i2) {
      const int s_ = 8 * (fr >> 2) + 4 * bb + (fr & 3);
      const int j0 = 8 * fq + 2 * i2, j1 = j0 + 1;
      w[i2] = (j0 > s_ ? 0x3F80u : 0u) | ((j1 > s_ ? 0x3F80u : 0u) << 16);
    }
    tri[bb] = mk_frag(w[0], w[1], w[2], w[3]);
  }
  ones = mk_frag(0x3F803F80u, 0x3F803F80u, 0x3F803F80u, 0x3F803F80u);

  const int ntiles = 128 * 64;
  for (int tile = blockIdx.x; tile < ntiles; tile += gridDim.x) {
    const int qt = 63 - (tile >> 7), bh = tile & 127;
    const int b = bh >> 4, h = bh & 15;
    const int myq = qt * 64 + wave * 16 + fr;
    bf16x8 qf[2];
#pragma unroll
    for (int ks = 0; ks < 2; ++ks) qf[ks] = *(const bf16x8*)(p.qb + ((size_t)b * SEQ + myq) * DM + h * 64 + ks * 32 + fq * 8);
    f32x4 o[4];
#pragma unroll
    for (int dm = 0; dm < 4; ++dm) o[dm] = (f32x4){0.f, 0.f, 0.f, 0.f};
    float carry = 0.f;
    for (int kt = qt; kt >= 0; --kt) {
      load_tile64(sK, p.kb + ((size_t)b * SEQ + kt * 64) * DM + h * 64, DM, true);
      load_tile64(sV, p.vT + ((size_t)(b * 16 + h) * 64) * SEQ + kt * 64, SEQ, false);
      __syncthreads();
      f32x4 s[4];
#pragma unroll
      for (int mt = 0; mt < 4; ++mt) {
        s[mt] = (f32x4){0.f, 0.f, 0.f, 0.f};
#pragma unroll
        for (int ks = 0; ks < 2; ++ks) {
          bf16x8 kf = *(const bf16x8*)(sK + (mt * 16 + fr) * LDSP + ks * 32 + fq * 8);
          s[mt] = mfma16(kf, qf[ks], s[mt]);
        }
      }
      float L[4][4], lb[4][4];
      unsigned vmask = 0;
#pragma unroll
      for (int mt = 0; mt < 4; ++mt)
#pragma unroll
        for (int j = 0; j < 4; ++j) {
          const float z = s[mt][j] * 0.125f;
          const int key = kt * 64 + 32 * (mt >> 1) + 8 * fq + 4 * (mt & 1) + j;
          const bool valid = key < myq;
          const float e = __expf(-fabsf(z));
          const float sp = fmaxf(z, 0.f) + __logf(1.f + e);
          L[mt][j] = valid ? -sp : 0.f;
          lb[mt][j] = z - sp;
          vmask |= (valid ? 1u : 0u) << (mt * 4 + j);
        }
      bf16x8 Lh[2], Ll[2];
#pragma unroll
      for (int k2 = 0; k2 < 2; ++k2) {
        uint32_t hw[4], lw[4];
#pragma unroll
        for (int e2 = 0; e2 < 4; ++e2) {
          const int mt = 2 * k2 + (e2 >> 1), j = (e2 & 1) * 2;
          const u16 h0 = f2bf(L[mt][j]), h1 = f2bf(L[mt][j + 1]);
          const float r0 = L[mt][j] - bf2f(h0), r1 = L[mt][j + 1] - bf2f(h1);
          hw[e2] = (uint32_t)h0 | ((uint32_t)h1 << 16);
          lw[e2] = pack2(r0, r1);
        }
        Lh[k2] = mk_frag(hw[0], hw[1], hw[2], hw[3]);
        Ll[k2] = mk_frag(lw[0], lw[1], lw[2], lw[3]);
      }
      f32x4 cum[4];
#pragma unroll
      for (int ms = 0; ms < 4; ++ms) {
        const int a = ms >> 1, bb = ms & 1;
        f32x4 c = (f32x4){0.f, 0.f, 0.f, 0.f};
        c = mfma16(tri[bb], Lh[a], c);
        c = mfma16(tri[bb], Ll[a], c);
        if (a == 0) { c = mfma16(ones, Lh[1], c); c = mfma16(ones, Ll[1], c); }
        cum[ms] = c;
      }
      float tot = cum[0][0] + L[0][0];
      tot = __shfl(tot, fr);
      bf16x8 pf[2];
#pragma unroll
      for (int k2 = 0; k2 < 2; ++k2) {
        uint32_t pw[4];
#pragma unroll
        for (int e2 = 0; e2 < 4; ++e2) {
          const int mt = 2 * k2 + (e2 >> 1), j = (e2 & 1) * 2;
          float p0 = ((vmask >> (mt * 4 + j)) & 1u) ? __expf(lb[mt][j] + cum[mt][j] + carry) : 0.f;
          float p1 = ((vmask >> (mt * 4 + j + 1)) & 1u) ? __expf(lb[mt][j + 1] + cum[mt][j + 1] + carry) : 0.f;
          pw[e2] = pack2(p0, p1);
        }
        pf[k2] = mk_frag(pw[0], pw[1], pw[2], pw[3]);
      }
#pragma unroll
      for (int k2 = 0; k2 < 2; ++k2)
#pragma unroll
        for (int dm = 0; dm < 4; ++dm) {
          bf16x8 vf = *(const bf16x8*)(sV + (dm * 16 + fr) * LDSP + k2 * 32 + fq * 8);
          o[dm] = mfma16(vf, pf[k2], o[dm]);
        }
      carry += tot;
      if (__syncthreads_and(carry < -104.f)) break;
    }
#pragma unroll
    for (int dm = 0; dm < 4; ++dm)
      *(uint2*)(p.ob + ((size_t)b * SEQ + myq) * DM + h * 64 + dm * 16 + fq * 4) = pack4(o[dm]);
  }
}

struct NsaState {
  f32x4 acc[2][4];
  float m[2], l[2];
};

__device__ __forceinline__ void nsa_qk(f32x4 (&s)[2][4], const u16* sK, const bf16x8 (&qf)[2][2], int fr, int fq) {
#pragma unroll
  for (int mt = 0; mt < 4; ++mt) {
    s[0][mt] = (f32x4){0.f, 0.f, 0.f, 0.f}; s[1][mt] = (f32x4){0.f, 0.f, 0.f, 0.f};
#pragma unroll
    for (int ks = 0; ks < 2; ++ks) {
      bf16x8 kf = *(const bf16x8*)(sK + (mt * 16 + fr) * LDSP + ks * 32 + fq * 8);
      s[0][mt] = mfma16(kf, qf[0][ks], s[0][mt]);
      s[1][mt] = mfma16(kf, qf[1][ks], s[1][mt]);
    }
  }
}

__device__ __forceinline__ void nsa_pv(f32x4 (&acc)[2][4], const u16* sV, const bf16x8 (&pf)[2][2], int fr, int fq) {
#pragma unroll
  for (int k2 = 0; k2 < 2; ++k2)
#pragma unroll
    for (int dm = 0; dm < 4; ++dm) {
      bf16x8 vf = *(const bf16x8*)(sV + (dm * 16 + fr) * LDSP + k2 * 32 + fq * 8);
      acc[0][dm] = mfma16(vf, pf[0][k2], acc[0][dm]);
      acc[1][dm] = mfma16(vf, pf[1][k2], acc[1][dm]);
    }
}

__device__ __forceinline__ void nsa_online_step(NsaState& st, f32x4 (&s)[2][4], unsigned vmask, const u16* sV, int fr, int fq) {
  bf16x8 pf[2][2];
#pragma unroll
  for (int hh = 0; hh < 2; ++hh) {
    float tmax = -1e30f;
#pragma unroll
    for (int mt = 0; mt < 4; ++mt)
#pragma unroll
      for (int j = 0; j < 4; ++j) {
        const float sc = ((vmask >> (mt * 4 + j)) & 1u) ? s[hh][mt][j] * 0.125f : -1e30f;
        s[hh][mt][j] = sc;
        tmax = fmaxf(tmax, sc);
      }
    tmax = fmaxf(tmax, __shfl_xor(tmax, 16));
    tmax = fmaxf(tmax, __shfl_xor(tmax, 32));
    const float mnew = fmaxf(st.m[hh], tmax);
    const float alpha = __expf(st.m[hh] - mnew);
    st.m[hh] = mnew;
    float psum = 0.f;
#pragma unroll
    for (int k2 = 0; k2 < 2; ++k2) {
      uint32_t pw[4];
#pragma unroll
      for (int e2 = 0; e2 < 4; ++e2) {
        const int mt = 2 * k2 + (e2 >> 1), j = (e2 & 1) * 2;
        float p0 = ((vmask >> (mt * 4 + j)) & 1u) ? __expf(s[hh][mt][j] - mnew) : 0.f;
        float p1 = ((vmask >> (mt * 4 + j + 1)) & 1u) ? __expf(s[hh][mt][j + 1] - mnew) : 0.f;
        psum += p0 + p1;
        pw[e2] = pack2(p0, p1);
      }
      pf[hh][k2] = mk_frag(pw[0], pw[1], pw[2], pw[3]);
    }
    st.l[hh] = st.l[hh] * alpha + psum;
#pragma unroll
    for (int dm = 0; dm < 4; ++dm) st.acc[hh][dm] *= alpha;
  }
  nsa_pv(st.acc, sV, pf, fr, fq);
}

__device__ __forceinline__ void nsa_reset(NsaState& st) {
#pragma unroll
  for (int hh = 0; hh < 2; ++hh) {
    st.m[hh] = -1e30f; st.l[hh] = 0.f;
#pragma unroll
    for (int dm = 0; dm < 4; ++dm) st.acc[hh][dm] = (f32x4){0.f, 0.f, 0.f, 0.f};
  }
}

__device__ __forceinline__ void nsa_finish(NsaState& st, f32x4 (&out)[2][4], const float (&gate)[2]) {
#pragma unroll
  for (int hh = 0; hh < 2; ++hh) {
    float l = st.l[hh];
    l += __shfl_xor(l, 16);
    l += __shfl_xor(l, 32);
    const float sc = (l > 0.f) ? gate[hh] / l : 0.f;
#pragma unroll
    for (int dm = 0; dm < 4; ++dm) out[hh][dm] += st.acc[hh][dm] * sc;
  }
}

__device__ void phase_nsa_cmp(const Params& p, u16* sm) {
  const int tid = threadIdx.x, lane = tid & 63, wave = tid >> 6, fr = lane & 15, fq = lane >> 4;
  u16* sK = sm; u16* sV = sm + 64 * LDSP;
  float* Psum = (float*)(sm + 2 * 64 * LDSP);
  float* Imp = Psum + 16 * 260;
  const int ntiles = 16 * 256;
  for (int tile = blockIdx.x; tile < ntiles; tile += gridDim.x) {
    const int qb = 255 - (tile >> 4), bg = tile & 15, b = bg >> 1, g = bg & 1;
    const int t0 = qb * 16, myt = t0 + fr;
    const size_t tokbase = (size_t)b * SEQ;
    const int hA = g * 8 + wave * 2;
    bf16x8 qf[2][2];
#pragma unroll
    for (int hh = 0; hh < 2; ++hh)
#pragma unroll
      for (int ks = 0; ks < 2; ++ks)
        qf[hh][ks] = *(const bf16x8*)(p.qn + (tokbase + myt) * DM + (hA + hh) * 64 + ks * 32 + fq * 8);
    float gate0[2];
#pragma unroll
    for (int hh = 0; hh < 2; ++hh) gate0[hh] = p.gbuf[(tokbase + myt) * 48 + (hA + hh) * 3 + 0];

#pragma unroll
    for (int i = 0; i < 17; ++i) { int idx = tid + 256 * i; if (idx < 16 * 260) Psum[idx] = 0.f; }

    const u16* kcb = p.kc + (size_t)(b * 2 + g) * 256 * 64;
    const u16* vcb = p.vcT + (size_t)(b * 2 + g) * 64 * 256;
    const int ncmp = t0 >> 4;
    const int nct = (ncmp + 63) >> 6;
    NsaState st;
    f32x4 s[2][4];
    nsa_reset(st);
    for (int kt = 0; kt < nct; ++kt) {
      __syncthreads();
      load_tile64(sK, kcb + (size_t)kt * 64 * 64, 64, true);
      __syncthreads();
      nsa_qk(s, sK, qf, fr, fq);
      unsigned vmask = 0;
#pragma unroll
      for (int mt = 0; mt < 4; ++mt)
#pragma unroll
        for (int j = 0; j < 4; ++j) {
          const int c = kt * 64 + 32 * (mt >> 1) + 8 * fq + 4 * (mt & 1) + j;
          vmask |= ((16 * c + 31 <= myt) ? 1u : 0u) << (mt * 4 + j);
        }
#pragma unroll
      for (int hh = 0; hh < 2; ++hh) {
        float tmax = -1e30f;
#pragma unroll
        for (int mt = 0; mt < 4; ++mt)
#pragma unroll
          for (int j = 0; j < 4; ++j) {
            const float sc = ((vmask >> (mt * 4 + j)) & 1u) ? s[hh][mt][j] * 0.125f : -1e30f;
            s[hh][mt][j] = sc; tmax = fmaxf(tmax, sc);
          }
        tmax = fmaxf(tmax, __shfl_xor(tmax, 16));
        tmax = fmaxf(tmax, __shfl_xor(tmax, 32));
        const float mnew = fmaxf(st.m[hh], tmax);
        float psum = 0.f;
#pragma unroll
        for (int mt = 0; mt < 4; ++mt)
#pragma unroll
          for (int j = 0; j < 4; ++j) psum += ((vmask >> (mt * 4 + j)) & 1u) ? __expf(s[hh][mt][j] - mnew) : 0.f;
        st.l[hh] = st.l[hh] * __expf(st.m[hh] - mnew) + psum;
        st.m[hh] = mnew;
      }
    }
    float invl[2];
#pragma unroll
    for (int hh = 0; hh < 2; ++hh) {
      float l = st.l[hh];
      l += __shfl_xor(l, 16);
      l += __shfl_xor(l, 32);
      invl[hh] = (l > 0.f) ? 1.f / l : 0.f;
    }
    for (int kt = 0; kt < nct; ++kt) {
      __syncthreads();
      load_tile64(sK, kcb + (size_t)kt * 64 * 64, 64, true);
      load_tile64(sV, vcb + kt * 64, 256, false);
      __syncthreads();
      nsa_qk(s, sK, qf, fr, fq);
      bf16x8 pf[2][2];
      float pp[4][4];
#pragma unroll
      for (int mt = 0; mt < 4; ++mt)
#pragma unroll
        for (int j = 0; j < 4; ++j) pp[mt][j] = 0.f;
#pragma unroll
      for (int hh = 0; hh < 2; ++hh) {
#pragma unroll
        for (int k2 = 0; k2 < 2; ++k2) {
          uint32_t pw[4];
#pragma unroll
          for (int e2 = 0; e2 < 4; ++e2) {
            const int mt = 2 * k2 + (e2 >> 1), j = (e2 & 1) * 2;
            const int c0 = kt * 64 + 32 * (mt >> 1) + 8 * fq + 4 * (mt & 1) + j;
            float p0 = (16 * c0 + 31 <= myt) ? __expf(s[hh][mt][j] * 0.125f - st.m[hh]) * invl[hh] : 0.f;
            float p1 = (16 * (c0 + 1) + 31 <= myt) ? __expf(s[hh][mt][j + 1] * 0.125f - st.m[hh]) * invl[hh] : 0.f;
            pp[mt][j] += p0; pp[mt][j + 1] += p1;
            pw[e2] = pack2(p0, p1);
          }
          pf[hh][k2] = mk_frag(pw[0], pw[1], pw[2], pw[3]);
        }
      }
      nsa_pv(st.acc, sV, pf, fr, fq);
      for (int w = 0; w < 4; ++w) {
        if (wave == w) {
#pragma unroll
          for (int mt = 0; mt < 4; ++mt)
#pragma unroll
            for (int j = 0; j < 4; ++j) {
              const int c = kt * 64 + 32 * (mt >> 1) + 8 * fq + 4 * (mt & 1) + j;
              Psum[fr * 260 + c] += pp[mt][j];
            }
        }
        __syncthreads();
      }
    }
#pragma unroll
    for (int hh = 0; hh < 2; ++hh)
#pragma unroll
      for (int dm = 0; dm < 4; ++dm)
        *(uint2*)(p.ocp + (tokbase + myt) * DM + (hA + hh) * 64 + dm * 16 + fq * 4) = pack4(st.acc[hh][dm] * gate0[hh]);
    __syncthreads();
#pragma unroll
    for (int e = 0; e < 4; ++e) {
      const int idx = tid + 256 * e, q = idx >> 6, n = idx & 63;
      const float* Pq = Psum + q * 260 + 4 * n;
      float v = Pq[0] + Pq[1] + Pq[2] + 0.5f * (Pq[3] + (n > 0 ? Pq[-1] : 0.f));
      Imp[q * 64 + n] = v;
    }
    __syncthreads();
#pragma unroll
    for (int qi = 0; qi < 4; ++qi) {
      const int q = wave * 4 + qi, tq = t0 + q, cur = tq >> 6, n = lane;
      const bool causal = (n <= cur);
      const bool forced = (n == 0) || (n == cur) || (n == cur - 1);
      const float sc = causal ? (Imp[q * 64 + n] + (forced ? 1e4f : 0.f)) : -1e30f;
      int rank = 0;
      Imp[q * 64 + n] = sc;
      __builtin_amdgcn_wave_barrier();
#pragma unroll 8
      for (int n2 = 0; n2 < 64; ++n2) {
        const float s2 = Imp[q * 64 + n2];
        rank += ((s2 > sc) || (s2 == sc && n2 < n)) ? 1 : 0;
      }
      const unsigned long long mk = __ballot(causal && rank < 16);
      if (lane == 0) p.msk[(size_t)(b * 2 + g) * SEQ + tq] = mk;
    }
    __syncthreads();
  }
}

__device__ void phase_nsa_sw(const Params& p, u16* sm) {
  const int tid = threadIdx.x, lane = tid & 63, wave = tid >> 6, fr = lane & 15, fq = lane >> 4;
  u16* sK = sm; u16* sV = sm + 64 * LDSP;
  const int ntiles = 16 * 256;
  for (int tile = blockIdx.x; tile < ntiles; tile += gridDim.x) {
    const int qb = 255 - (tile >> 4), bg = tile & 15, b = bg >> 1, g = bg & 1;
    const int t0 = qb * 16, myt = t0 + fr;
    const size_t tokbase = (size_t)b * SEQ;
    const int hA = g * 8 + wave * 2;
    bf16x8 qf[2][2];
#pragma unroll
    for (int hh = 0; hh < 2; ++hh)
#pragma unroll
      for (int ks = 0; ks < 2; ++ks)
        qf[hh][ks] = *(const bf16x8*)(p.qn + (tokbase + myt) * DM + (hA + hh) * 64 + ks * 32 + fq * 8);
    float gates[2][3];
#pragma unroll
    for (int hh = 0; hh < 2; ++hh)
#pragma unroll
      for (int r = 0; r < 3; ++r) gates[hh][r] = p.gbuf[(tokbase + myt) * 48 + (hA + hh) * 3 + r];
    f32x4 out[2][4];
#pragma unroll
    for (int hh = 0; hh < 2; ++hh)
#pragma unroll
      for (int dm = 0; dm < 4; ++dm) {
        const uint2 pv = *(const uint2*)(p.ocp + (tokbase + myt) * DM + (hA + hh) * 64 + dm * 16 + fq * 4);
        out[hh][dm] = (f32x4){bf2f((u16)(pv.x & 0xffff)), bf2f((u16)(pv.x >> 16)), bf2f((u16)(pv.y & 0xffff)), bf2f((u16)(pv.y >> 16))};
      }

    NsaState st;
    f32x4 s[2][4];
    const unsigned long long* mskp = p.msk + (size_t)(b * 2 + g) * SEQ + t0;
    const unsigned long long mymask = mskp[fr];
    unsigned long long um = 0;
#pragma unroll
    for (int q = 0; q < 16; ++q) um |= mskp[q];
    nsa_reset(st);
    const u16* ksb = p.ksb + tokbase * 128 + g * 64;
    const u16* vsb = p.vsT + (size_t)(b * 2 + g) * 64 * SEQ;
    while (um) {
      const int n = __ffsll((long long)um) - 1;
      um &= um - 1;
      __syncthreads();
      load_tile64(sK, ksb + (size_t)n * 64 * 128, 128, true);
      load_tile64(sV, vsb + n * 64, SEQ, false);
      __syncthreads();
      nsa_qk(s, sK, qf, fr, fq);
      unsigned vmask = 0;
      const bool selq = (mymask >> n) & 1ull;
#pragma unroll
      for (int mt = 0; mt < 4; ++mt)
#pragma unroll
        for (int j = 0; j < 4; ++j) {
          const int key = n * 64 + 32 * (mt >> 1) + 8 * fq + 4 * (mt & 1) + j;
          vmask |= ((selq && key <= myt) ? 1u : 0u) << (mt * 4 + j);
        }
      nsa_online_step(st, s, vmask, sV, fr, fq);
    }
    {
      const float gg[2] = {gates[0][1], gates[1][1]};
      nsa_finish(st, out, gg);
    }
    nsa_reset(st);
    const u16* kwb = p.kwb + tokbase * 128 + g * 64;
    const u16* vwb = p.vwT + (size_t)(b * 2 + g) * 64 * SEQ;
    const int kt_lo = (t0 >= 511) ? ((t0 - 511) >> 6) : 0, kt_hi = t0 >> 6;
    for (int kt = kt_lo; kt <= kt_hi; ++kt) {
      __syncthreads();
      load_tile64(sK, kwb + (size_t)kt * 64 * 128, 128, true);
      load_tile64(sV, vwb + kt * 64, SEQ, false);
      __syncthreads();
      nsa_qk(s, sK, qf, fr, fq);
      unsigned vmask = 0;
#pragma unroll
      for (int mt = 0; mt < 4; ++mt)
#pragma unroll
        for (int j = 0; j < 4; ++j) {
          const int key = kt * 64 + 32 * (mt >> 1) + 8 * fq + 4 * (mt & 1) + j;
          const int diff = myt - key;
          vmask |= ((diff >= 0 && diff < 512) ? 1u : 0u) << (mt * 4 + j);
        }
      nsa_online_step(st, s, vmask, sV, fr, fq);
    }
    {
      const float gg[2] = {gates[0][2], gates[1][2]};
      nsa_finish(st, out, gg);
    }
#pragma unroll
    for (int hh = 0; hh < 2; ++hh)
#pragma unroll
      for (int dm = 0; dm < 4; ++dm)
        *(uint2*)(p.ob + (tokbase + myt) * DM + (hA + hh) * 64 + dm * 16 + fq * 4) = pack4(out[hh][dm]);
    __syncthreads();
  }
}

__device__ __forceinline__ void run_phase(const Params& p, const int ph, u16* sm) {
  switch (ph) {
    case 0: phase_prep(p, sm); break;
    case 1: phase_sba_qkv(p, sm); break;
    case 2: phase_sba_attn(p, sm); break;
    case 3: phase_proj_resid(p.ob, DM, DM, p.wt_sba_out, p.x, p.out, 0, NTOK, sm); break;
    case 4: phase_rmsnorm(p.out, p.norm_ffn, p.hn); break;
    case 5: phase_ffn_up(p, 0, 0, sm); break;
    case 6: phase_conv_act(p, 0); break;
    case 7: phase_proj_resid(p.act, DFF, DFF, p.wt_down0, p.out, p.out, 0, HALF_TOK, sm); break;
    case 8: phase_ffn_up(p, 0, 1, sm); break;
    case 9: phase_conv_act(p, 0); break;
    case 10: phase_proj_resid(p.act, DFF, DFF, p.wt_down0, p.out, p.out, HALF_TOK, HALF_TOK, sm); break;
    case 11: phase_rmsnorm(p.out, p.norm_mix + DM, p.hn); break;
    case 12: phase_nsa_in(p, sm); break;
    case 13: phase_compress(p, sm); break;
    case 14: phase_nsa_cmp(p, sm); break;
    case 15: phase_nsa_sw(p, sm); break;
    case 16: phase_proj_resid(p.ob, DM, DM, p.wt_nsa_out, p.out, p.out, 0, NTOK, sm); break;
    case 17: phase_rmsnorm(p.out, p.norm_ffn + DM, p.hn); break;
    case 18: phase_ffn_up(p, 1, 0, sm); break;
    case 19: phase_conv_act(p, 1); break;
    case 20: phase_proj_resid(p.act, DFF, DFF, p.wt_down1, p.out, p.out, 0, HALF_TOK, sm); break;
    case 21: phase_ffn_up(p, 1, 1, sm); break;
    case 22: phase_conv_act(p, 1); break;
    case 23: phase_proj_resid(p.act, DFF, DFF, p.wt_down1, p.out, p.out, HALF_TOK, HALF_TOK, sm); break;
    case 24: phase_final_norm(p.out, p.norm_final); break;
    default: break;
  }
}

#define PHASE_SEQ(n) if (p.phase_lo <= (n) && (n) <= p.phase_hi) { run_phase(p, (n), sm); if ((n) < p.phase_hi) cg::this_grid().sync(); }
__global__ void __launch_bounds__(256, 2) hybrid_megakernel(KArgs ka) {
  const Params p = make_params(ka);
  __shared__ __attribute__((aligned(16))) u16 sm[SMEM_BYTES / 2];
  PHASE_SEQ(0) PHASE_SEQ(1) PHASE_SEQ(2) PHASE_SEQ(3) PHASE_SEQ(4) PHASE_SEQ(5) PHASE_SEQ(6) PHASE_SEQ(7)
  PHASE_SEQ(8) PHASE_SEQ(9) PHASE_SEQ(10) PHASE_SEQ(11) PHASE_SEQ(12) PHASE_SEQ(13) PHASE_SEQ(14) PHASE_SEQ(15)
  PHASE_SEQ(16) PHASE_SEQ(17) PHASE_SEQ(18) PHASE_SEQ(19) PHASE_SEQ(20) PHASE_SEQ(21) PHASE_SEQ(22) PHASE_SEQ(23)
  PHASE_SEQ(24)
}

extern "C" void kernel_launch(void* const* d_in, const int* in_sizes, int n_in, void* d_out, int out_size, void* d_ws,
                              size_t ws_size, hipStream_t stream) {
  KArgs p;
  memset(&p, 0, sizeof(p));
  for (int i = 0; i < 19; ++i) p.in[i] = d_in[i];
  p.out = (float*)d_out;
  p.ws = (char*)d_ws;
  if (ws_size < WS_NEEDED) fprintf(stderr, "workspace too small: %zu < %zu\n", ws_size, (size_t)WS_NEEDED);

  static int grid_blocks = 0;
  if (!grid_blocks) {
    int dev = 0, cus = 0, per_cu = 0;
    hipGetDevice(&dev);
    hipDeviceGetAttribute(&cus, hipDeviceAttributeMultiprocessorCount, dev);
    hipOccupancyMaxActiveBlocksPerMultiprocessor(&per_cu, hybrid_megakernel, 256, 0);
    if (per_cu > 2) per_cu = 2;
    if (per_cu < 1) per_cu = 1;
    grid_blocks = cus * per_cu;
  }
#if ONE_LAUNCH
  p.phase_lo = 0; p.phase_hi = NPHASE - 1;
  void* args[] = {&p};
  hipError_t e = hipLaunchCooperativeKernel((void*)hybrid_megakernel, dim3(grid_blocks), dim3(256), args, 0, stream);
  if (e != hipSuccess) fprintf(stderr, "cooperative launch failed: %s (grid %d)\n", hipGetErrorString(e), grid_blocks);
#else
  for (int ph = 0; ph < NPHASE; ++ph) {
    p.phase_lo = ph; p.phase_hi = ph;
    hipLaunchKernelGGL(hybrid_megakernel, dim3(grid_blocks), dim3(256), 0, stream, p);
  }
#endif
}
```

```cpp
#include <hip/hip_runtime.h>
#include <hip/hip_cooperative_groups.h>
#include <stdint.h>
#include <string.h>
#include <stdio.h>
namespace cg = cooperative_groups;

#ifndef ONE_LAUNCH
#define ONE_LAUNCH 1
#endif

typedef unsigned short u16;
typedef __attribute__((ext_vector_type(8))) short bf16x8;
typedef __attribute__((ext_vector_type(4))) float f32x4;

constexpr int SEQ = 4096, DM = 1024, NTOK = 8 * 4096, DFF = 2816, NUP = 5632;
constexpr int NSAWP = 2048;
constexpr int HALF_TOK = NTOK / 2;
constexpr int LDSP = 72;
constexpr int NPHASE = 25;
constexpr int SMEM_BYTES = 131072;
constexpr int NTHR = 512;


struct Params {
  const float* x; const int* pos; const float* norm_mix; const float* sba_w_in; const float* sba_w_out;
  const float* nsa_w_in; const float* pe_k; const float* pe_v; const float* ck_w1; const float* ck_w2;
  const float* cv_w1; const float* cv_w2; const float* nsa_w_out; const float* norm_ffn; const float* w_up;
  const float* conv_w; const float* conv_b; const float* w_down; const float* norm_final;
  float* out;
  u16 *wt_sba_in, *wt_sba_out, *wt_nsa_in, *wt_nsa_out, *wt_up0, *wt_up1, *wt_down0, *wt_down1, *wt_ck1, *wt_cv1, *wt_ck2, *wt_cv2;
  float *bpart; float2* rope; unsigned long long* rowss; u16* xb;
  u16* hn;
  u16 *qb, *kb, *vT;
  u16 *qn, *cbuf, *ksb, *kwb, *vsT, *vwT, *kc, *vcT; float* gbuf; unsigned long long* msk; u16* ocp;
  float* ub;
  u16* ob;
  u16* act;
  int phase_lo, phase_hi;
  int pad_;
};

__device__ __forceinline__ u16 f2bf(float f) {
  uint32_t u = __float_as_uint(f);
  u += 0x7fffu + ((u >> 16) & 1u);
  return (u16)(u >> 16);
}
typedef float f32x2_t __attribute__((ext_vector_type(2)));
typedef __bf16 bf16x2_t __attribute__((ext_vector_type(2)));
__device__ __forceinline__ uint32_t pack2(float a, float b) {
  f32x2_t v = {a, b};
  bf16x2_t h = __builtin_convertvector(v, bf16x2_t);
  return __builtin_bit_cast(uint32_t, h);
}
__device__ __forceinline__ float bf2f(u16 h) { return __uint_as_float(((uint32_t)h) << 16); }
__device__ __forceinline__ uint2 pack4(f32x4 v) { return make_uint2(pack2(v[0], v[1]), pack2(v[2], v[3])); }
__device__ __forceinline__ f32x4 mfma16(bf16x8 a, bf16x8 b, f32x4 c) {
  return __builtin_amdgcn_mfma_f32_16x16x32_bf16(a, b, c, 0, 0, 0);
}
__device__ __forceinline__ bf16x8 mk_frag(uint32_t a, uint32_t b, uint32_t c, uint32_t d) {
  union { uint4 u; bf16x8 v; } t; t.u = make_uint4(a, b, c, d); return t.v;
}

#define XCD_BAR_WORDS 3456
constexpr size_t al256(size_t x) { return (x + 255) & ~(size_t)255; }
constexpr size_t MB = 1024 * 1024;
constexpr size_t O_WT_SBA_IN = 0;
constexpr size_t O_WT_SBA_OUT = O_WT_SBA_IN + al256((size_t)3072 * 1024 * 2);
constexpr size_t O_WT_NSA_IN = O_WT_SBA_OUT + al256((size_t)1024 * 1024 * 2);
constexpr size_t O_WT_NSA_OUT = O_WT_NSA_IN + al256((size_t)NSAWP * 1024 * 2);
constexpr size_t O_WT_UP0 = O_WT_NSA_OUT + al256((size_t)1024 * 1024 * 2);
constexpr size_t O_WT_UP1 = O_WT_UP0 + al256((size_t)NUP * 1024 * 2);
constexpr size_t O_WT_DOWN0 = O_WT_UP1 + al256((size_t)NUP * 1024 * 2);
constexpr size_t O_WT_DOWN1 = O_WT_DOWN0 + al256((size_t)1024 * DFF * 2);
constexpr size_t O_WT_CK1 = O_WT_DOWN1 + al256((size_t)1024 * DFF * 2);
constexpr size_t O_WT_CV1 = O_WT_CK1 + al256((size_t)128 * 2048 * 2);
constexpr size_t O_WT_CK2 = O_WT_CV1 + al256((size_t)128 * 2048 * 2);
constexpr size_t O_WT_CV2 = O_WT_CK2 + al256((size_t)64 * 128 * 2);
constexpr size_t O_BIAS1K = O_WT_CV2 + al256((size_t)64 * 128 * 2);
constexpr size_t O_BIAS1V = O_BIAS1K + 512;
constexpr size_t O_ROPE = O_BIAS1V + 512;
constexpr size_t O_HN = O_ROPE + al256((size_t)NTOK * 32 * 8);
constexpr size_t O_BIG = O_HN + al256((size_t)NTOK * DM * 2);
constexpr size_t O_R2 = O_BIG + 192 * MB;
constexpr size_t O_BAR = O_R2 + al256((size_t)HALF_TOK * DFF * 2);
constexpr size_t O_BPART = O_BAR + al256((size_t)XCD_BAR_WORDS * 4);
constexpr size_t O_ROWSS = O_BPART + al256((size_t)2 * 8 * 128 * 4);
constexpr size_t O_XB = O_ROWSS + al256((size_t)3 * NTOK * 8);
constexpr size_t WS_NEEDED = O_XB + al256((size_t)NTOK * DM * 2);
constexpr size_t O_QN = O_BIG;
constexpr size_t O_CBUF = O_QN + al256((size_t)NTOK * DM * 2);
constexpr size_t O_KSB = O_CBUF + al256((size_t)NTOK * 256 * 2);
constexpr size_t O_KWB = O_KSB + al256((size_t)NTOK * 128 * 2);
constexpr size_t O_VST = O_KWB + al256((size_t)NTOK * 128 * 2);
constexpr size_t O_VWT = O_VST + al256((size_t)16 * 64 * SEQ * 2);
constexpr size_t O_KC = O_VWT + al256((size_t)16 * 64 * SEQ * 2);
constexpr size_t O_VCT = O_KC + al256((size_t)16 * 256 * 64 * 2);
constexpr size_t O_GBUF = O_VCT + al256((size_t)16 * 64 * 256 * 2);
constexpr size_t O_MSK = O_GBUF + al256((size_t)NTOK * 48 * 4);
static_assert(O_MSK + (size_t)16 * SEQ * 8 <= O_R2, "NSA buffers overflow BIG");
static_assert((size_t)NTOK * DFF * 2 <= 192 * MB, "act overflow");
static_assert((size_t)512 * 4 * NUP * 4 <= (size_t)HALF_TOK * DFF * 2, "ub overflow");

struct KArgs {
  const void* in[19];
  float* out;
  char* ws;
  int phase_lo, phase_hi;
};

__device__ __forceinline__ Params make_params(const KArgs& k) {
  Params p;
  p.x = (const float*)k.in[0]; p.pos = (const int*)k.in[1]; p.norm_mix = (const float*)k.in[2];
  p.sba_w_in = (const float*)k.in[3]; p.sba_w_out = (const float*)k.in[4]; p.nsa_w_in = (const float*)k.in[5];
  p.pe_k = (const float*)k.in[6]; p.pe_v = (const float*)k.in[7]; p.ck_w1 = (const float*)k.in[8];
  p.ck_w2 = (const float*)k.in[9]; p.cv_w1 = (const float*)k.in[10]; p.cv_w2 = (const float*)k.in[11];
  p.nsa_w_out = (const float*)k.in[12]; p.norm_ffn = (const float*)k.in[13]; p.w_up = (const float*)k.in[14];
  p.conv_w = (const float*)k.in[15]; p.conv_b = (const float*)k.in[16]; p.w_down = (const float*)k.in[17];
  p.norm_final = (const float*)k.in[18];
  p.out = k.out;
  char* ws = k.ws;
  p.wt_sba_in = (u16*)(ws + O_WT_SBA_IN); p.wt_sba_out = (u16*)(ws + O_WT_SBA_OUT);
  p.wt_nsa_in = (u16*)(ws + O_WT_NSA_IN); p.wt_nsa_out = (u16*)(ws + O_WT_NSA_OUT);
  p.wt_up0 = (u16*)(ws + O_WT_UP0); p.wt_up1 = (u16*)(ws + O_WT_UP1);
  p.wt_down0 = (u16*)(ws + O_WT_DOWN0); p.wt_down1 = (u16*)(ws + O_WT_DOWN1);
  p.wt_ck1 = (u16*)(ws + O_WT_CK1); p.wt_cv1 = (u16*)(ws + O_WT_CV1);
  p.wt_ck2 = (u16*)(ws + O_WT_CK2); p.wt_cv2 = (u16*)(ws + O_WT_CV2);
  p.bpart = (float*)(ws + O_BPART); p.rowss = (unsigned long long*)(ws + O_ROWSS); p.xb = (u16*)(ws + O_XB);
  p.rope = (float2*)(ws + O_ROPE);
  p.hn = (u16*)(ws + O_HN);
  p.qb = (u16*)(ws + O_BIG); p.kb = (u16*)(ws + O_BIG + 64 * MB); p.vT = (u16*)(ws + O_BIG + 128 * MB);
  p.qn = (u16*)(ws + O_QN); p.cbuf = (u16*)(ws + O_CBUF); p.ksb = (u16*)(ws + O_KSB); p.kwb = (u16*)(ws + O_KWB);
  p.vsT = (u16*)(ws + O_VST); p.vwT = (u16*)(ws + O_VWT); p.kc = (u16*)(ws + O_KC); p.vcT = (u16*)(ws + O_VCT);
  p.gbuf = (float*)(ws + O_GBUF); p.msk = (unsigned long long*)(ws + O_MSK);
  p.ocp = p.hn;
  p.act = (u16*)(ws + O_BIG);
  p.ob = (u16*)(ws + O_R2); p.ub = (float*)(ws + O_R2);
  p.phase_lo = k.phase_lo; p.phase_hi = k.phase_hi; p.pad_ = 0;
  return p;
}


#define LAS __attribute__((address_space(3)))
__device__ __forceinline__ unsigned xb_ld(unsigned* p)              { return __hip_atomic_load(p, __ATOMIC_RELAXED, __HIP_MEMORY_SCOPE_AGENT); }
__device__ __forceinline__ unsigned xb_add(unsigned* p, unsigned v) { return __hip_atomic_fetch_add(p, v, __ATOMIC_RELAXED, __HIP_MEMORY_SCOPE_AGENT); }
#define XB_XCNT(j)  (256  + 64 * (j))
#define XB_XSUB(j)  (1280 + 64 * (j))
#define XB_XGEN(j)  (2304 + 64 * (j))
#define XB_TOP      3328
#define XB_TOPGEN   3392
__device__ __forceinline__ unsigned xb_xcc_id() { return (unsigned)__builtin_amdgcn_s_getreg((3 << 11) | 20) & 0xFu; }
#define XB_SPIN(cond) do { unsigned _sp = 0; while (cond) { __builtin_amdgcn_s_sleep(1); if (++_sp > (1u << 24)) break; } } while (0)
__device__ __forceinline__ void xb_post(unsigned* bar) { (void)xb_add(&bar[XB_XCNT(xb_xcc_id())], 1u); }
__device__ __forceinline__ void xb_census(unsigned* bar, volatile LAS unsigned* st) {
  const unsigned x = xb_xcc_id();
  unsigned cnt = 0u, mine = 1u;
#pragma unroll 1
  for (unsigned j = 0; j < 16; ++j) { const unsigned c = xb_ld(&bar[XB_XCNT(j)]); cnt += (c > 0u) ? 1u : 0u; if (j == x) mine = c; }
  st[0] = mine > 0u ? mine : 1u; st[1] = cnt > 0u ? cnt : 1u; st[2] = x;
}
__device__ __forceinline__ void grid_barrier(unsigned* bar, volatile LAS unsigned* st, unsigned k) {
  asm volatile("s_waitcnt vmcnt(0)" ::: "memory");
  __syncthreads();
  if (threadIdx.x == 0) {
    __builtin_amdgcn_s_waitcnt(0);
    const unsigned nloc = st[0], nx = st[1], x = st[2];
    const unsigned old = xb_add(&bar[XB_XSUB(x)], 1u);
    if (old + 1u == (k + 1u) * nloc) {
      __builtin_amdgcn_fence(__ATOMIC_RELEASE, "agent");
      asm volatile("s_waitcnt vmcnt(0)" ::: "memory");
      const unsigned og = xb_add(&bar[XB_TOP], 1u);
      if (og + 1u == (k + 1u) * nx) xb_add(&bar[XB_TOPGEN], 1u);
      else XB_SPIN(xb_ld(&bar[XB_TOPGEN]) == k);
      __builtin_amdgcn_fence(__ATOMIC_ACQUIRE, "agent");
      xb_add(&bar[XB_XGEN(x)], 1u);
      asm volatile("s_waitcnt vmcnt(0)" ::: "memory");
    } else {
      XB_SPIN(xb_ld(&bar[XB_XGEN(x)]) == k);
      __builtin_amdgcn_fence(__ATOMIC_ACQUIRE, "agent");
      asm volatile("s_waitcnt vmcnt(0)" ::: "memory");
    }
  }
  __syncthreads();
}

__device__ __forceinline__ void transpose_tile2(const float* tsrc, u16* tdst, int tK, int tN, int tNpad, int tile, u16* sm, const bool rp0 = false, const bool rp1 = false, const bool upperm = false, const float* gk = nullptr) {
  const int nNt = tNpad >> 6;
  const int tid = threadIdx.x & 255;
  const int c4 = tid & 15, r = tid >> 4;
  float4 v[2][4];
  int k0s[2], n0s[2];
#pragma unroll
  for (int t = 0; t < 2; ++t) {
    const int kt = (tile + t) / nNt, nt = (tile + t) - kt * nNt;
    k0s[t] = kt * 64; n0s[t] = nt * 64;
#pragma unroll
    for (int i = 0; i < 4; ++i) {
      const int nsrc0 = upperm ? (((n0s[t] >> 7) & 1) * DFF + 128 * (n0s[t] >> 8) + (n0s[t] & 127)) : n0s[t];
      const int k = r + 16 * i, n = nsrc0 + c4 * 4;
      v[t][i] = make_float4(0.f, 0.f, 0.f, 0.f);
      if (n < tN) v[t][i] = *(const float4*)(tsrc + (size_t)(k0s[t] + k) * tN + n);
      if (gk) { const float gs = gk[k0s[t] + k]; v[t][i].x *= gs; v[t][i].y *= gs; v[t][i].z *= gs; v[t][i].w *= gs; }
    }
  }
#pragma unroll
  for (int t = 0; t < 2; ++t)
#pragma unroll
    for (int i = 0; i < 4; ++i) {
      const int k = r + 16 * i;
      u16* d = sm + t * 64 * LDSP;
      const uint32_t p01 = pack2(v[t][i].x, v[t][i].y), p23 = pack2(v[t][i].z, v[t][i].w);
      d[(c4 * 4 + 0) * LDSP + k] = (u16)(p01 & 0xffff);
      d[(c4 * 4 + 1) * LDSP + k] = (u16)(p01 >> 16);
      d[(c4 * 4 + 2) * LDSP + k] = (u16)(p23 & 0xffff);
      d[(c4 * 4 + 3) * LDSP + k] = (u16)(p23 >> 16);
    }
  __syncthreads();
  const int c8 = tid & 7, rn = tid >> 3;
#pragma unroll
  for (int t = 0; t < 2; ++t) {
    const bool ropeperm = t ? rp1 : rp0;
#pragma unroll
    for (int i = 0; i < 2; ++i) {
      const int n = rn + 32 * i;
      const int nsrc = ropeperm ? (16 * (n >> 5) + (n & 15) + 32 * ((n >> 4) & 1)) : n;
      const uint4 w = *(const uint4*)(sm + t * 64 * LDSP + nsrc * LDSP + c8 * 8);
      *(uint4*)(tdst + (size_t)(n0s[t] + n) * tK + k0s[t] + c8 * 8) = w;
    }
  }
  __syncthreads();
}

__device__ __forceinline__ void rmsnorm_row_bf16(const float* x, const float* g, u16* out, int row, int lane) {
  const float4* xr = (const float4*)(x + (size_t)row * DM);
  float4 v[4]; float ss = 0.f;
#pragma unroll
  for (int i = 0; i < 4; ++i) { v[i] = xr[lane + 64 * i]; ss += v[i].x * v[i].x + v[i].y * v[i].y + v[i].z * v[i].z + v[i].w * v[i].w; }
#pragma unroll
  for (int off = 32; off >= 1; off >>= 1) ss += __shfl_xor(ss, off);
  const float rs = rsqrtf(ss * (1.f / DM) + 1e-6f);
#pragma unroll
  for (int i = 0; i < 4; ++i) {
    float4 gg = ((const float4*)g)[lane + 64 * i];
    uint2 pk = make_uint2(pack2(v[i].x * rs * gg.x, v[i].y * rs * gg.y), pack2(v[i].z * rs * gg.z, v[i].w * rs * gg.w));
    *(uint2*)(out + (size_t)row * DM + (lane + 64 * i) * 4) = pk;
  }
}

__device__ __forceinline__ void rmsnorm_2rows_bf16(const float* x, const float* g, u16* out, int row, int lane) {
  const float4* xr = (const float4*)(x + (size_t)row * DM);
  float4 v[2][4]; float ss[2] = {0.f, 0.f};
#pragma unroll
  for (int t = 0; t < 2; ++t)
#pragma unroll
    for (int i = 0; i < 4; ++i) v[t][i] = xr[t * (DM / 4) + lane + 64 * i];
#pragma unroll
  for (int t = 0; t < 2; ++t)
#pragma unroll
    for (int i = 0; i < 4; ++i) ss[t] += v[t][i].x * v[t][i].x + v[t][i].y * v[t][i].y + v[t][i].z * v[t][i].z + v[t][i].w * v[t][i].w;
#pragma unroll
  for (int off = 32; off >= 1; off >>= 1) { ss[0] += __shfl_xor(ss[0], off); ss[1] += __shfl_xor(ss[1], off); }
#pragma unroll
  for (int t = 0; t < 2; ++t) {
    const float rs = rsqrtf(ss[t] * (1.f / DM) + 1e-6f);
#pragma unroll
    for (int i = 0; i < 4; ++i) {
      const float4 gg = ((const float4*)g)[lane + 64 * i];
      const uint2 pk = make_uint2(pack2(v[t][i].x * rs * gg.x, v[t][i].y * rs * gg.y), pack2(v[t][i].z * rs * gg.z, v[t][i].w * rs * gg.w));
      *(uint2*)(out + (size_t)(row + t) * DM + (lane + 64 * i) * 4) = pk;
    }
  }
}

__device__ __forceinline__ void phase_rmsnorm(const float* x, const float* g, u16* out) {
  const int lane = threadIdx.x & 63, wave = threadIdx.x >> 6;
  for (int it = blockIdx.x; it < NTOK / 8; it += gridDim.x) rmsnorm_row_bf16(x, g, out, it * 8 + wave, lane);
}

__device__ __forceinline__ void phase_final_norm(float* x, const float* g) {
  const int lane = threadIdx.x & 63, wave = threadIdx.x >> 6;
  for (int it = blockIdx.x; it < NTOK / 8; it += gridDim.x) {
    int row = it * 8 + wave;
    float4* xr = (float4*)(x + (size_t)row * DM);
    float4 v[4]; float ss = 0.f;
#pragma unroll
    for (int i = 0; i < 4; ++i) { v[i] = xr[lane + 64 * i]; ss += v[i].x * v[i].x + v[i].y * v[i].y + v[i].z * v[i].z + v[i].w * v[i].w; }
#pragma unroll
    for (int off = 32; off >= 1; off >>= 1) ss += __shfl_xor(ss, off);
    const float rs = rsqrtf(ss * (1.f / DM) + 1e-6f);
#pragma unroll
    for (int i = 0; i < 4; ++i) {
      float4 gg = ((const float4*)g)[lane + 64 * i];
      xr[lane + 64 * i] = make_float4(v[i].x * rs * gg.x, v[i].y * rs * gg.y, v[i].z * rs * gg.z, v[i].w * rs * gg.w);
    }
  }
}

__device__ __forceinline__ void phase_prep(const Params& p, u16* sm) {
  const int tid = threadIdx.x & 255, sub = threadIdx.x >> 8;
  sm += sub * 2 * 64 * LDSP;
  const int n_tr = (768 + 256 + 512 + 256 + 1408 * 2 + 704 * 2 + 64 * 2 + 2 * 2) / 2;
  const int n_rope = NTOK * 32 / 256;
  const int n_bias = 16;
  const int n_norm = NTOK / 8;
  const int total = n_tr + n_rope + n_bias + n_norm;
  for (int i = blockIdx.x * NTHR + threadIdx.x; i < 3 * NTOK; i += gridDim.x * NTHR) p.rowss[i] = 0ull;
  for (int it = 2 * blockIdx.x + sub; it < total; it += 2 * gridDim.x) {
    if (it < n_tr) {
      const int tl = it * 2;
      constexpr int T1 = 768, T2 = T1 + 256, T3 = T2 + 512, T4 = T3 + 256, T5 = T4 + 1408, T6 = T5 + 1408,
                    T7 = T6 + 704, T8 = T7 + 704, T9 = T8 + 64, T10 = T9 + 64, T11 = T10 + 2;
      if (tl < T1) { transpose_tile2(p.sba_w_in, p.wt_sba_in, 1024, 3072, 3072, tl - (0), sm); }
      else if (tl < T2) { transpose_tile2(p.sba_w_out, p.wt_sba_out, 1024, 1024, 1024, tl - (T1), sm); }
      else if (tl < T3) {
        const int nt0 = (tl - T2) & 31, nt1 = nt0 + 1;
        const bool rp0 = (nt0 < 16) || (nt0 == 20) || (nt0 == 21) || (nt0 == 24) || (nt0 == 25);
        const bool rp1 = (nt1 < 16) || (nt1 == 20) || (nt1 == 21) || (nt1 == 24) || (nt1 == 25);
        transpose_tile2(p.nsa_w_in, p.wt_nsa_in, 1024, 1840, NSAWP, tl - (T2), sm, rp0, rp1, false, p.norm_mix + DM);
      }
      else if (tl < T4) { transpose_tile2(p.nsa_w_out, p.wt_nsa_out, 1024, 1024, 1024, tl - (T3), sm); }
      else if (tl < T5) { transpose_tile2(p.w_up, p.wt_up0, 1024, NUP, NUP, tl - (T4), sm, false, false, true, p.norm_ffn); }
      else if (tl < T6) { transpose_tile2(p.w_up + (size_t)1024 * NUP, p.wt_up1, 1024, NUP, NUP, tl - (T5), sm, false, false, true, p.norm_ffn + DM); }
      else if (tl < T7) { transpose_tile2(p.w_down, p.wt_down0, DFF, 1024, 1024, tl - (T6), sm); }
      else if (tl < T8) { transpose_tile2(p.w_down + (size_t)DFF * 1024, p.wt_down1, DFF, 1024, 1024, tl - (T7), sm); }
      else if (tl < T9) { transpose_tile2(p.ck_w1, p.wt_ck1, 2048, 128, 128, tl - (T8), sm); }
      else if (tl < T10) { transpose_tile2(p.cv_w1, p.wt_cv1, 2048, 128, 128, tl - (T9), sm); }
      else if (tl < T11) { transpose_tile2(p.ck_w2, p.wt_ck2, 128, 64, 64, tl - (T10), sm); }
      else { transpose_tile2(p.cv_w2, p.wt_cv2, 128, 64, 64, tl - (T11), sm); }
    } else if (it < n_tr + n_rope) {
      int idx = (it - n_tr) * 256 + tid;
      int tok = idx >> 5, f = idx & 31;
      float inv = powf(10000.f, -(float)f / 32.f);
      float ang = (float)p.pos[tok] * inv;
      p.rope[idx] = make_float2(cosf(ang), sinf(ang));
    } else if (it < n_tr + n_rope + n_bias) {
      const int bi = it - n_tr - n_rope, which = bi >> 3, ch = bi & 7;
      const float* pe = which ? p.pe_v : p.pe_k;
      const float* w1 = which ? p.cv_w1 : p.ck_w1;
      const int n = tid & 127, hf = tid >> 7;
      const int kk0 = ch * 256 + hf * 128;
      float s0 = 0.f;
#pragma unroll 8
      for (int kk = 0; kk < 128; ++kk) s0 += pe[kk0 + kk] * w1[(size_t)(kk0 + kk) * 128 + n];
      float* red = (float*)sm;
      if (hf) red[n] = s0;
      __syncthreads();
      if (!hf) p.bpart[(which * 8 + ch) * 128 + n] = s0 + red[n];
      __syncthreads();
    } else {
      const int r = (it - n_tr - n_rope - n_bias) * 8 + (tid >> 6) * 2;
      rmsnorm_2rows_bf16(p.x, p.norm_mix, p.hn, r, tid & 63);
    }
  }
}

constexpr int PG_BM = 256, PG_BK = 64, PG_HALF = 128, PG_HTB = PG_HALF * PG_BK * 2, PG_NXCD = 8, PG_WGM = 8;
__device__ __forceinline__ int pg_lds_byte(int r, int c) { const int st = (r >> 4) * 2 + (c >> 5), rr = r & 15, cc = c & 31, ob = rr * 64 + cc * 2; return st * 1024 + (ob ^ (((ob >> 9) & 1) << 5)); }
__device__ __forceinline__ void pg_stage_rc(int b, int& R, int& C) { const int st = b / 1024, sb = b % 1024, swz = sb ^ (((sb >> 9) & 1) << 5); R = (st >> 1) * 16 + swz / 64; C = (st & 1) * 32 + (swz % 64) / 2; }
struct Unit { int pm, pn; };
struct Gemm { const u16* A; const u16* Bt; int M, N, K; };
struct StaticOrder {
  int nM, nN, nwg, G, c;
  __device__ void init(int M, int N, int G_, int c_) { nM = M / PG_BM; nN = N / PG_BM; nwg = nM * nN; G = G_; c = c_; }
  __device__ bool next(int i, Unit& u) const {
    const long L = (long)i * G + c; if (L >= nwg) return false;
    int wgid = (int)L; { const int q = nwg / PG_NXCD, r = nwg % PG_NXCD, xcd = wgid % PG_NXCD, off = wgid / PG_NXCD; wgid = (xcd < r ? xcd * (q + 1) : r * (q + 1) + (xcd - r) * q) + off; }
    const int nig = PG_WGM * nN, gid = wgid / nig, fm = gid * PG_WGM, gsz = (nM - fm) < PG_WGM ? (nM - fm) : PG_WGM;
    u.pm = fm + ((wgid % nig) % gsz); u.pn = (wgid % nig) / gsz; return true;
  }
};

template <class Epi>
__device__ __forceinline__ void gemm_phase(LAS unsigned char* lds, const Gemm g, const StaticOrder& S, const Epi& E) {
  const int tid = threadIdx.x, wid = __builtin_amdgcn_readfirstlane(tid >> 6), lane = tid & 63, wr = wid >> 2, wc = wid & 3, fr = lane & 15, fq = lane >> 4;
  const int K = g.K, nt = K / PG_BK;
  unsigned voffA[2];
#pragma unroll
  for (int i = 0; i < 2; ++i) { int R, C; pg_stage_rc(tid * 16 + i * 8192, R, C); voffA[i] = (unsigned)(R * K + C) * 2u; }
  const size_t kstep = (size_t)(PG_BK * 2);
  const size_t hstep = (size_t)PG_HALF * K * 2;
  const size_t tstep = 2 * hstep;
  const unsigned ldsw = (unsigned)wid * 1024u;
  const int aoff = pg_lds_byte(wr * 64 + fr, fq * 8), boff = pg_lds_byte(wc * 32 + fr, fq * 8);
  const unsigned lbase = (unsigned)(__UINTPTR_TYPE__)lds;
  const unsigned aaddr = lbase + (unsigned)aoff, baddr = lbase + 4u * PG_HTB + (unsigned)boff;
#define PG8_SA(b, h) (((b) * 2 + (h)) * PG_HTB)
#define PG8_SB(b, h) ((4 + (b) * 2 + (h)) * PG_HTB)
#define PG8_STAGE(bufoff, gbase, voff) do { _Pragma("unroll") for (int _i = 0; _i < 2; ++_i) \
    __builtin_amdgcn_global_load_lds((const unsigned*)((const char*)(gbase) + (voff)[_i]), (LAS unsigned*)(lds + (bufoff) + ldsw + _i * 8192), 16, 0, 0); } while (0)
#define PG8_DSR(dst, addr, imm) asm volatile("ds_read_b128 %0, %1 offset:%2" : "=v"(dst) : "v"(addr), "n"(imm) : "memory")
#define PG8_LDA(dst, b, h) do { \
    PG8_DSR(dst[0][0], aaddr, ((b) * 2 + (h)) * PG_HTB + 0 * 2048 + 0);    PG8_DSR(dst[0][1], aaddr, ((b) * 2 + (h)) * PG_HTB + 0 * 2048 + 1024); \
    PG8_DSR(dst[1][0], aaddr, ((b) * 2 + (h)) * PG_HTB + 1 * 2048 + 0);    PG8_DSR(dst[1][1], aaddr, ((b) * 2 + (h)) * PG_HTB + 1 * 2048 + 1024); \
    PG8_DSR(dst[2][0], aaddr, ((b) * 2 + (h)) * PG_HTB + 2 * 2048 + 0);    PG8_DSR(dst[2][1], aaddr, ((b) * 2 + (h)) * PG_HTB + 2 * 2048 + 1024); \
    PG8_DSR(dst[3][0], aaddr, ((b) * 2 + (h)) * PG_HTB + 3 * 2048 + 0);    PG8_DSR(dst[3][1], aaddr, ((b) * 2 + (h)) * PG_HTB + 3 * 2048 + 1024); } while (0)
#define PG8_LDB(dst, b, h) do { \
    PG8_DSR(dst[0][0], baddr, ((b) * 2 + (h)) * PG_HTB + 0 * 2048 + 0);    PG8_DSR(dst[0][1], baddr, ((b) * 2 + (h)) * PG_HTB + 0 * 2048 + 1024); \
    PG8_DSR(dst[1][0], baddr, ((b) * 2 + (h)) * PG_HTB + 1 * 2048 + 0);    PG8_DSR(dst[1][1], baddr, ((b) * 2 + (h)) * PG_HTB + 1 * 2048 + 1024); } while (0)
#define PG8_MMA(ai, bj, At, Bt) do { __builtin_amdgcn_s_setprio(1); _Pragma("unroll") for (int m = 0; m < 4; ++m) _Pragma("unroll") for (int n = 0; n < 2; ++n) _Pragma("unroll") for (int k = 0; k < 2; ++k) \
    acc[ai][bj][m][n] = __builtin_amdgcn_mfma_f32_16x16x32_bf16(Bt[n][k], At[m][k], acc[ai][bj][m][n], 0, 0, 0); __builtin_amdgcn_s_setprio(0); } while (0)
#define PG8_WAIT_V(n) asm volatile("s_waitcnt vmcnt(" #n ")" ::: "memory")
#define PG8_WAIT_L(n) asm volatile("s_waitcnt lgkmcnt(" #n ")" ::: "memory")
#define PG8_WAIT_L0 asm volatile("s_waitcnt lgkmcnt(0)" \
    : "+v"(At[0][0]), "+v"(At[0][1]), "+v"(At[1][0]), "+v"(At[1][1]), "+v"(At[2][0]), "+v"(At[2][1]), "+v"(At[3][0]), "+v"(At[3][1]), \
      "+v"(B0[0][0]), "+v"(B0[0][1]), "+v"(B0[1][0]), "+v"(B0[1][1]), "+v"(B1[0][0]), "+v"(B1[0][1]), "+v"(B1[1][0]), "+v"(B1[1][1]) :: "memory")
#define PG8_BAR __builtin_amdgcn_s_barrier()
#define PG8_SCHED __builtin_amdgcn_sched_barrier(0)
  Unit cur, nxt; int ui = 0;
  if (!S.next(0, cur)) return;
  f32x4 acc[2][2][4][2];
#pragma unroll
  for (int a = 0; a < 2; ++a)
#pragma unroll
    for (int b = 0; b < 2; ++b)
#pragma unroll
      for (int m = 0; m < 4; ++m)
#pragma unroll
        for (int n = 0; n < 2; ++n) acc[a][b][m][n] = (f32x4){0.f, 0.f, 0.f, 0.f};
  bf16x8 At[4][2] = {}, B0[2][2] = {}, B1[2][2] = {};
  const char* cA = (const char*)g.A + (size_t)cur.pm * tstep; const char* cB = (const char*)g.Bt + (size_t)cur.pn * tstep;
  PG8_STAGE(PG8_SB(0, 0), cB, voffA); PG8_STAGE(PG8_SA(0, 0), cA, voffA); PG8_STAGE(PG8_SB(0, 1), cB + hstep, voffA); PG8_STAGE(PG8_SA(0, 1), cA + hstep, voffA);
  if (wr == 1) PG8_BAR;
  PG8_WAIT_V(4); PG8_BAR;
  PG8_STAGE(PG8_SB(1, 0), cB + kstep, voffA); PG8_STAGE(PG8_SA(1, 0), cA + kstep, voffA); PG8_STAGE(PG8_SB(1, 1), cB + hstep + kstep, voffA);
  PG8_WAIT_V(6); PG8_BAR;
  for (;;) {
    const bool has_next = S.next(ui + 1, nxt);
    const char* nA = has_next ? (const char*)g.A + (size_t)nxt.pm * tstep : cA; const char* nB = has_next ? (const char*)g.Bt + (size_t)nxt.pn * tstep : cB;
    for (int t = 0; t < nt; t += 2) {
      const bool last = (t == nt - 2);
      const char* a1 = cA + (size_t)(t + 1) * kstep;
      const char* a2 = last ? nA : cA + (size_t)(t + 2) * kstep; const char* b2 = last ? nB : cB + (size_t)(t + 2) * kstep;
      const char* a3 = a2 + kstep; const char* b3 = b2 + kstep;
      PG8_LDB(B0, 0, 0); PG8_SCHED; PG8_LDA(At, 0, 0); PG8_STAGE(PG8_SA(1, 1), a1 + hstep, voffA);
      PG8_WAIT_L(8); PG8_BAR; PG8_WAIT_L0; PG8_MMA(0, 0, At, B0); PG8_BAR; PG8_SCHED;
      PG8_LDB(B1, 0, 1); PG8_STAGE(PG8_SB(0, 0), b2, voffA);
      PG8_BAR; PG8_WAIT_L0; PG8_MMA(0, 1, At, B1); PG8_BAR;
      PG8_LDA(At, 0, 1); PG8_STAGE(PG8_SA(0, 0), a2, voffA);
      PG8_BAR; PG8_WAIT_L0; PG8_MMA(1, 0, At, B0); PG8_BAR; PG8_SCHED;
      PG8_STAGE(PG8_SB(0, 1), b2 + hstep, voffA);
      PG8_WAIT_V(6); PG8_BAR; PG8_MMA(1, 1, At, B1); PG8_BAR;
      PG8_LDB(B0, 1, 0); PG8_SCHED; PG8_LDA(At, 1, 0); PG8_STAGE(PG8_SA(0, 1), a2 + hstep, voffA);
      PG8_WAIT_L(8); PG8_BAR; PG8_WAIT_L0; PG8_MMA(0, 0, At, B0); PG8_BAR; PG8_SCHED;
      PG8_LDB(B1, 1, 1); PG8_STAGE(PG8_SB(1, 0), b3, voffA);
      PG8_BAR; PG8_WAIT_L0; PG8_MMA(0, 1, At, B1); PG8_BAR;
      PG8_LDA(At, 1, 1); PG8_STAGE(PG8_SA(1, 0), a3, voffA);
      PG8_BAR; PG8_WAIT_L0; PG8_MMA(1, 0, At, B0); PG8_BAR; PG8_SCHED;
      PG8_STAGE(PG8_SB(1, 1), b3 + hstep, voffA);
      PG8_WAIT_V(6); PG8_BAR; PG8_MMA(1, 1, At, B1); PG8_BAR;
    }
    E(acc, cur, wr, wc, fr, fq);
    if (!has_next) break;
#pragma unroll
    for (int a = 0; a < 2; ++a)
#pragma unroll
      for (int b = 0; b < 2; ++b)
#pragma unroll
        for (int m = 0; m < 4; ++m)
#pragma unroll
          for (int n = 0; n < 2; ++n) acc[a][b][m][n] = (f32x4){0.f, 0.f, 0.f, 0.f};
    cur = nxt; cA = nA; cB = nB; ++ui;
  }
  PG8_WAIT_V(0);
  if (wr == 0) PG8_BAR;
  PG8_BAR;
#undef PG8_SA
#undef PG8_SB
#undef PG8_STAGE
#undef PG8_LDA
#undef PG8_DSR
#undef PG8_WAIT_L0
#undef PG8_LDB
#undef PG8_MMA
#undef PG8_WAIT_V
#undef PG8_WAIT_L
#undef PG8_BAR
#undef PG8_SCHED
}

typedef f32x4 AccT[2][2][4][2];
#define EPI_ROW(u, ai, m) ((u).pm * 256 + (ai) * 128 + wr * 64 + (m) * 16 + fr)
#define EPI_COL(u, bj, n) ((u).pn * 256 + (bj) * 128 + wc * 32 + (n) * 16 + fq * 4)

template <int CTRL> __device__ __forceinline__ float dpp_quad(float v) { return __int_as_float(__builtin_amdgcn_update_dpp(0, __float_as_int(v), CTRL, 0xf, 0xf, false)); }
__device__ __forceinline__ f32x4 quad_transpose(const f32x4 v, const int i) {
  const bool o1 = (i & 1) != 0, o2 = (i & 2) != 0;
  float x = o1 ? v[0] : v[1], y = o1 ? v[2] : v[3];
  float rx = dpp_quad<0xB1>(x), ry = dpp_quad<0xB1>(y);
  f32x4 u;
  u[0] = o1 ? rx : v[0]; u[1] = o1 ? v[1] : rx; u[2] = o1 ? ry : v[2]; u[3] = o1 ? v[3] : ry;
  x = o2 ? u[0] : u[2]; y = o2 ? u[1] : u[3];
  rx = dpp_quad<0x4E>(x); ry = dpp_quad<0x4E>(y);
  f32x4 w;
  w[0] = o2 ? rx : u[0]; w[1] = o2 ? ry : u[1]; w[2] = o2 ? u[2] : rx; w[3] = o2 ? u[3] : ry;
  return w;
}
struct EpiSbaQkv {
  u16 *qb, *kb, *vT;
  __device__ __forceinline__ void operator()(const AccT& acc, const Unit& u, int wr, int wc, int fr, int fq) const {
    if (u.pn < 8) {
      u16* dst = (u.pn < 4) ? qb : kb;
#pragma unroll
      for (int ai = 0; ai < 2; ++ai)
#pragma unroll
        for (int m = 0; m < 4; ++m) {
          u16* rowp = dst + (size_t)EPI_ROW(u, ai, m) * DM;
#pragma unroll
          for (int bj = 0; bj < 2; ++bj)
#pragma unroll
            for (int n = 0; n < 2; ++n) *(uint2*)(rowp + (EPI_COL(u, bj, n) & 1023)) = pack4(acc[ai][bj][m][n]);
        }
    } else {
#pragma unroll
      for (int ai = 0; ai < 2; ++ai)
#pragma unroll
        for (int m = 0; m < 4; ++m) {
          const int tok = EPI_ROW(u, ai, m), b = tok >> 12, t = tok & 4095;
#pragma unroll
          for (int bj = 0; bj < 2; ++bj)
#pragma unroll
            for (int n = 0; n < 2; ++n) {
              const int c = EPI_COL(u, bj, n) - 2048, h = c >> 6, d = (c & 63) + (fr & 3);
              *(uint2*)(vT + ((size_t)(b * 16 + h) * 64 + d) * SEQ + (t - (fr & 3))) = pack4(quad_transpose(acc[ai][bj][m][n], fr & 3));
            }
        }
    }
  }
};
constexpr float SS_FIX = 16777216.f;
template <bool RF32>
struct EpiResidB {
  const float* resid32; u16* xb; unsigned long long* rowss;
  __device__ __forceinline__ void operator()(const AccT& acc, const Unit& u, int wr, int wc, int fr, int fq) const {
#pragma unroll
    for (int ai = 0; ai < 2; ++ai) {
      f32x4 rv[4][2][2];
#pragma unroll
      for (int m = 0; m < 4; ++m) {
        const size_t ro = (size_t)EPI_ROW(u, ai, m) * DM;
#pragma unroll
        for (int bj = 0; bj < 2; ++bj)
#pragma unroll
          for (int n = 0; n < 2; ++n) {
            if (RF32) rv[m][bj][n] = *(const f32x4*)(resid32 + ro + EPI_COL(u, bj, n));
            else {
              const uint2 pk = *(const uint2*)(xb + ro + EPI_COL(u, bj, n));
              rv[m][bj][n] = (f32x4){__uint_as_float(pk.x << 16), __uint_as_float(pk.x & 0xffff0000u), __uint_as_float(pk.y << 16), __uint_as_float(pk.y & 0xffff0000u)};
            }
          }
      }
#pragma unroll
      for (int m = 0; m < 4; ++m) {
        const int row = EPI_ROW(u, ai, m);
        const size_t ro = (size_t)row * DM;
        float ss = 0.f;
#pragma unroll
        for (int bj = 0; bj < 2; ++bj)
#pragma unroll
          for (int n = 0; n < 2; ++n) {
            const f32x4 x = rv[m][bj][n] + acc[ai][bj][m][n];
            ss += x[0] * x[0] + x[1] * x[1] + x[2] * x[2] + x[3] * x[3];
            *(uint2*)(xb + ro + EPI_COL(u, bj, n)) = pack4(x);
          }
        ss += __shfl_xor(ss, 16);
        ss += __shfl_xor(ss, 32);
        if (fq == 0) atomicAdd(rowss + row, (unsigned long long)(ss * SS_FIX + 0.5f));
      }
    }
  }
};
struct EpiResidLast {
  const u16* xb; float* out;
  __device__ __forceinline__ void operator()(const AccT& acc, const Unit& u, int wr, int wc, int fr, int fq) const {
#pragma unroll
    for (int ai = 0; ai < 2; ++ai) {
      uint2 rv[4][2][2];
#pragma unroll
      for (int m = 0; m < 4; ++m) {
        const size_t ro = (size_t)EPI_ROW(u, ai, m) * DM;
#pragma unroll
        for (int bj = 0; bj < 2; ++bj)
#pragma unroll
          for (int n = 0; n < 2; ++n) rv[m][bj][n] = *(const uint2*)(xb + ro + EPI_COL(u, bj, n));
      }
#pragma unroll
      for (int m = 0; m < 4; ++m) {
        const size_t ro = (size_t)EPI_ROW(u, ai, m) * DM;
#pragma unroll
        for (int bj = 0; bj < 2; ++bj)
#pragma unroll
          for (int n = 0; n < 2; ++n) {
            const uint2 pk = rv[m][bj][n];
            const f32x4 a = acc[ai][bj][m][n];
            *(float4*)(out + ro + EPI_COL(u, bj, n)) = make_float4(__uint_as_float(pk.x << 16) + a[0], __uint_as_float(pk.x & 0xffff0000u) + a[1],
                                                                   __uint_as_float(pk.y << 16) + a[2], __uint_as_float(pk.y & 0xffff0000u) + a[3]);
          }
      }
    }
  }
};
__device__ __forceinline__ float rstd_of(const unsigned long long* rowss, int row) {
  return rsqrtf((float)rowss[row] * (1.f / (SS_FIX * DM)) + 1e-6f);
}
__device__ __forceinline__ float dpp_ror1(float v) { return __int_as_float(__builtin_amdgcn_update_dpp(0, __float_as_int(v), 0x121, 0xf, 0xf, false)); }
__device__ __forceinline__ float dpp_ror2(float v) { return __int_as_float(__builtin_amdgcn_update_dpp(0, __float_as_int(v), 0x122, 0xf, 0xf, false)); }
struct EpiUpConv {
  u16* act; float* ub; const unsigned long long* rowss; const float* cw; const float* cb;
  __device__ __forceinline__ void operator()(const AccT& acc, const Unit& u, int wr, int wc, int fr, int fq) const {
#pragma unroll
    for (int ai = 0; ai < 2; ++ai) {
      float rs[4];
#pragma unroll
      for (int m = 0; m < 4; ++m) rs[m] = rstd_of(rowss, EPI_ROW(u, ai, m));
      const int chunk = 4 * u.pm + 2 * ai + wr;
#pragma unroll
      for (int n = 0; n < 2; ++n) {
        const int f0 = 128 * u.pn + 32 * wc + 16 * n + 4 * fq;
        const int gc = u.pn * 256 + 32 * wc + 16 * n + 4 * fq;
        const f32x4 wg0 = *(const f32x4*)(cw + f0), wg1 = *(const f32x4*)(cw + NUP + f0), wg2 = *(const f32x4*)(cw + 2 * NUP + f0);
        const f32x4 wv0 = *(const f32x4*)(cw + DFF + f0), wv1 = *(const f32x4*)(cw + NUP + DFF + f0), wv2 = *(const f32x4*)(cw + 2 * NUP + DFF + f0);
        const f32x4 bg = *(const f32x4*)(cb + f0), bv = *(const f32x4*)(cb + DFF + f0);
        f32x4 xg[4], xv[4];
#pragma unroll
        for (int m = 0; m < 4; ++m) { xg[m] = acc[ai][0][m][n] * rs[m]; xv[m] = acc[ai][1][m][n] * rs[m]; }
        if (fr < 2) {
          float* d = ub + ((size_t)(chunk * 4 + fr) * NUP + gc);
          *(float4*)d = make_float4(xg[0][0], xg[0][1], xg[0][2], xg[0][3]);
          *(float4*)(d + 128) = make_float4(xv[0][0], xv[0][1], xv[0][2], xv[0][3]);
        }
        if (fr >= 14) {
          float* d = ub + ((size_t)(chunk * 4 + 2 + (fr - 14)) * NUP + gc);
          *(float4*)d = make_float4(xg[3][0], xg[3][1], xg[3][2], xg[3][3]);
          *(float4*)(d + 128) = make_float4(xv[3][0], xv[3][1], xv[3][2], xv[3][3]);
        }
#pragma unroll
        for (int m = 0; m < 4; ++m) {
          f32x4 res;
#pragma unroll
          for (int r = 0; r < 4; ++r) {
            const float g_cur = xg[m][r], v_cur = xv[m][r];
            const f32x4 xgp = xg[m > 0 ? m - 1 : 0], xvp = xv[m > 0 ? m - 1 : 0];
            const float g_pm = (m > 0) ? xgp[r] : 0.f, v_pm = (m > 0) ? xvp[r] : 0.f;
            const float g1 = dpp_ror1((fr == 15) ? g_pm : g_cur), g2 = dpp_ror2((fr >= 14) ? g_pm : g_cur);
            const float v1 = dpp_ror1((fr == 15) ? v_pm : v_cur), v2 = dpp_ror2((fr >= 14) ? v_pm : v_cur);
            const float cg_ = bg[r] + g2 * wg0[r] + g1 * wg1[r] + g_cur * wg2[r];
            const float cv_ = bv[r] + v2 * wv0[r] + v1 * wv1[r] + v_cur * wv2[r];
            res[r] = cg_ * __builtin_amdgcn_rcpf(1.f + __builtin_amdgcn_exp2f(-1.4426950408889634f * cg_)) * cv_;
          }
          if (m > 0 || fr >= 2)
            *(uint2*)(act + (size_t)EPI_ROW(u, ai, m) * DFF + f0) = pack4(res);
        }
      }
    }
  }
};

struct EpiNsaIn {
  u16 *qn, *cbuf, *ksb, *kwb, *vsT, *vwT; float* gbuf; const float2* rope; const unsigned long long* rowss;
  __device__ __forceinline__ void rope_store(const f32x4& x1, const f32x4& x2, int tok, int d1, u16* dst) const {
    const float4 cs01 = *(const float4*)(rope + (size_t)tok * 32 + d1);
    const float4 cs23 = *(const float4*)(rope + (size_t)tok * 32 + d1 + 2);
    const float cc[4] = {cs01.x, cs01.z, cs23.x, cs23.z};
    const float ss[4] = {cs01.y, cs01.w, cs23.y, cs23.w};
    f32x4 o1, o2;
#pragma unroll
    for (int r = 0; r < 4; ++r) { o1[r] = x1[r] * cc[r] - x2[r] * ss[r]; o2[r] = x2[r] * cc[r] + x1[r] * ss[r]; }
    *(uint2*)(dst + d1) = pack4(o1);
    *(uint2*)(dst + d1 + 32) = pack4(o2);
  }
  __device__ __forceinline__ void operator()(const AccT& acc_in, const Unit& u, int wr, int wc, int fr, int fq) const {
    const int d1 = 16 * (wc & 1) + 4 * fq;
#pragma unroll
    for (int ai = 0; ai < 2; ++ai)
#pragma unroll
      for (int m = 0; m < 4; ++m) {
        const int tok = EPI_ROW(u, ai, m);
        const float rs = rstd_of(rowss, tok);
        f32x4 acc[2][2][2];
#pragma unroll
        for (int bj = 0; bj < 2; ++bj)
#pragma unroll
          for (int n = 0; n < 2; ++n) acc[0][bj][n] = acc_in[ai][bj][m][n] * rs;
        if (u.pn < 4) {
#pragma unroll
          for (int bj = 0; bj < 2; ++bj) {
            const int head = 4 * u.pn + 2 * bj + (wc >> 1);
            rope_store(acc[0][bj][0], acc[0][bj][1], tok, d1, qn + (size_t)tok * DM + head * 64);
          }
        } else if (u.pn == 4) {
#pragma unroll
          for (int bj = 0; bj < 2; ++bj)
#pragma unroll
            for (int n = 0; n < 2; ++n) *(uint2*)(cbuf + (size_t)tok * 256 + (EPI_COL(u, bj, n) - 1024)) = pack4(acc[0][bj][n]);
        } else if (u.pn < 7) {
          u16* kdst = (u.pn == 5) ? ksb : kwb;
          u16* vdst = (u.pn == 5) ? vsT : vwT;
          const int gk = wc >> 1;
          rope_store(acc[0][0][0], acc[0][0][1], tok, d1, kdst + (size_t)tok * 128 + gk * 64);
          const int b = tok >> 12, t = tok & 4095;
#pragma unroll
          for (int n = 0; n < 2; ++n) {
            const int d = 32 * (wc & 1) + 16 * n + 4 * fq + (fr & 3);
            *(uint2*)(vdst + ((size_t)(b * 2 + gk) * 64 + d) * SEQ + (t - (fr & 3))) = pack4(quad_transpose(acc[0][1][n], fr & 3));
          }
        } else {
#pragma unroll
          for (int n = 0; n < 2; ++n) {
            const int c = 32 * wc + 16 * n + 4 * fq;
            if (c < 48) {
              const f32x4 a = acc[0][0][n];
              float4 gv;
              gv.x = 1.f / (1.f + __expf(-a[0])); gv.y = 1.f / (1.f + __expf(-a[1]));
              gv.z = 1.f / (1.f + __expf(-a[2])); gv.w = 1.f / (1.f + __expf(-a[3]));
              *(float4*)(gbuf + (size_t)tok * 48 + c) = gv;
            }
          }
        }
      }
  }
};

template <class Epi>
__device__ __forceinline__ void run_gemm(u16* sm, const u16* A, const u16* Bt, int M, int N, int K, const Epi& E) {
  Gemm g; g.A = A; g.Bt = Bt; g.M = M; g.N = N; g.K = K;
  StaticOrder S; S.init(M, N, (int)gridDim.x, (int)blockIdx.x);
  gemm_phase(( LAS unsigned char*)sm, g, S, E);
}

template <class ARowF>
__device__ __forceinline__ void gemm_mainloop(f32x4 (&acc)[4][4], ARowF arow, int a_kstep, const u16* bt, int ldb, int nk, u16* sm) {
  const int tid = threadIdx.x, lane = tid & 63, wave = tid >> 6;
  const int wm = wave >> 1, wn = wave & 1;
  const int lc = tid & 7, lr = tid >> 3;
  const u16* pa[4]; const u16* pb[2];
#pragma unroll
  for (int i = 0; i < 4; ++i) pa[i] = arow(lr + 64 * i) + lc * 8;
#pragma unroll
  for (int i = 0; i < 2; ++i) pb[i] = bt + (size_t)(lr + 64 * i) * ldb + lc * 8;
  u16* sA = sm; u16* sB = sm + 2 * 256 * LDSP;
  uint4 ra[4], rb[2];
#pragma unroll
  for (int i = 0; i < 4; ++i) ra[i] = *(const uint4*)pa[i];
#pragma unroll
  for (int i = 0; i < 2; ++i) rb[i] = *(const uint4*)pb[i];
#pragma unroll
  for (int i = 0; i < 4; ++i) *(uint4*)(sA + (lr + 64 * i) * LDSP + lc * 8) = ra[i];
#pragma unroll
  for (int i = 0; i < 2; ++i) *(uint4*)(sB + (lr + 64 * i) * LDSP + lc * 8) = rb[i];
  __syncthreads();
  const int fr = lane & 15, fq = lane >> 4;
  for (int kt = 0; kt < nk; ++kt) {
    const bool more = (kt + 1 < nk);
    if (more) {
#pragma unroll
      for (int i = 0; i < 4; ++i) ra[i] = *(const uint4*)(pa[i] + (size_t)(kt + 1) * a_kstep);
#pragma unroll
      for (int i = 0; i < 2; ++i) rb[i] = *(const uint4*)(pb[i] + (size_t)(kt + 1) * 64);
    }
    const u16* cA = sA + (kt & 1) * 256 * LDSP + (wm * 64 + fr) * LDSP + fq * 8;
    const u16* cB = sB + (kt & 1) * 128 * LDSP + (wn * 64 + fr) * LDSP + fq * 8;
#pragma unroll
    for (int ks = 0; ks < 2; ++ks) {
      bf16x8 wf[4], xf[4];
#pragma unroll
      for (int i = 0; i < 4; ++i) {
        wf[i] = *(const bf16x8*)(cB + i * 16 * LDSP + ks * 32);
        xf[i] = *(const bf16x8*)(cA + i * 16 * LDSP + ks * 32);
      }
#pragma unroll
      for (int i = 0; i < 4; ++i)
#pragma unroll
        for (int j = 0; j < 4; ++j) acc[i][j] = mfma16(wf[i], xf[j], acc[i][j]);
    }
    if (more) {
      u16* dA = sA + ((kt + 1) & 1) * 256 * LDSP; u16* dB = sB + ((kt + 1) & 1) * 128 * LDSP;
#pragma unroll
      for (int i = 0; i < 4; ++i) *(uint4*)(dA + (lr + 64 * i) * LDSP + lc * 8) = ra[i];
#pragma unroll
      for (int i = 0; i < 2; ++i) *(uint4*)(dB + (lr + 64 * i) * LDSP + lc * 8) = rb[i];
    }
    __syncthreads();
  }
}

__device__ __forceinline__ void zero_acc(f32x4 (&acc)[4][4]) {
#pragma unroll
  for (int i = 0; i < 4; ++i)
#pragma unroll
    for (int j = 0; j < 4; ++j) acc[i][j] = (f32x4){0.f, 0.f, 0.f, 0.f};
}

__device__ __forceinline__ void phase_ffn_fix(const Params& p, int layer) {
  const float* cw = p.conv_w + (size_t)layer * 3 * NUP;
  const float* cb = p.conv_b + (size_t)layer * NUP;
  const int nitems = 512 * 2 * (DFF / 4);
  for (int it = blockIdx.x * NTHR + threadIdx.x; it < nitems; it += gridDim.x * NTHR) {
    const int f4 = it % (DFF / 4), cj = it / (DFF / 4), j = cj & 1, chunk = cj >> 1;
    const int f0 = f4 * 4;
    const int gc = 256 * (f0 >> 7) + (f0 & 127);
    const int t = chunk * 64 + j;
    const bool has_prev = ((chunk & 63) != 0);
    const float* cur = p.ub + (size_t)(chunk * 4) * NUP + gc;
    const float* prv = p.ub + (size_t)((has_prev ? chunk - 1 : chunk) * 4) * NUP + gc;
    const float pmask = has_prev ? 1.f : 0.f;
    const float* r1p = (j == 0) ? prv + (size_t)3 * NUP : cur;
    const float* r2p = (j == 0) ? prv + (size_t)2 * NUP : prv + (size_t)3 * NUP;
    const float m1 = (j == 0) ? pmask : 1.f, m2 = pmask;
    f32x4 g0 = *(const f32x4*)(cur + (size_t)j * NUP), v0 = *(const f32x4*)(cur + (size_t)j * NUP + 128);
    f32x4 g1 = *(const f32x4*)(r1p) * m1, v1 = *(const f32x4*)(r1p + 128) * m1;
    f32x4 g2 = *(const f32x4*)(r2p) * m2, v2 = *(const f32x4*)(r2p + 128) * m2;
    const f32x4 wg0 = *(const f32x4*)(cw + f0), wg1 = *(const f32x4*)(cw + NUP + f0), wg2 = *(const f32x4*)(cw + 2 * NUP + f0);
    const f32x4 wv0 = *(const f32x4*)(cw + DFF + f0), wv1 = *(const f32x4*)(cw + NUP + DFF + f0), wv2 = *(const f32x4*)(cw + 2 * NUP + DFF + f0);
    const f32x4 bg = *(const f32x4*)(cb + f0), bv = *(const f32x4*)(cb + DFF + f0);
    const f32x4 cg_ = bg + g2 * wg0 + g1 * wg1 + g0 * wg2;
    const f32x4 cv_ = bv + v2 * wv0 + v1 * wv1 + v0 * wv2;
    const float r0 = cg_[0] / (1.f + __expf(-cg_[0])) * cv_[0], r1 = cg_[1] / (1.f + __expf(-cg_[1])) * cv_[1];
    const float r2 = cg_[2] / (1.f + __expf(-cg_[2])) * cv_[2], r3 = cg_[3] / (1.f + __expf(-cg_[3])) * cv_[3];
    *(uint2*)(p.act + (size_t)t * DFF + f0) = make_uint2(pack2(r0, r1), pack2(r2, r3));
  }
}

__device__ __forceinline__ void phase_compress(const Params& p, u16* sm) {
  const int tid = threadIdx.x, lane = tid & 63, wave = tid >> 6, wm = wave >> 1, wn = wave & 1, fr = lane & 15, fq = lane >> 4;
  for (int tile = blockIdx.x; tile < 32; tile += gridDim.x) {
    const int which = tile & 1, mt = tile >> 1;
    const int m0 = mt * 256;
    const u16* w1t = which ? p.wt_cv1 : p.wt_ck1;
    const u16* w2t = which ? p.wt_cv2 : p.wt_ck2;
    const float* bias = p.bpart + which * 8 * 128;
    f32x4 acc[4][4]; zero_acc(acc);
    const u16* cb = p.cbuf + which * 128;
    gemm_mainloop(acc, [&](int r) {
      int row = m0 + r; int g = row & 1; int bc = row >> 1; int c = bc & 255; int b = bc >> 8;
      if (c > 254) c = 254;
      return cb + ((size_t)b * SEQ + c * 16) * 256 + g * 64;
    }, 256, w1t, 2048, 32, sm);
    u16* sH = sm; u16* sW = sm + 256 * 136;
#pragma unroll
    for (int i = 0; i < 4; ++i) {
      const int n = wn * 64 + i * 16 + fq * 4;
      float bb[4] = {0.f, 0.f, 0.f, 0.f};
#pragma unroll
      for (int c8 = 0; c8 < 8; ++c8) {
        const float4 bv = *(const float4*)(bias + c8 * 128 + n);
        bb[0] += bv.x; bb[1] += bv.y; bb[2] += bv.z; bb[3] += bv.w;
      }
#pragma unroll
      for (int j = 0; j < 4; ++j) {
        const int rl = wm * 64 + j * 16 + fr;
        f32x4 hv;
#pragma unroll
        for (int r = 0; r < 4; ++r) {
          float xv = acc[i][j][r] + bb[r];
          float inner = 0.7978845608028654f * (xv + 0.044715f * xv * xv * xv);
          hv[r] = 0.5f * xv * (1.f + tanhf(inner));
        }
        *(uint2*)(sH + rl * 136 + n) = pack4(hv);
      }
    }
    {
#pragma unroll
      for (int i = 0; i < 2; ++i) {
        int idx = tid + 512 * i; int r = idx >> 4, c = idx & 15;
        *(uint4*)(sW + r * 136 + c * 8) = *(const uint4*)(w2t + r * 128 + c * 8);
      }
    }
    __syncthreads();
    f32x4 o2[4][2];
#pragma unroll
    for (int dm = 0; dm < 4; ++dm) { o2[dm][0] = (f32x4){0.f, 0.f, 0.f, 0.f}; o2[dm][1] = (f32x4){0.f, 0.f, 0.f, 0.f}; }
#pragma unroll
    for (int ks = 0; ks < 4; ++ks) {
      bf16x8 hf[2];
#pragma unroll
      for (int j = 0; j < 2; ++j) hf[j] = *(const bf16x8*)(sH + (wave * 32 + j * 16 + fr) * 136 + ks * 32 + fq * 8);
#pragma unroll
      for (int dm = 0; dm < 4; ++dm) {
        bf16x8 wf = *(const bf16x8*)(sW + (dm * 16 + fr) * 136 + ks * 32 + fq * 8);
#pragma unroll
        for (int j = 0; j < 2; ++j) o2[dm][j] = mfma16(wf, hf[j], o2[dm][j]);
      }
    }
#pragma unroll
    for (int j = 0; j < 2; ++j) {
      const int row = m0 + wave * 32 + j * 16 + fr;
      const int g = row & 1, bc = row >> 1, c = bc & 255, b = bc >> 8;
      const bool valid = (c < 255);
      if (which == 0) {
        const int tok = b * SEQ + (valid ? c : 254) * 16 + 31;
        u16* dst = p.kc + ((size_t)(b * 2 + g) * 256 + c) * 64;
#pragma unroll
        for (int i = 0; i < 2; ++i) {
          const int d = i * 16 + fq * 4;
          const float4 cs01 = *(const float4*)(p.rope + (size_t)tok * 32 + d);
          const float4 cs23 = *(const float4*)(p.rope + (size_t)tok * 32 + d + 2);
          const float cc[4] = {cs01.x, cs01.z, cs23.x, cs23.z};
          const float ss[4] = {cs01.y, cs01.w, cs23.y, cs23.w};
          f32x4 o1, o2v;
#pragma unroll
          for (int r = 0; r < 4; ++r) {
            float x1 = o2[i][j][r], x2 = o2[i + 2][j][r];
            o1[r] = valid ? x1 * cc[r] - x2 * ss[r] : 0.f;
            o2v[r] = valid ? x2 * cc[r] + x1 * ss[r] : 0.f;
          }
          *(uint2*)(dst + d) = pack4(o1);
          *(uint2*)(dst + d + 32) = pack4(o2v);
        }
      } else {
#pragma unroll
        for (int dm = 0; dm < 4; ++dm)
#pragma unroll
          for (int r = 0; r < 4; ++r) {
            const int d = dm * 16 + fq * 4 + r;
            p.vcT[((size_t)(b * 2 + g) * 64 + d) * 256 + c] = valid ? f2bf(o2[dm][j][r]) : (u16)0;
          }
      }
    }
    __syncthreads();
  }
}

__device__ __forceinline__ int rho_row(int k) { return (k & 32) | ((k & 4) << 2) | ((k & 24) >> 1) | (k & 3); }

__device__ __forceinline__ void load_tile64(u16* s, const u16* src, size_t ld, bool perm) {
  const int c = threadIdx.x & 7, r0 = threadIdx.x >> 3;
  uint4 v0 = *(const uint4*)(src + (size_t)r0 * ld + c * 8);
  const int l0 = perm ? rho_row(r0) : r0;
  *(uint4*)(s + l0 * LDSP + c * 8) = v0;
}

__device__ __forceinline__ void phase_sba_attn(const Params& p, u16* sm) {
  const int tid = threadIdx.x, lane = tid & 63, wave = tid >> 6, fr = lane & 15, fq = lane >> 4;
  u16* sK0 = sm; u16* sV0 = sm + 64 * LDSP;
  bf16x8 tri[2], ones;
#pragma unroll
  for (int bb = 0; bb < 2; ++bb) {
    uint32_t w[4];
#pragma unroll
    for (int i2 = 0; i2 < 4; ++i2) {
      const int s_ = 8 * (fr >> 2) + 4 * bb + (fr & 3);
      const int j0 = 8 * fq + 2 * i2, j1 = j0 + 1;
      w[i2] = (j0 > s_ ? 0x3F80u : 0u) | ((j1 > s_ ? 0x3F80u : 0u) << 16);
    }
    tri[bb] = mk_frag(w[0], w[1], w[2], w[3]);
  }
  ones = mk_frag(0x3F803F80u, 0x3F803F80u, 0x3F803F80u, 0x3F803F80u);

  const int ntiles = 128 * 32;
  for (int tile = blockIdx.x; tile < ntiles; tile += gridDim.x) {
    const int qt = 31 - (tile >> 7), bh = tile & 127;
    const int b = bh >> 4, h = bh & 15;
    const int myq = qt * 128 + wave * 16 + fr;
    bf16x8 qf[2];
#pragma unroll
    for (int ks = 0; ks < 2; ++ks) qf[ks] = *(const bf16x8*)(p.qb + ((size_t)b * SEQ + myq) * DM + h * 64 + ks * 32 + fq * 8);
    f32x4 o[4];
#pragma unroll
    for (int dm = 0; dm < 4; ++dm) o[dm] = (f32x4){0.f, 0.f, 0.f, 0.f};
    float carry = 0.f;
    const int pc = tid & 7, pr = tid >> 3, prl = rho_row(pr);
    const u16* kbase = p.kb + ((size_t)b * SEQ) * DM + h * 64 + (size_t)pr * DM + pc * 8;
    const u16* vbase = p.vT + ((size_t)(b * 16 + h) * 64 + pr) * SEQ + pc * 8;
    uint4 rk = *(const uint4*)(kbase + (size_t)(2 * qt + 1) * 64 * DM);
    uint4 rv = *(const uint4*)(vbase + (2 * qt + 1) * 64);
    int buf = 0;
    for (int kt = 2 * qt + 1; kt >= 0; --kt) {
      u16* sK = sK0 + buf * 2 * 64 * LDSP; u16* sV = sV0 + buf * 2 * 64 * LDSP;
      *(uint4*)(sK + prl * LDSP + pc * 8) = rk;
      *(uint4*)(sV + pr * LDSP + pc * 8) = rv;
      if (kt > 0) { rk = *(const uint4*)(kbase + (size_t)(kt - 1) * 64 * DM); rv = *(const uint4*)(vbase + (kt - 1) * 64); }
      buf ^= 1;
      __syncthreads();
      const bool wave_idle = (kt * 64 >= qt * 128 + wave * 16 + 15) || (__ballot(carry >= -150.1f) == 0ull);
      if (!wave_idle) {
      f32x4 s[4];
#pragma unroll
      for (int mt = 0; mt < 4; ++mt) {
        s[mt] = (f32x4){0.f, 0.f, 0.f, 0.f};
#pragma unroll
        for (int ks = 0; ks < 2; ++ks) {
          bf16x8 kf = *(const bf16x8*)(sK + (mt * 16 + fr) * LDSP + ks * 32 + fq * 8);
          s[mt] = mfma16(kf, qf[ks], s[mt]);
        }
      }
      const bool tile_masked = (kt * 64 + 63 >= qt * 128 + wave * 16);
      constexpr float SBA_C = 0.125f * 1.4426950408889634f;
      float L[4][4], lb[4][4];
      unsigned vmask = 0xffffu;
      if (tile_masked) {
        vmask = 0;
#pragma unroll
        for (int mt = 0; mt < 4; ++mt)
#pragma unroll
          for (int j = 0; j < 4; ++j) {
            const float z = s[mt][j] * SBA_C;
            const int key = kt * 64 + 32 * (mt >> 1) + 8 * fq + 4 * (mt & 1) + j;
            const bool valid = key < myq;
            const float e = __builtin_amdgcn_exp2f(-fabsf(z));
            const float sp = fmaxf(z, 0.f) + __builtin_amdgcn_logf(1.f + e);
            L[mt][j] = valid ? -sp : 0.f;
            lb[mt][j] = z - sp;
            vmask |= (valid ? 1u : 0u) << (mt * 4 + j);
          }
      } else {
#pragma unroll
        for (int mt = 0; mt < 4; ++mt)
#pragma unroll
          for (int j = 0; j < 4; ++j) {
            const float z = s[mt][j] * SBA_C;
            const float e = __builtin_amdgcn_exp2f(-fabsf(z));
            const float sp = fmaxf(z, 0.f) + __builtin_amdgcn_logf(1.f + e);
            L[mt][j] = -sp;
            lb[mt][j] = z - sp;
          }
      }
      bf16x8 Lh[2], Ll[2];
#pragma unroll
      for (int k2 = 0; k2 < 2; ++k2) {
        uint32_t hw[4], lw[4];
#pragma unroll
        for (int e2 = 0; e2 < 4; ++e2) {
          const int mt = 2 * k2 + (e2 >> 1), j = (e2 & 1) * 2;
          hw[e2] = pack2(L[mt][j], L[mt][j + 1]);
          const float r0 = L[mt][j] - __uint_as_float(hw[e2] << 16), r1 = L[mt][j + 1] - __uint_as_float(hw[e2] & 0xffff0000u);
          lw[e2] = pack2(r0, r1);
        }
        Lh[k2] = mk_frag(hw[0], hw[1], hw[2], hw[3]);
        Ll[k2] = mk_frag(lw[0], lw[1], lw[2], lw[3]);
      }
      f32x4 cum[4];
#pragma unroll
      for (int ms = 0; ms < 4; ++ms) {
        const int a = ms >> 1, bb = ms & 1;
        f32x4 c = (f32x4){0.f, 0.f, 0.f, 0.f};
        c = mfma16(tri[bb], Lh[a], c);
        c = mfma16(tri[bb], Ll[a], c);
        if (a == 0) { c = mfma16(ones, Lh[1], c); c = mfma16(ones, Ll[1], c); }
        cum[ms] = c;
      }
      float tot = cum[0][0] + L[0][0];
      tot = __shfl(tot, fr);
      bf16x8 pf[2];
#pragma unroll
      for (int k2 = 0; k2 < 2; ++k2) {
        uint32_t pw[4];
#pragma unroll
        for (int e2 = 0; e2 < 4; ++e2) {
          const int mt = 2 * k2 + (e2 >> 1), j = (e2 & 1) * 2;
          float p0 = __builtin_amdgcn_exp2f(lb[mt][j] + cum[mt][j] + carry);
          float p1 = __builtin_amdgcn_exp2f(lb[mt][j + 1] + cum[mt][j + 1] + carry);
          if (tile_masked) {
            p0 = ((vmask >> (mt * 4 + j)) & 1u) ? p0 : 0.f;
            p1 = ((vmask >> (mt * 4 + j + 1)) & 1u) ? p1 : 0.f;
          }
          pw[e2] = pack2(p0, p1);
        }
        pf[k2] = mk_frag(pw[0], pw[1], pw[2], pw[3]);
      }
#pragma unroll
      for (int k2 = 0; k2 < 2; ++k2)
#pragma unroll
        for (int dm = 0; dm < 4; ++dm) {
          bf16x8 vf = *(const bf16x8*)(sV + (dm * 16 + fr) * LDSP + k2 * 32 + fq * 8);
          o[dm] = mfma16(vf, pf[k2], o[dm]);
        }
      carry += tot;
      }
      if (__syncthreads_and(carry < -150.1f)) break;
    }
#pragma unroll
    for (int dm = 0; dm < 4; ++dm)
      *(uint2*)(p.ob + ((size_t)b * SEQ + myq) * DM + h * 64 + dm * 16 + fq * 4) = pack4(o[dm]);
  }
}

struct NsaState {
  f32x4 acc[2][4];
  f32x4 accL[2];
  float m[2], l[2];
};

__device__ __forceinline__ void nsa_qk(f32x4 (&s)[2][4], const u16* sK, const bf16x8 (&qf)[2][2], int fr, int fq) {
#pragma unroll
  for (int mt = 0; mt < 4; ++mt) {
    s[0][mt] = (f32x4){0.f, 0.f, 0.f, 0.f}; s[1][mt] = (f32x4){0.f, 0.f, 0.f, 0.f};
#pragma unroll
    for (int ks = 0; ks < 2; ++ks) {
      bf16x8 kf = *(const bf16x8*)(sK + (mt * 16 + fr) * LDSP + ks * 32 + fq * 8);
      s[0][mt] = mfma16(kf, qf[0][ks], s[0][mt]);
      s[1][mt] = mfma16(kf, qf[1][ks], s[1][mt]);
    }
  }
}

__device__ __forceinline__ void nsa_pv(f32x4 (&acc)[2][4], const u16* sV, const bf16x8 (&pf)[2][2], int fr, int fq) {
#pragma unroll
  for (int k2 = 0; k2 < 2; ++k2)
#pragma unroll
    for (int dm = 0; dm < 4; ++dm) {
      bf16x8 vf = *(const bf16x8*)(sV + (dm * 16 + fr) * LDSP + k2 * 32 + fq * 8);
      acc[0][dm] = mfma16(vf, pf[0][k2], acc[0][dm]);
      acc[1][dm] = mfma16(vf, pf[1][k2], acc[1][dm]);
    }
}

constexpr float SM_C = 0.125f * 1.4426950408889634f;
template <bool MASKED>
__device__ __forceinline__ void nsa_online_step(NsaState& st, f32x4 (&s)[2][4], unsigned vmask, bool lanevalid, const u16* sV, int fr, int fq) {
  bf16x8 pf[2][2];
  const uint32_t lmask = lanevalid ? 0xffffffffu : 0u;
  const bf16x8 ones = mk_frag(0x3F803F80u, 0x3F803F80u, 0x3F803F80u, 0x3F803F80u);
  constexpr float DEFER = 8.f / SM_C;
#pragma unroll
  for (int hh = 0; hh < 2; ++hh) {
    float tmax = -1e30f;
    if (MASKED) {
#pragma unroll
      for (int mt = 0; mt < 4; ++mt)
#pragma unroll
        for (int j = 0; j < 4; ++j) {
          const float sc = ((vmask >> (mt * 4 + j)) & 1u) ? s[hh][mt][j] : -1e30f;
          s[hh][mt][j] = sc;
          tmax = fmaxf(tmax, sc);
        }
    } else {
#pragma unroll
      for (int mt = 0; mt < 4; ++mt)
#pragma unroll
        for (int j = 0; j < 4; ++j) tmax = fmaxf(tmax, s[hh][mt][j]);
      tmax = lanevalid ? tmax : -1e30f;
    }
    tmax = fmaxf(tmax, __shfl_xor(tmax, 16));
    tmax = fmaxf(tmax, __shfl_xor(tmax, 32));
    const bool upd = tmax > st.m[hh] + DEFER;
    if (__ballot(upd) != 0ull) {
      const float mnew = upd ? tmax : st.m[hh];
      const float alpha = __builtin_amdgcn_exp2f((st.m[hh] - mnew) * SM_C);
      st.m[hh] = mnew;
#pragma unroll
      for (int dm = 0; dm < 4; ++dm) st.acc[hh][dm] *= alpha;
      st.accL[hh] *= alpha;
    }
    const float nb = -st.m[hh] * SM_C;
#pragma unroll
    for (int k2 = 0; k2 < 2; ++k2) {
      uint32_t pw[4];
#pragma unroll
      for (int e2 = 0; e2 < 4; ++e2) {
        const int mt = 2 * k2 + (e2 >> 1), j = (e2 & 1) * 2;
        float p0 = __builtin_amdgcn_exp2f(__builtin_fmaf(s[hh][mt][j], SM_C, nb));
        float p1 = __builtin_amdgcn_exp2f(__builtin_fmaf(s[hh][mt][j + 1], SM_C, nb));
        if (MASKED) {
          p0 = ((vmask >> (mt * 4 + j)) & 1u) ? p0 : 0.f;
          p1 = ((vmask >> (mt * 4 + j + 1)) & 1u) ? p1 : 0.f;
        }
        pw[e2] = pack2(p0, p1);
        if (!MASKED) pw[e2] &= lmask;
      }
      pf[hh][k2] = mk_frag(pw[0], pw[1], pw[2], pw[3]);
      st.accL[hh] = mfma16(ones, pf[hh][k2], st.accL[hh]);
    }
#pragma unroll
    for (int k2 = 0; k2 < 2; ++k2)
#pragma unroll
      for (int dm = 0; dm < 4; ++dm) {
        const bf16x8 vf = *(const bf16x8*)(sV + (dm * 16 + fr) * LDSP + k2 * 32 + fq * 8);
        st.acc[hh][dm] = mfma16(vf, pf[hh][k2], st.acc[hh][dm]);
      }
  }
}

__device__ __forceinline__ void nsa_reset(NsaState& st) {
#pragma unroll
  for (int hh = 0; hh < 2; ++hh) {
    st.m[hh] = -1e30f; st.l[hh] = 0.f; st.accL[hh] = (f32x4){0.f, 0.f, 0.f, 0.f};
#pragma unroll
    for (int dm = 0; dm < 4; ++dm) st.acc[hh][dm] = (f32x4){0.f, 0.f, 0.f, 0.f};
  }
}

__device__ __forceinline__ void nsa_finish(NsaState& st, f32x4 (&out)[2][4], const float (&gate)[2]) {
#pragma unroll
  for (int hh = 0; hh < 2; ++hh) {
    const float l = st.accL[hh][0];
    const float sc = (l > 0.f) ? gate[hh] / l : 0.f;
#pragma unroll
    for (int dm = 0; dm < 4; ++dm) out[hh][dm] += st.acc[hh][dm] * sc;
  }
}

__device__ __forceinline__ void phase_nsa_cmp(const Params& p, u16* sm) {
  const int tid = threadIdx.x, lane = tid & 63, wave = tid >> 6, fr = lane & 15, fq = lane >> 4;
  const int wq = wave & 3, qh = wave >> 2;
  u16* sKall = sm; u16* sVall = sm + 4 * 64 * LDSP;
  unsigned* PsumU = (unsigned*)(sm + 8 * 64 * LDSP);
  float* Imp = (float*)(PsumU + 32 * 260);
  const int ntiles = 16 * 128;
  for (int tile = blockIdx.x; tile < ntiles; tile += gridDim.x) {
    int qb = 127 - (tile >> 4), bg = tile & 15;
    if (gridDim.x == 256) {
      const int k = 7 - (tile >> 8), r = (int)blockIdx.x >> 4;
      qb = 32 * (k >> 1) + ((k & 1) ? 31 - r : r);
      bg = (int)blockIdx.x & 15;
    }
    const int b = bg >> 1, g = bg & 1;
    const int t0 = qb * 32, myt = t0 + 16 * qh + fr;
    const size_t tokbase = (size_t)b * SEQ;
    const int hA = g * 8 + wq * 2;
    bf16x8 qf[2][2];
#pragma unroll
    for (int hh = 0; hh < 2; ++hh)
#pragma unroll
      for (int ks = 0; ks < 2; ++ks)
        qf[hh][ks] = *(const bf16x8*)(p.qn + (tokbase + myt) * DM + (hA + hh) * 64 + ks * 32 + fq * 8);
    float gate0[2];
#pragma unroll
    for (int hh = 0; hh < 2; ++hh) gate0[hh] = p.gbuf[(tokbase + myt) * 48 + (hA + hh) * 3 + 0];

#pragma unroll
    for (int i = 0; i < 17; ++i) { int idx = tid + 512 * i; if (idx < 32 * 260) PsumU[idx] = 0u; }

    const u16* kcb = p.kc + (size_t)(b * 2 + g) * 256 * 64;
    const u16* vcb = p.vcT + (size_t)(b * 2 + g) * 64 * 256;
    const int ncmp = (t0 >> 4) + 1;
    const int nct = (ncmp + 63) >> 6;
    NsaState st;
    f32x4 s[2][4];
    for (int kt = 0; kt < nct; ++kt) {
      load_tile64(sKall + kt * 64 * LDSP, kcb + (size_t)kt * 64 * 64, 64, true);
      load_tile64(sVall + kt * 64 * LDSP, vcb + kt * 64, 256, false);
    }
    __syncthreads();
    nsa_reset(st);
    for (int kt = 0; kt < nct; ++kt) {
      const u16* sK = sKall + kt * 64 * LDSP;
      nsa_qk(s, sK, qf, fr, fq);
      unsigned vmask = 0;
#pragma unroll
      for (int mt = 0; mt < 4; ++mt)
#pragma unroll
        for (int j = 0; j < 4; ++j) {
          const int c = kt * 64 + 32 * (mt >> 1) + 8 * fq + 4 * (mt & 1) + j;
          vmask |= ((16 * c + 31 <= myt) ? 1u : 0u) << (mt * 4 + j);
        }
#pragma unroll
      for (int hh = 0; hh < 2; ++hh) {
        float tmax = -1e30f;
#pragma unroll
        for (int mt = 0; mt < 4; ++mt)
#pragma unroll
          for (int j = 0; j < 4; ++j) {
            const float sc = ((vmask >> (mt * 4 + j)) & 1u) ? s[hh][mt][j] * 0.125f : -1e30f;
            s[hh][mt][j] = sc; tmax = fmaxf(tmax, sc);
          }
        tmax = fmaxf(tmax, __shfl_xor(tmax, 16));
        tmax = fmaxf(tmax, __shfl_xor(tmax, 32));
        const float mnew = fmaxf(st.m[hh], tmax);
        float psum = 0.f;
#pragma unroll
        for (int mt = 0; mt < 4; ++mt)
#pragma unroll
          for (int j = 0; j < 4; ++j) psum += ((vmask >> (mt * 4 + j)) & 1u) ? __expf(s[hh][mt][j] - mnew) : 0.f;
        st.l[hh] = st.l[hh] * __expf(st.m[hh] - mnew) + psum;
        st.m[hh] = mnew;
      }
    }
    float invl[2];
#pragma unroll
    for (int hh = 0; hh < 2; ++hh) {
      float l = st.l[hh];
      l += __shfl_xor(l, 16);
      l += __shfl_xor(l, 32);
      invl[hh] = (l > 0.f) ? 1.f / l : 0.f;
    }
    for (int kt = 0; kt < nct; ++kt) {
      const u16* sK = sKall + kt * 64 * LDSP;
      const u16* sV = sVall + kt * 64 * LDSP;
      nsa_qk(s, sK, qf, fr, fq);
      bf16x8 pf[2][2];
      float pp[4][4];
#pragma unroll
      for (int mt = 0; mt < 4; ++mt)
#pragma unroll
        for (int j = 0; j < 4; ++j) pp[mt][j] = 0.f;
#pragma unroll
      for (int hh = 0; hh < 2; ++hh) {
#pragma unroll
        for (int k2 = 0; k2 < 2; ++k2) {
          uint32_t pw[4];
#pragma unroll
          for (int e2 = 0; e2 < 4; ++e2) {
            const int mt = 2 * k2 + (e2 >> 1), j = (e2 & 1) * 2;
            const int c0 = kt * 64 + 32 * (mt >> 1) + 8 * fq + 4 * (mt & 1) + j;
            float p0 = (16 * c0 + 31 <= myt) ? __expf(s[hh][mt][j] * 0.125f - st.m[hh]) * invl[hh] : 0.f;
            float p1 = (16 * (c0 + 1) + 31 <= myt) ? __expf(s[hh][mt][j + 1] * 0.125f - st.m[hh]) * invl[hh] : 0.f;
            pp[mt][j] += p0; pp[mt][j + 1] += p1;
            pw[e2] = pack2(p0, p1);
          }
          pf[hh][k2] = mk_frag(pw[0], pw[1], pw[2], pw[3]);
        }
#pragma unroll
        for (int k2 = 0; k2 < 2; ++k2)
#pragma unroll
          for (int dm = 0; dm < 4; ++dm) {
            const bf16x8 vf = *(const bf16x8*)(sV + (dm * 16 + fr) * LDSP + k2 * 32 + fq * 8);
            st.acc[hh][dm] = mfma16(vf, pf[hh][k2], st.acc[hh][dm]);
          }
      }
#pragma unroll
      for (int mt = 0; mt < 4; ++mt)
#pragma unroll
        for (int j = 0; j < 4; ++j) {
          const int c = kt * 64 + 32 * (mt >> 1) + 8 * fq + 4 * (mt & 1) + j;
          atomicAdd(&PsumU[(16 * qh + fr) * 260 + c], (unsigned)(pp[mt][j] * 268435456.f + 0.5f));
        }
    }
#pragma unroll
    for (int hh = 0; hh < 2; ++hh)
#pragma unroll
      for (int dm = 0; dm < 4; ++dm)
        *(uint2*)(p.ocp + (tokbase + myt) * DM + (hA + hh) * 64 + dm * 16 + fq * 4) = pack4(st.acc[hh][dm] * gate0[hh]);
    __syncthreads();
#pragma unroll
    for (int e = 0; e < 4; ++e) {
      const int idx = tid + 512 * e, q = idx >> 6, n = idx & 63;
      const unsigned* Pq = PsumU + q * 260 + 4 * n;
      const float sc28 = 1.f / 268435456.f;
      float v = ((float)Pq[0] + (float)Pq[1] + (float)Pq[2] + 0.5f * ((float)Pq[3] + (n > 0 ? (float)Pq[-1] : 0.f))) * sc28;
      Imp[q * 64 + n] = v;
    }
    __syncthreads();
#pragma unroll
    for (int qi = 0; qi < 4; ++qi) {
      const int q = wave * 4 + qi, tq = t0 + q, cur = tq >> 6, n = lane;
      const bool causal = (n <= cur);
      const bool forced = (n == 0) || (n == cur) || (n == cur - 1);
      const float sc = causal ? (Imp[q * 64 + n] + (forced ? 1e4f : 0.f)) : -1e30f;
      int rank = 0;
      Imp[q * 64 + n] = sc;
      __builtin_amdgcn_wave_barrier();
#pragma unroll 8
      for (int n2 = 0; n2 < 64; ++n2) {
        const float s2 = Imp[q * 64 + n2];
        rank += ((s2 > sc) || (s2 == sc && n2 < n)) ? 1 : 0;
      }
      const unsigned long long mk = __ballot(causal && rank < 16);
      if (lane == 0) p.msk[(size_t)(b * 2 + g) * SEQ + tq] = mk;
    }
    __syncthreads();
  }
}

__device__ __forceinline__ void phase_nsa_sw(const Params& p, u16* sm) {
  const int tid = threadIdx.x, lane = tid & 63, wave = tid >> 6, fr = lane & 15, fq = lane >> 4;
  const int wq = wave & 3, qh = wave >> 2;
  u16* sK = sm; u16* sV = sm + 64 * LDSP;
  int* lst = (int*)(sm + 4 * 64 * LDSP);
  uint2* selL = (uint2*)(sm + 4 * 64 * LDSP + 256) + wave * 512 + lane;
  const int ntiles = 16 * 128;
  for (int tile = blockIdx.x; tile < ntiles; tile += gridDim.x) {
    int qb = 127 - (tile >> 4), bg = tile & 15;
    if (gridDim.x == 256) {
      const int k = 7 - (tile >> 8), r = (int)blockIdx.x >> 4;
      qb = 32 * (k >> 1) + ((k & 1) ? 31 - r : r);
      bg = (int)blockIdx.x & 15;
    }
    const int b = bg >> 1, g = bg & 1;
    const int t0 = qb * 32, myt = t0 + 16 * qh + fr;
    const size_t tokbase = (size_t)b * SEQ;
    const int hA = g * 8 + wq * 2;
    bf16x8 qf[2][2];
#pragma unroll
    for (int hh = 0; hh < 2; ++hh)
#pragma unroll
      for (int ks = 0; ks < 2; ++ks)
        qf[hh][ks] = *(const bf16x8*)(p.qn + (tokbase + myt) * DM + (hA + hh) * 64 + ks * 32 + fq * 8);
    float gates[2][3];
#pragma unroll
    for (int hh = 0; hh < 2; ++hh)
#pragma unroll
      for (int r = 0; r < 3; ++r) gates[hh][r] = p.gbuf[(tokbase + myt) * 48 + (hA + hh) * 3 + r];
    NsaState st;
    f32x4 s[2][4];
    const unsigned long long* mskp = p.msk + (size_t)(b * 2 + g) * SEQ + t0;
    const unsigned long long mymask = mskp[16 * qh + fr];
    unsigned long long um = 0;
#pragma unroll
    for (int q = 0; q < 32; ++q) um |= mskp[q];
    const u16* ksb = p.ksb + tokbase * 128 + g * 64;
    const u16* vsb = p.vsT + (size_t)(b * 2 + g) * 64 * SEQ;
    const u16* kwb = p.kwb + tokbase * 128 + g * 64;
    const u16* vwb = p.vwT + (size_t)(b * 2 + g) * 64 * SEQ;
    const int kt_lo = (t0 >= 511) ? ((t0 - 511) >> 6) : 0, kt_hi = (t0 + 31) >> 6;
    const int nsel = __popcll(um), ntl = nsel + (kt_hi - kt_lo + 1);
    if (tid < 64) {
      if ((um >> tid) & 1ull) lst[__popcll(um & ((1ull << tid) - 1ull))] = tid;
      if (tid <= kt_hi - kt_lo) lst[nsel + tid] = 64 + kt_lo + tid;
    }
    __syncthreads();
    const int pc = tid & 7, pr = tid >> 3, prl = rho_row(pr);
    uint4 rkA, rvA;
#define NSA_FETCH(rk, rv, e) do { const int v_ = lst[(e)]; \
      const u16* kp_ = (v_ < 64) ? ksb + (size_t)v_ * 64 * 128 : kwb + (size_t)(v_ - 64) * 64 * 128; \
      const u16* vp_ = (v_ < 64) ? vsb + v_ * 64 : vwb + (v_ - 64) * 64; \
      rk = *(const uint4*)(kp_ + (size_t)pr * 128 + pc * 8); rv = *(const uint4*)(vp_ + (size_t)pr * SEQ + pc * 8); } while (0)
#define NSA_PUT(rk, rv, buf) do { *(uint4*)(sK + (buf) * 2 * 64 * LDSP + prl * LDSP + pc * 8) = rk; \
      *(uint4*)(sV + (buf) * 2 * 64 * LDSP + pr * LDSP + pc * 8) = rv; } while (0)
    NSA_FETCH(rkA, rvA, 0);
    NSA_PUT(rkA, rvA, 0);
    if (ntl > 1) NSA_FETCH(rkA, rvA, 1);
    nsa_reset(st);
    for (int i = 0; i < ntl; ++i) {
      __syncthreads();
      const int v = lst[i];
      const u16* cK = sK + (i & 1) * 2 * 64 * LDSP;
      const u16* cV = sV + (i & 1) * 2 * 64 * LDSP;
      if (i == nsel) {
        f32x4 tmp[2][4];
#pragma unroll
        for (int hh = 0; hh < 2; ++hh)
#pragma unroll
          for (int dm = 0; dm < 4; ++dm) tmp[hh][dm] = (f32x4){0.f, 0.f, 0.f, 0.f};
        const float gg[2] = {gates[0][1], gates[1][1]};
        nsa_finish(st, tmp, gg);
#pragma unroll
        for (int hh = 0; hh < 2; ++hh)
#pragma unroll
          for (int dm = 0; dm < 4; ++dm) selL[(hh * 4 + dm) * 64] = pack4(tmp[hh][dm]);
        nsa_reset(st);
      }
      nsa_qk(s, cK, qf, fr, fq);
      {
        const bool is_sel = (v < 64);
        const int kt = is_sel ? v : v - 64;
        const bool lv = is_sel ? (bool)((mymask >> v) & 1ull) : true;
        const bool masked = is_sel ? (v == (t0 >> 6)) : !((64 * kt + 63 <= t0) && (64 * kt >= t0 - 480));
        if (masked) {
          const int wnd = is_sel ? (1 << 30) : 512;
          unsigned vmask = 0;
#pragma unroll
          for (int mt = 0; mt < 4; ++mt)
#pragma unroll
            for (int j = 0; j < 4; ++j) {
              const int key = kt * 64 + 32 * (mt >> 1) + 8 * fq + 4 * (mt & 1) + j;
              const int diff = myt - key;
              vmask |= ((lv && diff >= 0 && diff < wnd) ? 1u : 0u) << (mt * 4 + j);
            }
          nsa_online_step<true>(st, s, vmask, true, cV, fr, fq);
        } else {
          nsa_online_step<false>(st, s, 0u, lv, cV, fr, fq);
        }
      }
      if (i + 1 < ntl) NSA_PUT(rkA, rvA, (i + 1) & 1);
      if (i + 2 < ntl) NSA_FETCH(rkA, rvA, i + 2);
    }
#undef NSA_FETCH
#undef NSA_PUT
    f32x4 out[2][4];
#pragma unroll
    for (int hh = 0; hh < 2; ++hh)
#pragma unroll
      for (int dm = 0; dm < 4; ++dm) {
        const uint2 pv = *(const uint2*)(p.ocp + (tokbase + myt) * DM + (hA + hh) * 64 + dm * 16 + fq * 4);
        const uint2 sv = selL[(hh * 4 + dm) * 64];
        out[hh][dm] = (f32x4){bf2f((u16)(pv.x & 0xffff)) + bf2f((u16)(sv.x & 0xffff)), bf2f((u16)(pv.x >> 16)) + bf2f((u16)(sv.x >> 16)),
                              bf2f((u16)(pv.y & 0xffff)) + bf2f((u16)(sv.y & 0xffff)), bf2f((u16)(pv.y >> 16)) + bf2f((u16)(sv.y >> 16))};
      }
    {
      const float gg[2] = {gates[0][2], gates[1][2]};
      nsa_finish(st, out, gg);
    }
#pragma unroll
    for (int hh = 0; hh < 2; ++hh)
#pragma unroll
      for (int dm = 0; dm < 4; ++dm)
        *(uint2*)(p.ob + (tokbase + myt) * DM + (hA + hh) * 64 + dm * 16 + fq * 4) = pack4(out[hh][dm]);
    __syncthreads();
  }
}

__device__ __forceinline__ void run_phase(const Params& p, const int ph, u16* sm) {
  switch (ph) {
    case 0: phase_prep(p, sm); break;
    case 1: { EpiSbaQkv e; e.qb = p.qb; e.kb = p.kb; e.vT = p.vT; run_gemm(sm, p.hn, p.wt_sba_in, NTOK, 3072, DM, e); } break;
    case 2: phase_sba_attn(p, sm); break;
    case 3: { EpiResidB<true> e; e.resid32 = p.x; e.xb = p.xb; e.rowss = p.rowss; run_gemm(sm, p.ob, p.wt_sba_out, NTOK, DM, DM, e); } break;
    case 5: { EpiUpConv e; e.act = p.act; e.ub = p.ub; e.rowss = p.rowss; e.cw = p.conv_w; e.cb = p.conv_b; run_gemm(sm, p.xb, p.wt_up0, NTOK, NUP, DM, e); } break;
    case 6: phase_ffn_fix(p, 0); break;
    case 7: { EpiResidB<false> e; e.resid32 = nullptr; e.xb = p.xb; e.rowss = p.rowss + NTOK; run_gemm(sm, p.act, p.wt_down0, NTOK, DM, DFF, e); } break;
    case 12: { EpiNsaIn e; e.qn = p.qn; e.cbuf = p.cbuf; e.ksb = p.ksb; e.kwb = p.kwb; e.vsT = p.vsT; e.vwT = p.vwT; e.gbuf = p.gbuf; e.rope = p.rope; e.rowss = p.rowss + NTOK;
               run_gemm(sm, p.xb, p.wt_nsa_in, NTOK, NSAWP, DM, e); } break;
    case 13: phase_compress(p, sm); break;
    case 14: phase_nsa_cmp(p, sm); break;
    case 15: phase_nsa_sw(p, sm); break;
    case 16: { EpiResidB<false> e; e.resid32 = nullptr; e.xb = p.xb; e.rowss = p.rowss + 2 * NTOK; run_gemm(sm, p.ob, p.wt_nsa_out, NTOK, DM, DM, e); } break;
    case 18: { EpiUpConv e; e.act = p.act; e.ub = p.ub; e.rowss = p.rowss + 2 * NTOK; e.cw = p.conv_w + (size_t)3 * NUP; e.cb = p.conv_b + NUP; run_gemm(sm, p.xb, p.wt_up1, NTOK, NUP, DM, e); } break;
    case 19: phase_ffn_fix(p, 1); break;
    case 20: { EpiResidLast e; e.xb = p.xb; e.out = p.out; run_gemm(sm, p.act, p.wt_down1, NTOK, DM, DFF, e); } break;
    case 24: phase_final_norm(p.out, p.norm_final); break;
    default: break;
  }
}

#ifndef PROBE_REP
#define PROBE_REP 0u
#endif
#define GRID_BAR() grid_barrier((unsigned*)(ka.ws + O_BAR), (volatile LAS unsigned*)&xb_words, bar_k++)
#define PHASE_SEQ(n) if (p.phase_lo <= (n) && (n) <= p.phase_hi) { \
    if ((PROBE_REP >> (n)) & 1u) { run_phase(p, (n), sm); GRID_BAR(); } \
    run_phase(p, (n), sm); if ((n) < p.phase_hi) { if ((n) == 0) { cg::this_grid().sync(); if (threadIdx.x == 0) xb_census((unsigned*)(ka.ws + O_BAR), (volatile LAS unsigned*)&xb_words); __syncthreads(); } else GRID_BAR(); } }
__global__ void __launch_bounds__(512, 2) hybrid_megakernel(KArgs ka) {
  const Params p = make_params(ka);
  __shared__ __attribute__((aligned(16))) u16 sm[SMEM_BYTES / 2];
  unsigned bar_k = 0;
  __shared__ uint4 xb_words;
  if (threadIdx.x == 0 && p.phase_lo < p.phase_hi) xb_post((unsigned*)(ka.ws + O_BAR));
  PHASE_SEQ(0) PHASE_SEQ(1) PHASE_SEQ(2) PHASE_SEQ(3) PHASE_SEQ(5) PHASE_SEQ(6) PHASE_SEQ(7)
  PHASE_SEQ(12) PHASE_SEQ(13) PHASE_SEQ(14) PHASE_SEQ(15)
  PHASE_SEQ(16) PHASE_SEQ(18) PHASE_SEQ(19) PHASE_SEQ(20)
  PHASE_SEQ(24)
}

extern "C" void kernel_launch(void* const* d_in, const int* in_sizes, int n_in, void* d_out, int out_size, void* d_ws,
                              size_t ws_size, hipStream_t stream) {
  KArgs p;
  memset(&p, 0, sizeof(p));
  for (int i = 0; i < 19; ++i) p.in[i] = d_in[i];
  p.out = (float*)d_out;
  p.ws = (char*)d_ws;
  if (ws_size < WS_NEEDED) fprintf(stderr, "workspace too small: %zu < %zu\n", ws_size, (size_t)WS_NEEDED);

  static int grid_blocks = 0;
  if (!grid_blocks) {
    int dev = 0, cus = 0, per_cu = 0;
    hipGetDevice(&dev);
    hipDeviceGetAttribute(&cus, hipDeviceAttributeMultiprocessorCount, dev);
    hipOccupancyMaxActiveBlocksPerMultiprocessor(&per_cu, hybrid_megakernel, NTHR, 0);
    if (per_cu > 1) per_cu = 1;
    if (per_cu < 1) per_cu = 1;
    grid_blocks = cus * per_cu;
  }
#if ONE_LAUNCH
  p.phase_lo = 0; p.phase_hi = NPHASE - 1;
  hipMemsetAsync((char*)d_ws + O_BAR, 0, XCD_BAR_WORDS * 4, stream);
  void* args[] = {&p};
  hipError_t e = hipLaunchCooperativeKernel((void*)hybrid_megakernel, dim3(grid_blocks), dim3(NTHR), args, 0, stream);
  if (e != hipSuccess) fprintf(stderr, "cooperative launch failed: %s (grid %d)\n", hipGetErrorString(e), grid_blocks);
#else
  for (int ph = 0; ph < NPHASE; ++ph) {
    p.phase_lo = ph; p.phase_hi = ph;
    hipLaunchKernelGGL(hybrid_megakernel, dim3(grid_blocks), dim3(NTHR), 0, stream, p);
  }
#endif
}
```

```cpp
#include <hip/hip_runtime.h>
#include <hip/hip_cooperative_groups.h>
#include <stdint.h>
#include <string.h>
#include <stdio.h>
namespace cg = cooperative_groups;

#ifndef ONE_LAUNCH
#define ONE_LAUNCH 1
#endif

typedef unsigned short u16;
typedef __attribute__((ext_vector_type(8))) short bf16x8;
typedef __attribute__((ext_vector_type(4))) float f32x4;

constexpr int SEQ = 4096, DM = 1024, NTOK = 8 * 4096, DFF = 2816, NUP = 5632;
constexpr int NSAWP = 2048;
constexpr int HALF_TOK = NTOK / 2;
constexpr int LDSP = 72;
constexpr int NPHASE = 25;
constexpr int SMEM_BYTES = 131072;
constexpr int NTHR = 512;


struct Params {
  const float* x; const int* pos; const float* norm_mix; const float* sba_w_in; const float* sba_w_out;
  const float* nsa_w_in; const float* pe_k; const float* pe_v; const float* ck_w1; const float* ck_w2;
  const float* cv_w1; const float* cv_w2; const float* nsa_w_out; const float* norm_ffn; const float* w_up;
  const float* conv_w; const float* conv_b; const float* w_down; const float* norm_final;
  float* out;
  u16 *wt_sba_in, *wt_sba_out, *wt_nsa_in, *wt_nsa_out, *wt_up0, *wt_up1, *wt_down0, *wt_down1, *wt_ck1, *wt_cv1, *wt_ck2, *wt_cv2;
  float *bpart; float2* rope; unsigned long long* rowss; u16* xb;
  u16* hn;
  u16 *qb, *kb, *vT;
  u16 *qn, *cbuf, *ksb, *kwb, *vsT, *vwT, *kc, *vcT; float* gbuf; unsigned long long* msk; u16* ocp;
  float* ub;
  u16* ob;
  u16* act;
  int phase_lo, phase_hi;
  int pad_;
};

__device__ __forceinline__ u16 f2bf(float f) {
  uint32_t u = __float_as_uint(f);
  u += 0x7fffu + ((u >> 16) & 1u);
  return (u16)(u >> 16);
}
typedef float f32x2_t __attribute__((ext_vector_type(2)));
typedef __bf16 bf16x2_t __attribute__((ext_vector_type(2)));
__device__ __forceinline__ uint32_t pack2(float a, float b) {
  f32x2_t v = {a, b};
  bf16x2_t h = __builtin_convertvector(v, bf16x2_t);
  return __builtin_bit_cast(uint32_t, h);
}
__device__ __forceinline__ float bf2f(u16 h) { return __uint_as_float(((uint32_t)h) << 16); }
__device__ __forceinline__ uint2 pack4(f32x4 v) { return make_uint2(pack2(v[0], v[1]), pack2(v[2], v[3])); }
__device__ __forceinline__ f32x4 mfma16(bf16x8 a, bf16x8 b, f32x4 c) {
  return __builtin_amdgcn_mfma_f32_16x16x32_bf16(a, b, c, 0, 0, 0);
}
__device__ __forceinline__ bf16x8 mk_frag(uint32_t a, uint32_t b, uint32_t c, uint32_t d) {
  union { uint4 u; bf16x8 v; } t; t.u = make_uint4(a, b, c, d); return t.v;
}

#define XCD_BAR_WORDS 3456
constexpr size_t al256(size_t x) { return (x + 255) & ~(size_t)255; }
constexpr size_t MB = 1024 * 1024;
constexpr size_t O_WT_SBA_IN = 0;
constexpr size_t O_WT_SBA_OUT = O_WT_SBA_IN + al256((size_t)3072 * 1024 * 2);
constexpr size_t O_WT_NSA_IN = O_WT_SBA_OUT + al256((size_t)1024 * 1024 * 2);
constexpr size_t O_WT_NSA_OUT = O_WT_NSA_IN + al256((size_t)NSAWP * 1024 * 2);
constexpr size_t O_WT_UP0 = O_WT_NSA_OUT + al256((size_t)1024 * 1024 * 2);
constexpr size_t O_WT_UP1 = O_WT_UP0 + al256((size_t)NUP * 1024 * 2);
constexpr size_t O_WT_DOWN0 = O_WT_UP1 + al256((size_t)NUP * 1024 * 2);
constexpr size_t O_WT_DOWN1 = O_WT_DOWN0 + al256((size_t)1024 * DFF * 2);
constexpr size_t O_WT_CK1 = O_WT_DOWN1 + al256((size_t)1024 * DFF * 2);
constexpr size_t O_WT_CV1 = O_WT_CK1 + al256((size_t)128 * 2048 * 2);
constexpr size_t O_WT_CK2 = O_WT_CV1 + al256((size_t)128 * 2048 * 2);
constexpr size_t O_WT_CV2 = O_WT_CK2 + al256((size_t)64 * 128 * 2);
constexpr size_t O_BIAS1K = O_WT_CV2 + al256((size_t)64 * 128 * 2);
constexpr size_t O_BIAS1V = O_BIAS1K + 512;
constexpr size_t O_ROPE = O_BIAS1V + 512;
constexpr size_t O_HN = O_ROPE + al256((size_t)NTOK * 32 * 8);
constexpr size_t O_BIG = O_HN + al256((size_t)NTOK * DM * 2);
constexpr size_t O_R2 = O_BIG + 192 * MB;
constexpr size_t O_BAR = O_R2 + al256((size_t)HALF_TOK * DFF * 2);
constexpr size_t O_BPART = O_BAR + al256((size_t)XCD_BAR_WORDS * 4);
constexpr size_t O_ROWSS = O_BPART + al256((size_t)2 * 8 * 128 * 4);
constexpr size_t O_XB = O_ROWSS + al256((size_t)3 * NTOK * 8);
constexpr size_t WS_NEEDED = O_XB + al256((size_t)NTOK * DM * 2);
constexpr size_t O_QN = O_BIG;
constexpr size_t O_CBUF = O_QN + al256((size_t)NTOK * DM * 2);
constexpr size_t O_KSB = O_CBUF + al256((size_t)NTOK * 256 * 2);
constexpr size_t O_KWB = O_KSB + al256((size_t)NTOK * 128 * 2);
constexpr size_t O_VST = O_KWB + al256((size_t)NTOK * 128 * 2);
constexpr size_t O_VWT = O_VST + al256((size_t)16 * 64 * SEQ * 2);
constexpr size_t O_KC = O_VWT + al256((size_t)16 * 64 * SEQ * 2);
constexpr size_t O_VCT = O_KC + al256((size_t)16 * 256 * 64 * 2);
constexpr size_t O_GBUF = O_VCT + al256((size_t)16 * 64 * 256 * 2);
constexpr size_t O_MSK = O_GBUF + al256((size_t)NTOK * 48 * 4);
static_assert(O_MSK + (size_t)16 * SEQ * 8 <= O_R2, "NSA buffers overflow BIG");
static_assert((size_t)NTOK * DFF * 2 <= 192 * MB, "act overflow");
static_assert((size_t)512 * 4 * NUP * 4 <= (size_t)HALF_TOK * DFF * 2, "ub overflow");

struct KArgs {
  const void* in[19];
  float* out;
  char* ws;
  int phase_lo, phase_hi;
};

__device__ __forceinline__ Params make_params(const KArgs& k) {
  Params p;
  p.x = (const float*)k.in[0]; p.pos = (const int*)k.in[1]; p.norm_mix = (const float*)k.in[2];
  p.sba_w_in = (const float*)k.in[3]; p.sba_w_out = (const float*)k.in[4]; p.nsa_w_in = (const float*)k.in[5];
  p.pe_k = (const float*)k.in[6]; p.pe_v = (const float*)k.in[7]; p.ck_w1 = (const float*)k.in[8];
  p.ck_w2 = (const float*)k.in[9]; p.cv_w1 = (const float*)k.in[10]; p.cv_w2 = (const float*)k.in[11];
  p.nsa_w_out = (const float*)k.in[12]; p.norm_ffn = (const float*)k.in[13]; p.w_up = (const float*)k.in[14];
  p.conv_w = (const float*)k.in[15]; p.conv_b = (const float*)k.in[16]; p.w_down = (const float*)k.in[17];
  p.norm_final = (const float*)k.in[18];
  p.out = k.out;
  char* ws = k.ws;
  p.wt_sba_in = (u16*)(ws + O_WT_SBA_IN); p.wt_sba_out = (u16*)(ws + O_WT_SBA_OUT);
  p.wt_nsa_in = (u16*)(ws + O_WT_NSA_IN); p.wt_nsa_out = (u16*)(ws + O_WT_NSA_OUT);
  p.wt_up0 = (u16*)(ws + O_WT_UP0); p.wt_up1 = (u16*)(ws + O_WT_UP1);
  p.wt_down0 = (u16*)(ws + O_WT_DOWN0); p.wt_down1 = (u16*)(ws + O_WT_DOWN1);
  p.wt_ck1 = (u16*)(ws + O_WT_CK1); p.wt_cv1 = (u16*)(ws + O_WT_CV1);
  p.wt_ck2 = (u16*)(ws + O_WT_CK2); p.wt_cv2 = (u16*)(ws + O_WT_CV2);
  p.bpart = (float*)(ws + O_BPART); p.rowss = (unsigned long long*)(ws + O_ROWSS); p.xb = (u16*)(ws + O_XB);
  p.rope = (float2*)(ws + O_ROPE);
  p.hn = (u16*)(ws + O_HN);
  p.qb = (u16*)(ws + O_BIG); p.kb = (u16*)(ws + O_BIG + 64 * MB); p.vT = (u16*)(ws + O_BIG + 128 * MB);
  p.qn = (u16*)(ws + O_QN); p.cbuf = (u16*)(ws + O_CBUF); p.ksb = (u16*)(ws + O_KSB); p.kwb = (u16*)(ws + O_KWB);
  p.vsT = (u16*)(ws + O_VST); p.vwT = (u16*)(ws + O_VWT); p.kc = (u16*)(ws + O_KC); p.vcT = (u16*)(ws + O_VCT);
  p.gbuf = (float*)(ws + O_GBUF); p.msk = (unsigned long long*)(ws + O_MSK);
  p.ocp = p.hn;
  p.act = (u16*)(ws + O_BIG);
  p.ob = (u16*)(ws + O_R2); p.ub = (float*)(ws + O_R2);
  p.phase_lo = k.phase_lo; p.phase_hi = k.phase_hi; p.pad_ = 0;
  return p;
}


#define LAS __attribute__((address_space(3)))
__device__ __forceinline__ unsigned xb_ld(unsigned* p)              { return __hip_atomic_load(p, __ATOMIC_RELAXED, __HIP_MEMORY_SCOPE_AGENT); }
__device__ __forceinline__ unsigned xb_add(unsigned* p, unsigned v) { return __hip_atomic_fetch_add(p, v, __ATOMIC_RELAXED, __HIP_MEMORY_SCOPE_AGENT); }
#define XB_XCNT(j)  (256  + 64 * (j))
#define XB_XSUB(j)  (1280 + 64 * (j))
#define XB_XGEN(j)  (2304 + 64 * (j))
#define XB_TOP      3328
#define XB_TOPGEN   3392
__device__ __forceinline__ unsigned xb_xcc_id() { return (unsigned)__builtin_amdgcn_s_getreg((3 << 11) | 20) & 0xFu; }
#define XB_SPIN(cond) do { unsigned _sp = 0; while (cond) { __builtin_amdgcn_s_sleep(1); if (++_sp > (1u << 24)) break; } } while (0)
__device__ __forceinline__ void xb_post(unsigned* bar) { (void)xb_add(&bar[XB_XCNT(xb_xcc_id())], 1u); }
__device__ __forceinline__ void xb_census(unsigned* bar, volatile LAS unsigned* st) {
  const unsigned x = xb_xcc_id();
  unsigned cnt = 0u, mine = 1u;
#pragma unroll 1
  for (unsigned j = 0; j < 16; ++j) { const unsigned c = xb_ld(&bar[XB_XCNT(j)]); cnt += (c > 0u) ? 1u : 0u; if (j == x) mine = c; }
  st[0] = mine > 0u ? mine : 1u; st[1] = cnt > 0u ? cnt : 1u; st[2] = x;
}
__device__ __forceinline__ void grid_barrier(unsigned* bar, volatile LAS unsigned* st, unsigned k) {
  asm volatile("s_waitcnt vmcnt(0)" ::: "memory");
  __syncthreads();
  if (threadIdx.x == 0) {
    __builtin_amdgcn_s_waitcnt(0);
    const unsigned nloc = st[0], nx = st[1], x = st[2];
    const unsigned old = xb_add(&bar[XB_XSUB(x)], 1u);
    if (old + 1u == (k + 1u) * nloc) {
      __builtin_amdgcn_fence(__ATOMIC_RELEASE, "agent");
      asm volatile("s_waitcnt vmcnt(0)" ::: "memory");
      const unsigned og = xb_add(&bar[XB_TOP], 1u);
      if (og + 1u == (k + 1u) * nx) xb_add(&bar[XB_TOPGEN], 1u);
      else XB_SPIN(xb_ld(&bar[XB_TOPGEN]) == k);
      __builtin_amdgcn_fence(__ATOMIC_ACQUIRE, "agent");
      xb_add(&bar[XB_XGEN(x)], 1u);
      asm volatile("s_waitcnt vmcnt(0)" ::: "memory");
    } else {
      XB_SPIN(xb_ld(&bar[XB_XGEN(x)]) == k);
      __builtin_amdgcn_fence(__ATOMIC_ACQUIRE, "agent");
      asm volatile("s_waitcnt vmcnt(0)" ::: "memory");
    }
  }
  __syncthreads();
}

__device__ __forceinline__ void transpose_tile2(const float* tsrc, u16* tdst, int tK, int tN, int tNpad, int tile, u16* sm, const bool rp0 = false, const bool rp1 = false, const bool upperm = false, const float* gk = nullptr) {
  const int nNt = tNpad >> 6;
  const int tid = threadIdx.x & 255;
  const int c4 = tid & 15, r = tid >> 4;
  float4 v[2][4];
  int k0s[2], n0s[2];
#pragma unroll
  for (int t = 0; t < 2; ++t) {
    const int kt = (tile + t) / nNt, nt = (tile + t) - kt * nNt;
    k0s[t] = kt * 64; n0s[t] = nt * 64;
#pragma unroll
    for (int i = 0; i < 4; ++i) {
      const int nsrc0 = upperm ? (((n0s[t] >> 7) & 1) * DFF + 128 * (n0s[t] >> 8) + (n0s[t] & 127)) : n0s[t];
      const int k = r + 16 * i, n = nsrc0 + c4 * 4;
      v[t][i] = make_float4(0.f, 0.f, 0.f, 0.f);
      if (n < tN) v[t][i] = *(const float4*)(tsrc + (size_t)(k0s[t] + k) * tN + n);
      if (gk) { const float gs = gk[k0s[t] + k]; v[t][i].x *= gs; v[t][i].y *= gs; v[t][i].z *= gs; v[t][i].w *= gs; }
    }
  }
#pragma unroll
  for (int t = 0; t < 2; ++t)
#pragma unroll
    for (int i = 0; i < 4; ++i) {
      const int k = r + 16 * i;
      u16* d = sm + t * 64 * LDSP;
      const uint32_t p01 = pack2(v[t][i].x, v[t][i].y), p23 = pack2(v[t][i].z, v[t][i].w);
      d[(c4 * 4 + 0) * LDSP + k] = (u16)(p01 & 0xffff);
      d[(c4 * 4 + 1) * LDSP + k] = (u16)(p01 >> 16);
      d[(c4 * 4 + 2) * LDSP + k] = (u16)(p23 & 0xffff);
      d[(c4 * 4 + 3) * LDSP + k] = (u16)(p23 >> 16);
    }
  __syncthreads();
  const int c8 = tid & 7, rn = tid >> 3;
#pragma unroll
  for (int t = 0; t < 2; ++t) {
    const bool ropeperm = t ? rp1 : rp0;
#pragma unroll
    for (int i = 0; i < 2; ++i) {
      const int n = rn + 32 * i;
      const int nsrc = ropeperm ? (16 * (n >> 5) + (n & 15) + 32 * ((n >> 4) & 1)) : n;
      const uint4 w = *(const uint4*)(sm + t * 64 * LDSP + nsrc * LDSP + c8 * 8);
      *(uint4*)(tdst + (size_t)(n0s[t] + n) * tK + k0s[t] + c8 * 8) = w;
    }
  }
  __syncthreads();
}

__device__ __forceinline__ void rmsnorm_row_bf16(const float* x, const float* g, u16* out, int row, int lane) {
  const float4* xr = (const float4*)(x + (size_t)row * DM);
  float4 v[4]; float ss = 0.f;
#pragma unroll
  for (int i = 0; i < 4; ++i) { v[i] = xr[lane + 64 * i]; ss += v[i].x * v[i].x + v[i].y * v[i].y + v[i].z * v[i].z + v[i].w * v[i].w; }
#pragma unroll
  for (int off = 32; off >= 1; off >>= 1) ss += __shfl_xor(ss, off);
  const float rs = rsqrtf(ss * (1.f / DM) + 1e-6f);
#pragma unroll
  for (int i = 0; i < 4; ++i) {
    float4 gg = ((const float4*)g)[lane + 64 * i];
    uint2 pk = make_uint2(pack2(v[i].x * rs * gg.x, v[i].y * rs * gg.y), pack2(v[i].z * rs * gg.z, v[i].w * rs * gg.w));
    *(uint2*)(out + (size_t)row * DM + (lane + 64 * i) * 4) = pk;
  }
}

__device__ __forceinline__ void rmsnorm_2rows_bf16(const float* x, const float* g, u16* out, int row, int lane) {
  const float4* xr = (const float4*)(x + (size_t)row * DM);
  float4 v[2][4]; float ss[2] = {0.f, 0.f};
#pragma unroll
  for (int t = 0; t < 2; ++t)
#pragma unroll
    for (int i = 0; i < 4; ++i) v[t][i] = xr[t * (DM / 4) + lane + 64 * i];
#pragma unroll
  for (int t = 0; t < 2; ++t)
#pragma unroll
    for (int i = 0; i < 4; ++i) ss[t] += v[t][i].x * v[t][i].x + v[t][i].y * v[t][i].y + v[t][i].z * v[t][i].z + v[t][i].w * v[t][i].w;
#pragma unroll
  for (int off = 32; off >= 1; off >>= 1) { ss[0] += __shfl_xor(ss[0], off); ss[1] += __shfl_xor(ss[1], off); }
#pragma unroll
  for (int t = 0; t < 2; ++t) {
    const float rs = rsqrtf(ss[t] * (1.f / DM) + 1e-6f);
#pragma unroll
    for (int i = 0; i < 4; ++i) {
      const float4 gg = ((const float4*)g)[lane + 64 * i];
      const uint2 pk = make_uint2(pack2(v[t][i].x * rs * gg.x, v[t][i].y * rs * gg.y), pack2(v[t][i].z * rs * gg.z, v[t][i].w * rs * gg.w));
      *(uint2*)(out + (size_t)(row + t) * DM + (lane + 64 * i) * 4) = pk;
    }
  }
}

__device__ __forceinline__ void phase_rmsnorm(const float* x, const float* g, u16* out) {
  const int lane = threadIdx.x & 63, wave = threadIdx.x >> 6;
  for (int it = blockIdx.x; it < NTOK / 8; it += gridDim.x) rmsnorm_row_bf16(x, g, out, it * 8 + wave, lane);
}

__device__ __forceinline__ void phase_final_norm(float* x, const float* g) {
  const int lane = threadIdx.x & 63, wave = threadIdx.x >> 6;
  for (int it = blockIdx.x; it < NTOK / 8; it += gridDim.x) {
    int row = it * 8 + wave;
    float4* xr = (float4*)(x + (size_t)row * DM);
    float4 v[4]; float ss = 0.f;
#pragma unroll
    for (int i = 0; i < 4; ++i) { v[i] = xr[lane + 64 * i]; ss += v[i].x * v[i].x + v[i].y * v[i].y + v[i].z * v[i].z + v[i].w * v[i].w; }
#pragma unroll
    for (int off = 32; off >= 1; off >>= 1) ss += __shfl_xor(ss, off);
    const float rs = rsqrtf(ss * (1.f / DM) + 1e-6f);
#pragma unroll
    for (int i = 0; i < 4; ++i) {
      float4 gg = ((const float4*)g)[lane + 64 * i];
      xr[lane + 64 * i] = make_float4(v[i].x * rs * gg.x, v[i].y * rs * gg.y, v[i].z * rs * gg.z, v[i].w * rs * gg.w);
    }
  }
}

__device__ __forceinline__ void phase_prep(const Params& p, u16* sm) {
  const int tid = threadIdx.x & 255, sub = threadIdx.x >> 8;
  sm += sub * 2 * 64 * LDSP;
  const int n_tr = (768 + 256 + 512 + 256 + 1408 * 2 + 704 * 2 + 64 * 2 + 2 * 2) / 2;
  const int n_rope = NTOK * 32 / 256;
  const int n_bias = 16;
  const int n_norm = NTOK / 8;
  const int total = n_tr + n_rope + n_bias + n_norm;
  for (int i = blockIdx.x * NTHR + threadIdx.x; i < 3 * NTOK; i += gridDim.x * NTHR) p.rowss[i] = 0ull;
  for (int it = 2 * blockIdx.x + sub; it < total; it += 2 * gridDim.x) {
    if (it < n_tr) {
      const int tl = it * 2;
      constexpr int T1 = 768, T2 = T1 + 256, T3 = T2 + 512, T4 = T3 + 256, T5 = T4 + 1408, T6 = T5 + 1408,
                    T7 = T6 + 704, T8 = T7 + 704, T9 = T8 + 64, T10 = T9 + 64, T11 = T10 + 2;
      if (tl < T1) { transpose_tile2(p.sba_w_in, p.wt_sba_in, 1024, 3072, 3072, tl - (0), sm); }
      else if (tl < T2) { transpose_tile2(p.sba_w_out, p.wt_sba_out, 1024, 1024, 1024, tl - (T1), sm); }
      else if (tl < T3) {
        const int nt0 = (tl - T2) & 31, nt1 = nt0 + 1;
        const bool rp0 = (nt0 < 16) || (nt0 == 20) || (nt0 == 21) || (nt0 == 24) || (nt0 == 25);
        const bool rp1 = (nt1 < 16) || (nt1 == 20) || (nt1 == 21) || (nt1 == 24) || (nt1 == 25);
        transpose_tile2(p.nsa_w_in, p.wt_nsa_in, 1024, 1840, NSAWP, tl - (T2), sm, rp0, rp1, false, p.norm_mix + DM);
      }
      else if (tl < T4) { transpose_tile2(p.nsa_w_out, p.wt_nsa_out, 1024, 1024, 1024, tl - (T3), sm); }
      else if (tl < T5) { transpose_tile2(p.w_up, p.wt_up0, 1024, NUP, NUP, tl - (T4), sm, false, false, true, p.norm_ffn); }
      else if (tl < T6) { transpose_tile2(p.w_up + (size_t)1024 * NUP, p.wt_up1, 1024, NUP, NUP, tl - (T5), sm, false, false, true, p.norm_ffn + DM); }
      else if (tl < T7) { transpose_tile2(p.w_down, p.wt_down0, DFF, 1024, 1024, tl - (T6), sm); }
      else if (tl < T8) { transpose_tile2(p.w_down + (size_t)DFF * 1024, p.wt_down1, DFF, 1024, 1024, tl - (T7), sm); }
      else if (tl < T9) { transpose_tile2(p.ck_w1, p.wt_ck1, 2048, 128, 128, tl - (T8), sm); }
      else if (tl < T10) { transpose_tile2(p.cv_w1, p.wt_cv1, 2048, 128, 128, tl - (T9), sm); }
      else if (tl < T11) { transpose_tile2(p.ck_w2, p.wt_ck2, 128, 64, 64, tl - (T10), sm); }
      else { transpose_tile2(p.cv_w2, p.wt_cv2, 128, 64, 64, tl - (T11), sm); }
    } else if (it < n_tr + n_rope) {
      int idx = (it - n_tr) * 256 + tid;
      int tok = idx >> 5, f = idx & 31;
      float inv = powf(10000.f, -(float)f / 32.f);
      float ang = (float)p.pos[tok] * inv;
      p.rope[idx] = make_float2(cosf(ang), sinf(ang));
    } else if (it < n_tr + n_rope + n_bias) {
      const int bi = it - n_tr - n_rope, which = bi >> 3, ch = bi & 7;
      const float* pe = which ? p.pe_v : p.pe_k;
      const float* w1 = which ? p.cv_w1 : p.ck_w1;
      const int n = tid & 127, hf = tid >> 7;
      const int kk0 = ch * 256 + hf * 128;
      float s0 = 0.f;
#pragma unroll 8
      for (int kk = 0; kk < 128; ++kk) s0 += pe[kk0 + kk] * w1[(size_t)(kk0 + kk) * 128 + n];
      float* red = (float*)sm;
      if (hf) red[n] = s0;
      __syncthreads();
      if (!hf) p.bpart[(which * 8 + ch) * 128 + n] = s0 + red[n];
      __syncthreads();
    } else {
      const int r = (it - n_tr - n_rope - n_bias) * 8 + (tid >> 6) * 2;
      rmsnorm_2rows_bf16(p.x, p.norm_mix, p.hn, r, tid & 63);
    }
  }
}

constexpr int PG_BM = 256, PG_BK = 64, PG_HALF = 128, PG_HTB = PG_HALF * PG_BK * 2, PG_NXCD = 8, PG_WGM = 8;
__device__ __forceinline__ int pg_lds_byte(int r, int c) { const int st = (r >> 4) * 2 + (c >> 5), rr = r & 15, cc = c & 31, ob = rr * 64 + cc * 2; return st * 1024 + (ob ^ (((ob >> 9) & 1) << 5)); }
__device__ __forceinline__ void pg_stage_rc(int b, int& R, int& C) { const int st = b / 1024, sb = b % 1024, swz = sb ^ (((sb >> 9) & 1) << 5); R = (st >> 1) * 16 + swz / 64; C = (st & 1) * 32 + (swz % 64) / 2; }
struct Unit { int pm, pn; };
struct Gemm { const u16* A; const u16* Bt; int M, N, K; };
struct StaticOrder {
  int nM, nN, nwg, G, c;
  __device__ void init(int M, int N, int G_, int c_) { nM = M / PG_BM; nN = N / PG_BM; nwg = nM * nN; G = G_; c = c_; }
  __device__ bool next(int i, Unit& u) const {
    const long L = (long)i * G + c; if (L >= nwg) return false;
    int wgid = (int)L; { const int q = nwg / PG_NXCD, r = nwg % PG_NXCD, xcd = wgid % PG_NXCD, off = wgid / PG_NXCD; wgid = (xcd < r ? xcd * (q + 1) : r * (q + 1) + (xcd - r) * q) + off; }
    const int nig = PG_WGM * nN, gid = wgid / nig, fm = gid * PG_WGM, gsz = (nM - fm) < PG_WGM ? (nM - fm) : PG_WGM;
    u.pm = fm + ((wgid % nig) % gsz); u.pn = (wgid % nig) / gsz; return true;
  }
};

template <class Epi>
__device__ __forceinline__ void gemm_phase(LAS unsigned char* lds, const Gemm g, const StaticOrder& S, const Epi& E) {
  const int tid = threadIdx.x, wid = __builtin_amdgcn_readfirstlane(tid >> 6), lane = tid & 63, wr = wid >> 2, wc = wid & 3, fr = lane & 15, fq = lane >> 4;
  const int K = g.K, nt = K / PG_BK;
  unsigned voffA[2];
#pragma unroll
  for (int i = 0; i < 2; ++i) { int R, C; pg_stage_rc(tid * 16 + i * 8192, R, C); voffA[i] = (unsigned)(R * K + C) * 2u; }
  const size_t kstep = (size_t)(PG_BK * 2);
  const size_t hstep = (size_t)PG_HALF * K * 2;
  const size_t tstep = 2 * hstep;
  const unsigned ldsw = (unsigned)wid * 1024u;
  const int aoff = pg_lds_byte(wr * 64 + fr, fq * 8), boff = pg_lds_byte(wc * 32 + fr, fq * 8);
  const unsigned lbase = (unsigned)(__UINTPTR_TYPE__)lds;
  const unsigned aaddr = lbase + (unsigned)aoff, baddr = lbase + 4u * PG_HTB + (unsigned)boff;
#define PG8_SA(b, h) (((b) * 2 + (h)) * PG_HTB)
#define PG8_SB(b, h) ((4 + (b) * 2 + (h)) * PG_HTB)
#define PG8_STAGE(bufoff, gbase, voff) do { _Pragma("unroll") for (int _i = 0; _i < 2; ++_i) \
    __builtin_amdgcn_global_load_lds((const unsigned*)((const char*)(gbase) + (voff)[_i]), (LAS unsigned*)(lds + (bufoff) + ldsw + _i * 8192), 16, 0, 0); } while (0)
#define PG8_DSR(dst, addr, imm) asm volatile("ds_read_b128 %0, %1 offset:%2" : "=v"(dst) : "v"(addr), "n"(imm) : "memory")
#define PG8_LDA(dst, b, h) do { \
    PG8_DSR(dst[0][0], aaddr, ((b) * 2 + (h)) * PG_HTB + 0 * 2048 + 0);    PG8_DSR(dst[0][1], aaddr, ((b) * 2 + (h)) * PG_HTB + 0 * 2048 + 1024); \
    PG8_DSR(dst[1][0], aaddr, ((b) * 2 + (h)) * PG_HTB + 1 * 2048 + 0);    PG8_DSR(dst[1][1], aaddr, ((b) * 2 + (h)) * PG_HTB + 1 * 2048 + 1024); \
    PG8_DSR(dst[2][0], aaddr, ((b) * 2 + (h)) * PG_HTB + 2 * 2048 + 0);    PG8_DSR(dst[2][1], aaddr, ((b) * 2 + (h)) * PG_HTB + 2 * 2048 + 1024); \
    PG8_DSR(dst[3][0], aaddr, ((b) * 2 + (h)) * PG_HTB + 3 * 2048 + 0);    PG8_DSR(dst[3][1], aaddr, ((b) * 2 + (h)) * PG_HTB + 3 * 2048 + 1024); } while (0)
#define PG8_LDB(dst, b, h) do { \
    PG8_DSR(dst[0][0], baddr, ((b) * 2 + (h)) * PG_HTB + 0 * 2048 + 0);    PG8_DSR(dst[0][1], baddr, ((b) * 2 + (h)) * PG_HTB + 0 * 2048 + 1024); \
    PG8_DSR(dst[1][0], baddr, ((b) * 2 + (h)) * PG_HTB + 1 * 2048 + 0);    PG8_DSR(dst[1][1], baddr, ((b) * 2 + (h)) * PG_HTB + 1 * 2048 + 1024); } while (0)
#define PG8_MMA(ai, bj, At, Bt) do { __builtin_amdgcn_s_setprio(1); _Pragma("unroll") for (int m = 0; m < 4; ++m) _Pragma("unroll") for (int n = 0; n < 2; ++n) _Pragma("unroll") for (int k = 0; k < 2; ++k) \
    acc[ai][bj][m][n] = __builtin_amdgcn_mfma_f32_16x16x32_bf16(Bt[n][k], At[m][k], acc[ai][bj][m][n], 0, 0, 0); __builtin_amdgcn_s_setprio(0); } while (0)
#define PG8_WAIT_V(n) asm volatile("s_waitcnt vmcnt(" #n ")" ::: "memory")
#define PG8_WAIT_L(n) asm volatile("s_waitcnt lgkmcnt(" #n ")" ::: "memory")
#define PG8_WAIT_L0 asm volatile("s_waitcnt lgkmcnt(0)" \
    : "+v"(At[0][0]), "+v"(At[0][1]), "+v"(At[1][0]), "+v"(At[1][1]), "+v"(At[2][0]), "+v"(At[2][1]), "+v"(At[3][0]), "+v"(At[3][1]), \
      "+v"(B0[0][0]), "+v"(B0[0][1]), "+v"(B0[1][0]), "+v"(B0[1][1]), "+v"(B1[0][0]), "+v"(B1[0][1]), "+v"(B1[1][0]), "+v"(B1[1][1]) :: "memory")
#define PG8_BAR __builtin_amdgcn_s_barrier()
#define PG8_SCHED __builtin_amdgcn_sched_barrier(0)
  Unit cur, nxt; int ui = 0;
  if (!S.next(0, cur)) return;
  f32x4 acc[2][2][4][2];
#pragma unroll
  for (int a = 0; a < 2; ++a)
#pragma unroll
    for (int b = 0; b < 2; ++b)
#pragma unroll
      for (int m = 0; m < 4; ++m)
#pragma unroll
        for (int n = 0; n < 2; ++n) acc[a][b][m][n] = (f32x4){0.f, 0.f, 0.f, 0.f};
  bf16x8 At[4][2] = {}, B0[2][2] = {}, B1[2][2] = {};
  const char* cA = (const char*)g.A + (size_t)cur.pm * tstep; const char* cB = (const char*)g.Bt + (size_t)cur.pn * tstep;
  PG8_STAGE(PG8_SB(0, 0), cB, voffA); PG8_STAGE(PG8_SA(0, 0), cA, voffA); PG8_STAGE(PG8_SB(0, 1), cB + hstep, voffA); PG8_STAGE(PG8_SA(0, 1), cA + hstep, voffA);
  if (wr == 1) PG8_BAR;
  PG8_WAIT_V(4); PG8_BAR;
  PG8_STAGE(PG8_SB(1, 0), cB + kstep, voffA); PG8_STAGE(PG8_SA(1, 0), cA + kstep, voffA); PG8_STAGE(PG8_SB(1, 1), cB + hstep + kstep, voffA);
  PG8_WAIT_V(6); PG8_BAR;
  for (;;) {
    const bool has_next = S.next(ui + 1, nxt);
    const char* nA = has_next ? (const char*)g.A + (size_t)nxt.pm * tstep : cA; const char* nB = has_next ? (const char*)g.Bt + (size_t)nxt.pn * tstep : cB;
    for (int t = 0; t < nt; t += 2) {
      const bool last = (t == nt - 2);
      const char* a1 = cA + (size_t)(t + 1) * kstep;
      const char* a2 = last ? nA : cA + (size_t)(t + 2) * kstep; const char* b2 = last ? nB : cB + (size_t)(t + 2) * kstep;
      const char* a3 = a2 + kstep; const char* b3 = b2 + kstep;
      PG8_LDB(B0, 0, 0); PG8_SCHED; PG8_LDA(At, 0, 0); PG8_STAGE(PG8_SA(1, 1), a1 + hstep, voffA);
      PG8_WAIT_L(8); PG8_BAR; PG8_WAIT_L0; PG8_MMA(0, 0, At, B0); PG8_BAR; PG8_SCHED;
      PG8_LDB(B1, 0, 1); PG8_STAGE(PG8_SB(0, 0), b2, voffA);
      PG8_BAR; PG8_WAIT_L0; PG8_MMA(0, 1, At, B1); PG8_BAR;
      PG8_LDA(At, 0, 1); PG8_STAGE(PG8_SA(0, 0), a2, voffA);
      PG8_BAR; PG8_WAIT_L0; PG8_MMA(1, 0, At, B0); PG8_BAR; PG8_SCHED;
      PG8_STAGE(PG8_SB(0, 1), b2 + hstep, voffA);
      PG8_WAIT_V(6); PG8_BAR; PG8_MMA(1, 1, At, B1); PG8_BAR;
      PG8_LDB(B0, 1, 0); PG8_SCHED; PG8_LDA(At, 1, 0); PG8_STAGE(PG8_SA(0, 1), a2 + hstep, voffA);
      PG8_WAIT_L(8); PG8_BAR; PG8_WAIT_L0; PG8_MMA(0, 0, At, B0); PG8_BAR; PG8_SCHED;
      PG8_LDB(B1, 1, 1); PG8_STAGE(PG8_SB(1, 0), b3, voffA);
      PG8_BAR; PG8_WAIT_L0; PG8_MMA(0, 1, At, B1); PG8_BAR;
      PG8_LDA(At, 1, 1); PG8_STAGE(PG8_SA(1, 0), a3, voffA);
      PG8_BAR; PG8_WAIT_L0; PG8_MMA(1, 0, At, B0); PG8_BAR; PG8_SCHED;
      PG8_STAGE(PG8_SB(1, 1), b3 + hstep, voffA);
      PG8_WAIT_V(6); PG8_BAR; PG8_MMA(1, 1, At, B1); PG8_BAR;
    }
    E(acc, cur, wr, wc, fr, fq);
    if (!has_next) break;
#pragma unroll
    for (int a = 0; a < 2; ++a)
#pragma unroll
      for (int b = 0; b < 2; ++b)
#pragma unroll
        for (int m = 0; m < 4; ++m)
#pragma unroll
          for (int n = 0; n < 2; ++n) acc[a][b][m][n] = (f32x4){0.f, 0.f, 0.f, 0.f};
    cur = nxt; cA = nA; cB = nB; ++ui;
  }
  PG8_WAIT_V(0);
  if (wr == 0) PG8_BAR;
  PG8_BAR;
#undef PG8_SA
#undef PG8_SB
#undef PG8_STAGE
#undef PG8_LDA
#undef PG8_DSR
#undef PG8_WAIT_L0
#undef PG8_LDB
#undef PG8_MMA
#undef PG8_WAIT_V
#undef PG8_WAIT_L
#undef PG8_BAR
#undef PG8_SCHED
}

typedef f32x4 AccT[2][2][4][2];
#define EPI_ROW(u, ai, m) ((u).pm * 256 + (ai) * 128 + wr * 64 + (m) * 16 + fr)
#define EPI_COL(u, bj, n) ((u).pn * 256 + (bj) * 128 + wc * 32 + (n) * 16 + fq * 4)

struct EpiSbaQkv {
  u16 *qb, *kb, *vT;
  __device__ __forceinline__ void operator()(const AccT& acc, const Unit& u, int wr, int wc, int fr, int fq) const {
    if (u.pn < 8) {
      u16* dst = (u.pn < 4) ? qb : kb;
#pragma unroll
      for (int ai = 0; ai < 2; ++ai)
#pragma unroll
        for (int m = 0; m < 4; ++m) {
          u16* rowp = dst + (size_t)EPI_ROW(u, ai, m) * DM;
#pragma unroll
          for (int bj = 0; bj < 2; ++bj)
#pragma unroll
            for (int n = 0; n < 2; ++n) *(uint2*)(rowp + (EPI_COL(u, bj, n) & 1023)) = pack4(acc[ai][bj][m][n]);
        }
    } else {
#pragma unroll
      for (int ai = 0; ai < 2; ++ai)
#pragma unroll
        for (int m = 0; m < 4; ++m) {
          const int tok = EPI_ROW(u, ai, m), b = tok >> 12, t = tok & 4095;
#pragma unroll
          for (int bj = 0; bj < 2; ++bj)
#pragma unroll
            for (int n = 0; n < 2; ++n) {
              const int c = EPI_COL(u, bj, n) - 2048, h = c >> 6, d = c & 63;
#pragma unroll
              for (int r = 0; r < 4; ++r) vT[((size_t)(b * 16 + h) * 64 + d + r) * SEQ + t] = f2bf(acc[ai][bj][m][n][r]);
            }
        }
    }
  }
};
constexpr float SS_FIX = 16777216.f;
template <bool RF32>
struct EpiResidB {
  const float* resid32; u16* xb; unsigned long long* rowss;
  __device__ __forceinline__ void operator()(const AccT& acc, const Unit& u, int wr, int wc, int fr, int fq) const {
#pragma unroll
    for (int ai = 0; ai < 2; ++ai) {
      f32x4 rv[4][2][2];
#pragma unroll
      for (int m = 0; m < 4; ++m) {
        const size_t ro = (size_t)EPI_ROW(u, ai, m) * DM;
#pragma unroll
        for (int bj = 0; bj < 2; ++bj)
#pragma unroll
          for (int n = 0; n < 2; ++n) {
            if (RF32) rv[m][bj][n] = *(const f32x4*)(resid32 + ro + EPI_COL(u, bj, n));
            else {
              const uint2 pk = *(const uint2*)(xb + ro + EPI_COL(u, bj, n));
              rv[m][bj][n] = (f32x4){__uint_as_float(pk.x << 16), __uint_as_float(pk.x & 0xffff0000u), __uint_as_float(pk.y << 16), __uint_as_float(pk.y & 0xffff0000u)};
            }
          }
      }
#pragma unroll
      for (int m = 0; m < 4; ++m) {
        const int row = EPI_ROW(u, ai, m);
        const size_t ro = (size_t)row * DM;
        float ss = 0.f;
#pragma unroll
        for (int bj = 0; bj < 2; ++bj)
#pragma unroll
          for (int n = 0; n < 2; ++n) {
            const f32x4 x = rv[m][bj][n] + acc[ai][bj][m][n];
            ss += x[0] * x[0] + x[1] * x[1] + x[2] * x[2] + x[3] * x[3];
            *(uint2*)(xb + ro + EPI_COL(u, bj, n)) = pack4(x);
          }
        ss += __shfl_xor(ss, 16);
        ss += __shfl_xor(ss, 32);
        if (fq == 0) atomicAdd(rowss + row, (unsigned long long)(ss * SS_FIX + 0.5f));
      }
    }
  }
};
struct EpiResidLast {
  const u16* xb; float* out;
  __device__ __forceinline__ void operator()(const AccT& acc, const Unit& u, int wr, int wc, int fr, int fq) const {
#pragma unroll
    for (int ai = 0; ai < 2; ++ai) {
      uint2 rv[4][2][2];
#pragma unroll
      for (int m = 0; m < 4; ++m) {
        const size_t ro = (size_t)EPI_ROW(u, ai, m) * DM;
#pragma unroll
        for (int bj = 0; bj < 2; ++bj)
#pragma unroll
          for (int n = 0; n < 2; ++n) rv[m][bj][n] = *(const uint2*)(xb + ro + EPI_COL(u, bj, n));
      }
#pragma unroll
      for (int m = 0; m < 4; ++m) {
        const size_t ro = (size_t)EPI_ROW(u, ai, m) * DM;
#pragma unroll
        for (int bj = 0; bj < 2; ++bj)
#pragma unroll
          for (int n = 0; n < 2; ++n) {
            const uint2 pk = rv[m][bj][n];
            const f32x4 a = acc[ai][bj][m][n];
            *(float4*)(out + ro + EPI_COL(u, bj, n)) = make_float4(__uint_as_float(pk.x << 16) + a[0], __uint_as_float(pk.x & 0xffff0000u) + a[1],
                                                                   __uint_as_float(pk.y << 16) + a[2], __uint_as_float(pk.y & 0xffff0000u) + a[3]);
          }
      }
    }
  }
};
__device__ __forceinline__ float rstd_of(const unsigned long long* rowss, int row) {
  return rsqrtf((float)rowss[row] * (1.f / (SS_FIX * DM)) + 1e-6f);
}
__device__ __forceinline__ float dpp_ror1(float v) { return __int_as_float(__builtin_amdgcn_update_dpp(0, __float_as_int(v), 0x121, 0xf, 0xf, false)); }
__device__ __forceinline__ float dpp_ror2(float v) { return __int_as_float(__builtin_amdgcn_update_dpp(0, __float_as_int(v), 0x122, 0xf, 0xf, false)); }
struct EpiUpConv {
  u16* act; float* ub; const unsigned long long* rowss; const float* cw; const float* cb;
  __device__ __forceinline__ void operator()(const AccT& acc, const Unit& u, int wr, int wc, int fr, int fq) const {
#pragma unroll
    for (int ai = 0; ai < 2; ++ai) {
      float rs[4];
#pragma unroll
      for (int m = 0; m < 4; ++m) rs[m] = rstd_of(rowss, EPI_ROW(u, ai, m));
      const int chunk = 4 * u.pm + 2 * ai + wr;
#pragma unroll
      for (int n = 0; n < 2; ++n) {
        const int f0 = 128 * u.pn + 32 * wc + 16 * n + 4 * fq;
        const int gc = u.pn * 256 + 32 * wc + 16 * n + 4 * fq;
        const f32x4 wg0 = *(const f32x4*)(cw + f0), wg1 = *(const f32x4*)(cw + NUP + f0), wg2 = *(const f32x4*)(cw + 2 * NUP + f0);
        const f32x4 wv0 = *(const f32x4*)(cw + DFF + f0), wv1 = *(const f32x4*)(cw + NUP + DFF + f0), wv2 = *(const f32x4*)(cw + 2 * NUP + DFF + f0);
        const f32x4 bg = *(const f32x4*)(cb + f0), bv = *(const f32x4*)(cb + DFF + f0);
        f32x4 xg[4], xv[4];
#pragma unroll
        for (int m = 0; m < 4; ++m) { xg[m] = acc[ai][0][m][n] * rs[m]; xv[m] = acc[ai][1][m][n] * rs[m]; }
        if (fr < 2) {
          float* d = ub + ((size_t)(chunk * 4 + fr) * NUP + gc);
          *(float4*)d = make_float4(xg[0][0], xg[0][1], xg[0][2], xg[0][3]);
          *(float4*)(d + 128) = make_float4(xv[0][0], xv[0][1], xv[0][2], xv[0][3]);
        }
        if (fr >= 14) {
          float* d = ub + ((size_t)(chunk * 4 + 2 + (fr - 14)) * NUP + gc);
          *(float4*)d = make_float4(xg[3][0], xg[3][1], xg[3][2], xg[3][3]);
          *(float4*)(d + 128) = make_float4(xv[3][0], xv[3][1], xv[3][2], xv[3][3]);
        }
#pragma unroll
        for (int m = 0; m < 4; ++m) {
          f32x4 res;
#pragma unroll
          for (int r = 0; r < 4; ++r) {
            const float g_cur = xg[m][r], v_cur = xv[m][r];
            const f32x4 xgp = xg[m > 0 ? m - 1 : 0], xvp = xv[m > 0 ? m - 1 : 0];
            const float g_pm = (m > 0) ? xgp[r] : 0.f, v_pm = (m > 0) ? xvp[r] : 0.f;
            const float g1 = dpp_ror1((fr == 15) ? g_pm : g_cur), g2 = dpp_ror2((fr >= 14) ? g_pm : g_cur);
            const float v1 = dpp_ror1((fr == 15) ? v_pm : v_cur), v2 = dpp_ror2((fr >= 14) ? v_pm : v_cur);
            const float cg_ = bg[r] + g2 * wg0[r] + g1 * wg1[r] + g_cur * wg2[r];
            const float cv_ = bv[r] + v2 * wv0[r] + v1 * wv1[r] + v_cur * wv2[r];
            res[r] = cg_ * __builtin_amdgcn_rcpf(1.f + __builtin_amdgcn_exp2f(-1.4426950408889634f * cg_)) * cv_;
          }
          if (m > 0 || fr >= 2)
            *(uint2*)(act + (size_t)EPI_ROW(u, ai, m) * DFF + f0) = pack4(res);
        }
      }
    }
  }
};

struct EpiNsaIn {
  u16 *qn, *cbuf, *ksb, *kwb, *vsT, *vwT; float* gbuf; const float2* rope; const unsigned long long* rowss;
  __device__ __forceinline__ void rope_store(const f32x4& x1, const f32x4& x2, int tok, int d1, u16* dst) const {
    const float4 cs01 = *(const float4*)(rope + (size_t)tok * 32 + d1);
    const float4 cs23 = *(const float4*)(rope + (size_t)tok * 32 + d1 + 2);
    const float cc[4] = {cs01.x, cs01.z, cs23.x, cs23.z};
    const float ss[4] = {cs01.y, cs01.w, cs23.y, cs23.w};
    f32x4 o1, o2;
#pragma unroll
    for (int r = 0; r < 4; ++r) { o1[r] = x1[r] * cc[r] - x2[r] * ss[r]; o2[r] = x2[r] * cc[r] + x1[r] * ss[r]; }
    *(uint2*)(dst + d1) = pack4(o1);
    *(uint2*)(dst + d1 + 32) = pack4(o2);
  }
  __device__ __forceinline__ void operator()(const AccT& acc_in, const Unit& u, int wr, int wc, int fr, int fq) const {
    const int d1 = 16 * (wc & 1) + 4 * fq;
#pragma unroll
    for (int ai = 0; ai < 2; ++ai)
#pragma unroll
      for (int m = 0; m < 4; ++m) {
        const int tok = EPI_ROW(u, ai, m);
        const float rs = rstd_of(rowss, tok);
        f32x4 acc[2][2][2];
#pragma unroll
        for (int bj = 0; bj < 2; ++bj)
#pragma unroll
          for (int n = 0; n < 2; ++n) acc[0][bj][n] = acc_in[ai][bj][m][n] * rs;
        if (u.pn < 4) {
#pragma unroll
          for (int bj = 0; bj < 2; ++bj) {
            const int head = 4 * u.pn + 2 * bj + (wc >> 1);
            rope_store(acc[0][bj][0], acc[0][bj][1], tok, d1, qn + (size_t)tok * DM + head * 64);
          }
        } else if (u.pn == 4) {
#pragma unroll
          for (int bj = 0; bj < 2; ++bj)
#pragma unroll
            for (int n = 0; n < 2; ++n) *(uint2*)(cbuf + (size_t)tok * 256 + (EPI_COL(u, bj, n) - 1024)) = pack4(acc[0][bj][n]);
        } else if (u.pn < 7) {
          u16* kdst = (u.pn == 5) ? ksb : kwb;
          u16* vdst = (u.pn == 5) ? vsT : vwT;
          const int gk = wc >> 1;
          rope_store(acc[0][0][0], acc[0][0][1], tok, d1, kdst + (size_t)tok * 128 + gk * 64);
          const int b = tok >> 12, t = tok & 4095;
#pragma unroll
          for (int n = 0; n < 2; ++n) {
            const int d = 32 * (wc & 1) + 16 * n + 4 * fq;
#pragma unroll
            for (int r = 0; r < 4; ++r) vdst[((size_t)(b * 2 + gk) * 64 + d + r) * SEQ + t] = f2bf(acc[0][1][n][r]);
          }
        } else {
#pragma unroll
          for (int n = 0; n < 2; ++n) {
            const int c = 32 * wc + 16 * n + 4 * fq;
            if (c < 48) {
              const f32x4 a = acc[0][0][n];
              float4 gv;
              gv.x = 1.f / (1.f + __expf(-a[0])); gv.y = 1.f / (1.f + __expf(-a[1]));
              gv.z = 1.f / (1.f + __expf(-a[2])); gv.w = 1.f / (1.f + __expf(-a[3]));
              *(float4*)(gbuf + (size_t)tok * 48 + c) = gv;
            }
          }
        }
      }
  }
};

template <class Epi>
__device__ __forceinline__ void run_gemm(u16* sm, const u16* A, const u16* Bt, int M, int N, int K, const Epi& E) {
  Gemm g; g.A = A; g.Bt = Bt; g.M = M; g.N = N; g.K = K;
  StaticOrder S; S.init(M, N, (int)gridDim.x, (int)blockIdx.x);
  gemm_phase(( LAS unsigned char*)sm, g, S, E);
}

template <class ARowF>
__device__ __forceinline__ void gemm_mainloop(f32x4 (&acc)[4][4], ARowF arow, int a_kstep, const u16* bt, int ldb, int nk, u16* sm) {
  const int tid = threadIdx.x, lane = tid & 63, wave = tid >> 6;
  const int wm = wave >> 1, wn = wave & 1;
  const int lc = tid & 7, lr = tid >> 3;
  const u16* pa[4]; const u16* pb[2];
#pragma unroll
  for (int i = 0; i < 4; ++i) pa[i] = arow(lr + 64 * i) + lc * 8;
#pragma unroll
  for (int i = 0; i < 2; ++i) pb[i] = bt + (size_t)(lr + 64 * i) * ldb + lc * 8;
  u16* sA = sm; u16* sB = sm + 2 * 256 * LDSP;
  uint4 ra[4], rb[2];
#pragma unroll
  for (int i = 0; i < 4; ++i) ra[i] = *(const uint4*)pa[i];
#pragma unroll
  for (int i = 0; i < 2; ++i) rb[i] = *(const uint4*)pb[i];
#pragma unroll
  for (int i = 0; i < 4; ++i) *(uint4*)(sA + (lr + 64 * i) * LDSP + lc * 8) = ra[i];
#pragma unroll
  for (int i = 0; i < 2; ++i) *(uint4*)(sB + (lr + 64 * i) * LDSP + lc * 8) = rb[i];
  __syncthreads();
  const int fr = lane & 15, fq = lane >> 4;
  for (int kt = 0; kt < nk; ++kt) {
    const bool more = (kt + 1 < nk);
    if (more) {
#pragma unroll
      for (int i = 0; i < 4; ++i) ra[i] = *(const uint4*)(pa[i] + (size_t)(kt + 1) * a_kstep);
#pragma unroll
      for (int i = 0; i < 2; ++i) rb[i] = *(const uint4*)(pb[i] + (size_t)(kt + 1) * 64);
    }
    const u16* cA = sA + (kt & 1) * 256 * LDSP + (wm * 64 + fr) * LDSP + fq * 8;
    const u16* cB = sB + (kt & 1) * 128 * LDSP + (wn * 64 + fr) * LDSP + fq * 8;
#pragma unroll
    for (int ks = 0; ks < 2; ++ks) {
      bf16x8 wf[4], xf[4];
#pragma unroll
      for (int i = 0; i < 4; ++i) {
        wf[i] = *(const bf16x8*)(cB + i * 16 * LDSP + ks * 32);
        xf[i] = *(const bf16x8*)(cA + i * 16 * LDSP + ks * 32);
      }
#pragma unroll
      for (int i = 0; i < 4; ++i)
#pragma unroll
        for (int j = 0; j < 4; ++j) acc[i][j] = mfma16(wf[i], xf[j], acc[i][j]);
    }
    if (more) {
      u16* dA = sA + ((kt + 1) & 1) * 256 * LDSP; u16* dB = sB + ((kt + 1) & 1) * 128 * LDSP;
#pragma unroll
      for (int i = 0; i < 4; ++i) *(uint4*)(dA + (lr + 64 * i) * LDSP + lc * 8) = ra[i];
#pragma unroll
      for (int i = 0; i < 2; ++i) *(uint4*)(dB + (lr + 64 * i) * LDSP + lc * 8) = rb[i];
    }
    __syncthreads();
  }
}

__device__ __forceinline__ void zero_acc(f32x4 (&acc)[4][4]) {
#pragma unroll
  for (int i = 0; i < 4; ++i)
#pragma unroll
    for (int j = 0; j < 4; ++j) acc[i][j] = (f32x4){0.f, 0.f, 0.f, 0.f};
}

__device__ __forceinline__ void phase_ffn_fix(const Params& p, int layer) {
  const float* cw = p.conv_w + (size_t)layer * 3 * NUP;
  const float* cb = p.conv_b + (size_t)layer * NUP;
  const int nitems = 512 * 2 * (DFF / 4);
  for (int it = blockIdx.x * NTHR + threadIdx.x; it < nitems; it += gridDim.x * NTHR) {
    const int f4 = it % (DFF / 4), cj = it / (DFF / 4), j = cj & 1, chunk = cj >> 1;
    const int f0 = f4 * 4;
    const int gc = 256 * (f0 >> 7) + (f0 & 127);
    const int t = chunk * 64 + j;
    const bool has_prev = ((chunk & 63) != 0);
    const float* cur = p.ub + (size_t)(chunk * 4) * NUP + gc;
    const float* prv = p.ub + (size_t)((has_prev ? chunk - 1 : chunk) * 4) * NUP + gc;
    const float pmask = has_prev ? 1.f : 0.f;
    const float* r1p = (j == 0) ? prv + (size_t)3 * NUP : cur;
    const float* r2p = (j == 0) ? prv + (size_t)2 * NUP : prv + (size_t)3 * NUP;
    const float m1 = (j == 0) ? pmask : 1.f, m2 = pmask;
    f32x4 g0 = *(const f32x4*)(cur + (size_t)j * NUP), v0 = *(const f32x4*)(cur + (size_t)j * NUP + 128);
    f32x4 g1 = *(const f32x4*)(r1p) * m1, v1 = *(const f32x4*)(r1p + 128) * m1;
    f32x4 g2 = *(const f32x4*)(r2p) * m2, v2 = *(const f32x4*)(r2p + 128) * m2;
    const f32x4 wg0 = *(const f32x4*)(cw + f0), wg1 = *(const f32x4*)(cw + NUP + f0), wg2 = *(const f32x4*)(cw + 2 * NUP + f0);
    const f32x4 wv0 = *(const f32x4*)(cw + DFF + f0), wv1 = *(const f32x4*)(cw + NUP + DFF + f0), wv2 = *(const f32x4*)(cw + 2 * NUP + DFF + f0);
    const f32x4 bg = *(const f32x4*)(cb + f0), bv = *(const f32x4*)(cb + DFF + f0);
    const f32x4 cg_ = bg + g2 * wg0 + g1 * wg1 + g0 * wg2;
    const f32x4 cv_ = bv + v2 * wv0 + v1 * wv1 + v0 * wv2;
    const float r0 = cg_[0] / (1.f + __expf(-cg_[0])) * cv_[0], r1 = cg_[1] / (1.f + __expf(-cg_[1])) * cv_[1];
    const float r2 = cg_[2] / (1.f + __expf(-cg_[2])) * cv_[2], r3 = cg_[3] / (1.f + __expf(-cg_[3])) * cv_[3];
    *(uint2*)(p.act + (size_t)t * DFF + f0) = make_uint2(pack2(r0, r1), pack2(r2, r3));
  }
}

__device__ __forceinline__ void phase_compress(const Params& p, u16* sm) {
  const int tid = threadIdx.x, lane = tid & 63, wave = tid >> 6, wm = wave >> 1, wn = wave & 1, fr = lane & 15, fq = lane >> 4;
  for (int tile = blockIdx.x; tile < 32; tile += gridDim.x) {
    const int which = tile & 1, mt = tile >> 1;
    const int m0 = mt * 256;
    const u16* w1t = which ? p.wt_cv1 : p.wt_ck1;
    const u16* w2t = which ? p.wt_cv2 : p.wt_ck2;
    const float* bias = p.bpart + which * 8 * 128;
    f32x4 acc[4][4]; zero_acc(acc);
    const u16* cb = p.cbuf + which * 128;
    gemm_mainloop(acc, [&](int r) {
      int row = m0 + r; int g = row & 1; int bc = row >> 1; int c = bc & 255; int b = bc >> 8;
      if (c > 254) c = 254;
      return cb + ((size_t)b * SEQ + c * 16) * 256 + g * 64;
    }, 256, w1t, 2048, 32, sm);
    u16* sH = sm; u16* sW = sm + 256 * 136;
#pragma unroll
    for (int i = 0; i < 4; ++i) {
      const int n = wn * 64 + i * 16 + fq * 4;
      float bb[4] = {0.f, 0.f, 0.f, 0.f};
#pragma unroll
      for (int c8 = 0; c8 < 8; ++c8) {
        const float4 bv = *(const float4*)(bias + c8 * 128 + n);
        bb[0] += bv.x; bb[1] += bv.y; bb[2] += bv.z; bb[3] += bv.w;
      }
#pragma unroll
      for (int j = 0; j < 4; ++j) {
        const int rl = wm * 64 + j * 16 + fr;
        f32x4 hv;
#pragma unroll
        for (int r = 0; r < 4; ++r) {
          float xv = acc[i][j][r] + bb[r];
          float inner = 0.7978845608028654f * (xv + 0.044715f * xv * xv * xv);
          hv[r] = 0.5f * xv * (1.f + tanhf(inner));
        }
        *(uint2*)(sH + rl * 136 + n) = pack4(hv);
      }
    }
    {
#pragma unroll
      for (int i = 0; i < 2; ++i) {
        int idx = tid + 512 * i; int r = idx >> 4, c = idx & 15;
        *(uint4*)(sW + r * 136 + c * 8) = *(const uint4*)(w2t + r * 128 + c * 8);
      }
    }
    __syncthreads();
    f32x4 o2[4][2];
#pragma unroll
    for (int dm = 0; dm < 4; ++dm) { o2[dm][0] = (f32x4){0.f, 0.f, 0.f, 0.f}; o2[dm][1] = (f32x4){0.f, 0.f, 0.f, 0.f}; }
#pragma unroll
    for (int ks = 0; ks < 4; ++ks) {
      bf16x8 hf[2];
#pragma unroll
      for (int j = 0; j < 2; ++j) hf[j] = *(const bf16x8*)(sH + (wave * 32 + j * 16 + fr) * 136 + ks * 32 + fq * 8);
#pragma unroll
      for (int dm = 0; dm < 4; ++dm) {
        bf16x8 wf = *(const bf16x8*)(sW + (dm * 16 + fr) * 136 + ks * 32 + fq * 8);
#pragma unroll
        for (int j = 0; j < 2; ++j) o2[dm][j] = mfma16(wf, hf[j], o2[dm][j]);
      }
    }
#pragma unroll
    for (int j = 0; j < 2; ++j) {
      const int row = m0 + wave * 32 + j * 16 + fr;
      const int g = row & 1, bc = row >> 1, c = bc & 255, b = bc >> 8;
      const bool valid = (c < 255);
      if (which == 0) {
        const int tok = b * SEQ + (valid ? c : 254) * 16 + 31;
        u16* dst = p.kc + ((size_t)(b * 2 + g) * 256 + c) * 64;
#pragma unroll
        for (int i = 0; i < 2; ++i) {
          const int d = i * 16 + fq * 4;
          const float4 cs01 = *(const float4*)(p.rope + (size_t)tok * 32 + d);
          const float4 cs23 = *(const float4*)(p.rope + (size_t)tok * 32 + d + 2);
          const float cc[4] = {cs01.x, cs01.z, cs23.x, cs23.z};
          const float ss[4] = {cs01.y, cs01.w, cs23.y, cs23.w};
          f32x4 o1, o2v;
#pragma unroll
          for (int r = 0; r < 4; ++r) {
            float x1 = o2[i][j][r], x2 = o2[i + 2][j][r];
            o1[r] = valid ? x1 * cc[r] - x2 * ss[r] : 0.f;
            o2v[r] = valid ? x2 * cc[r] + x1 * ss[r] : 0.f;
          }
          *(uint2*)(dst + d) = pack4(o1);
          *(uint2*)(dst + d + 32) = pack4(o2v);
        }
      } else {
#pragma unroll
        for (int dm = 0; dm < 4; ++dm)
#pragma unroll
          for (int r = 0; r < 4; ++r) {
            const int d = dm * 16 + fq * 4 + r;
            p.vcT[((size_t)(b * 2 + g) * 64 + d) * 256 + c] = valid ? f2bf(o2[dm][j][r]) : (u16)0;
          }
      }
    }
    __syncthreads();
  }
}

__device__ __forceinline__ int rho_row(int k) { return (k & 32) | ((k & 4) << 2) | ((k & 24) >> 1) | (k & 3); }

__device__ __forceinline__ void load_tile64(u16* s, const u16* src, size_t ld, bool perm) {
  const int c = threadIdx.x & 7, r0 = threadIdx.x >> 3;
  uint4 v0 = *(const uint4*)(src + (size_t)r0 * ld + c * 8);
  const int l0 = perm ? rho_row(r0) : r0;
  *(uint4*)(s + l0 * LDSP + c * 8) = v0;
}

__device__ __forceinline__ void phase_sba_attn(const Params& p, u16* sm) {
  const int tid = threadIdx.x, lane = tid & 63, wave = tid >> 6, fr = lane & 15, fq = lane >> 4;
  u16* sK0 = sm; u16* sV0 = sm + 64 * LDSP;
  bf16x8 tri[2], ones;
#pragma unroll
  for (int bb = 0; bb < 2; ++bb) {
    uint32_t w[4];
#pragma unroll
    for (int i2 = 0; i2 < 4; ++i2) {
      const int s_ = 8 * (fr >> 2) + 4 * bb + (fr & 3);
      const int j0 = 8 * fq + 2 * i2, j1 = j0 + 1;
      w[i2] = (j0 > s_ ? 0x3F80u : 0u) | ((j1 > s_ ? 0x3F80u : 0u) << 16);
    }
    tri[bb] = mk_frag(w[0], w[1], w[2], w[3]);
  }
  ones = mk_frag(0x3F803F80u, 0x3F803F80u, 0x3F803F80u, 0x3F803F80u);

  const int ntiles = 128 * 32;
  for (int tile = blockIdx.x; tile < ntiles; tile += gridDim.x) {
    const int qt = 31 - (tile >> 7), bh = tile & 127;
    const int b = bh >> 4, h = bh & 15;
    const int myq = qt * 128 + wave * 16 + fr;
    bf16x8 qf[2];
#pragma unroll
    for (int ks = 0; ks < 2; ++ks) qf[ks] = *(const bf16x8*)(p.qb + ((size_t)b * SEQ + myq) * DM + h * 64 + ks * 32 + fq * 8);
    f32x4 o[4];
#pragma unroll
    for (int dm = 0; dm < 4; ++dm) o[dm] = (f32x4){0.f, 0.f, 0.f, 0.f};
    float carry = 0.f;
    const int pc = tid & 7, pr = tid >> 3, prl = rho_row(pr);
    const u16* kbase = p.kb + ((size_t)b * SEQ) * DM + h * 64 + (size_t)pr * DM + pc * 8;
    const u16* vbase = p.vT + ((size_t)(b * 16 + h) * 64 + pr) * SEQ + pc * 8;
    uint4 rk = *(const uint4*)(kbase + (size_t)(2 * qt + 1) * 64 * DM);
    uint4 rv = *(const uint4*)(vbase + (2 * qt + 1) * 64);
    int buf = 0;
    for (int kt = 2 * qt + 1; kt >= 0; --kt) {
      u16* sK = sK0 + buf * 2 * 64 * LDSP; u16* sV = sV0 + buf * 2 * 64 * LDSP;
      *(uint4*)(sK + prl * LDSP + pc * 8) = rk;
      *(uint4*)(sV + pr * LDSP + pc * 8) = rv;
      if (kt > 0) { rk = *(const uint4*)(kbase + (size_t)(kt - 1) * 64 * DM); rv = *(const uint4*)(vbase + (kt - 1) * 64); }
      buf ^= 1;
      __syncthreads();
      const bool wave_idle = (kt * 64 >= qt * 128 + wave * 16 + 15) || (__ballot(carry >= -150.1f) == 0ull);
      if (!wave_idle) {
      f32x4 s[4];
#pragma unroll
      for (int mt = 0; mt < 4; ++mt) {
        s[mt] = (f32x4){0.f, 0.f, 0.f, 0.f};
#pragma unroll
        for (int ks = 0; ks < 2; ++ks) {
          bf16x8 kf = *(const bf16x8*)(sK + (mt * 16 + fr) * LDSP + ks * 32 + fq * 8);
          s[mt] = mfma16(kf, qf[ks], s[mt]);
        }
      }
      const bool tile_masked = (kt * 64 + 63 >= qt * 128 + wave * 16);
      constexpr float SBA_C = 0.125f * 1.4426950408889634f;
      float L[4][4], lb[4][4];
      unsigned vmask = 0xffffu;
      if (tile_masked) {
        vmask = 0;
#pragma unroll
        for (int mt = 0; mt < 4; ++mt)
#pragma unroll
          for (int j = 0; j < 4; ++j) {
            const float z = s[mt][j] * SBA_C;
            const int key = kt * 64 + 32 * (mt >> 1) + 8 * fq + 4 * (mt & 1) + j;
            const bool valid = key < myq;
            const float e = __builtin_amdgcn_exp2f(-fabsf(z));
            const float sp = fmaxf(z, 0.f) + __builtin_amdgcn_logf(1.f + e);
            L[mt][j] = valid ? -sp : 0.f;
            lb[mt][j] = z - sp;
            vmask |= (valid ? 1u : 0u) << (mt * 4 + j);
          }
      } else {
#pragma unroll
        for (int mt = 0; mt < 4; ++mt)
#pragma unroll
          for (int j = 0; j < 4; ++j) {
            const float z = s[mt][j] * SBA_C;
            const float e = __builtin_amdgcn_exp2f(-fabsf(z));
            const float sp = fmaxf(z, 0.f) + __builtin_amdgcn_logf(1.f + e);
            L[mt][j] = -sp;
            lb[mt][j] = z - sp;
          }
      }
      bf16x8 Lh[2], Ll[2];
#pragma unroll
      for (int k2 = 0; k2 < 2; ++k2) {
        uint32_t hw[4], lw[4];
#pragma unroll
        for (int e2 = 0; e2 < 4; ++e2) {
          const int mt = 2 * k2 + (e2 >> 1), j = (e2 & 1) * 2;
          hw[e2] = pack2(L[mt][j], L[mt][j + 1]);
          const float r0 = L[mt][j] - __uint_as_float(hw[e2] << 16), r1 = L[mt][j + 1] - __uint_as_float(hw[e2] & 0xffff0000u);
          lw[e2] = pack2(r0, r1);
        }
        Lh[k2] = mk_frag(hw[0], hw[1], hw[2], hw[3]);
        Ll[k2] = mk_frag(lw[0], lw[1], lw[2], lw[3]);
      }
      f32x4 cum[4];
#pragma unroll
      for (int ms = 0; ms < 4; ++ms) {
        const int a = ms >> 1, bb = ms & 1;
        f32x4 c = (f32x4){0.f, 0.f, 0.f, 0.f};
        c = mfma16(tri[bb], Lh[a], c);
        c = mfma16(tri[bb], Ll[a], c);
        if (a == 0) { c = mfma16(ones, Lh[1], c); c = mfma16(ones, Ll[1], c); }
        cum[ms] = c;
      }
      float tot = cum[0][0] + L[0][0];
      tot = __shfl(tot, fr);
      bf16x8 pf[2];
#pragma unroll
      for (int k2 = 0; k2 < 2; ++k2) {
        uint32_t pw[4];
#pragma unroll
        for (int e2 = 0; e2 < 4; ++e2) {
          const int mt = 2 * k2 + (e2 >> 1), j = (e2 & 1) * 2;
          float p0 = __builtin_amdgcn_exp2f(lb[mt][j] + cum[mt][j] + carry);
          float p1 = __builtin_amdgcn_exp2f(lb[mt][j + 1] + cum[mt][j + 1] + carry);
          if (tile_masked) {
            p0 = ((vmask >> (mt * 4 + j)) & 1u) ? p0 : 0.f;
            p1 = ((vmask >> (mt * 4 + j + 1)) & 1u) ? p1 : 0.f;
          }
          pw[e2] = pack2(p0, p1);
        }
        pf[k2] = mk_frag(pw[0], pw[1], pw[2], pw[3]);
      }
#pragma unroll
      for (int k2 = 0; k2 < 2; ++k2)
#pragma unroll
        for (int dm = 0; dm < 4; ++dm) {
          bf16x8 vf = *(const bf16x8*)(sV + (dm * 16 + fr) * LDSP + k2 * 32 + fq * 8);
          o[dm] = mfma16(vf, pf[k2], o[dm]);
        }
      carry += tot;
      }
      if (__syncthreads_and(carry < -150.1f)) break;
    }
#pragma unroll
    for (int dm = 0; dm < 4; ++dm)
      *(uint2*)(p.ob + ((size_t)b * SEQ + myq) * DM + h * 64 + dm * 16 + fq * 4) = pack4(o[dm]);
  }
}

struct NsaState {
  f32x4 acc[2][4];
  f32x4 accL[2];
  float m[2], l[2];
};

__device__ __forceinline__ void nsa_qk(f32x4 (&s)[2][4], const u16* sK, const bf16x8 (&qf)[2][2], int fr, int fq) {
#pragma unroll
  for (int mt = 0; mt < 4; ++mt) {
    s[0][mt] = (f32x4){0.f, 0.f, 0.f, 0.f}; s[1][mt] = (f32x4){0.f, 0.f, 0.f, 0.f};
#pragma unroll
    for (int ks = 0; ks < 2; ++ks) {
      bf16x8 kf = *(const bf16x8*)(sK + (mt * 16 + fr) * LDSP + ks * 32 + fq * 8);
      s[0][mt] = mfma16(kf, qf[0][ks], s[0][mt]);
      s[1][mt] = mfma16(kf, qf[1][ks], s[1][mt]);
    }
  }
}

__device__ __forceinline__ void nsa_pv(f32x4 (&acc)[2][4], const u16* sV, const bf16x8 (&pf)[2][2], int fr, int fq) {
#pragma unroll
  for (int k2 = 0; k2 < 2; ++k2)
#pragma unroll
    for (int dm = 0; dm < 4; ++dm) {
      bf16x8 vf = *(const bf16x8*)(sV + (dm * 16 + fr) * LDSP + k2 * 32 + fq * 8);
      acc[0][dm] = mfma16(vf, pf[0][k2], acc[0][dm]);
      acc[1][dm] = mfma16(vf, pf[1][k2], acc[1][dm]);
    }
}

constexpr float SM_C = 0.125f * 1.4426950408889634f;
template <bool MASKED>
__device__ __forceinline__ void nsa_online_step(NsaState& st, f32x4 (&s)[2][4], unsigned vmask, bool lanevalid, const u16* sV, int fr, int fq) {
  bf16x8 pf[2][2];
  const uint32_t lmask = lanevalid ? 0xffffffffu : 0u;
  const bf16x8 ones = mk_frag(0x3F803F80u, 0x3F803F80u, 0x3F803F80u, 0x3F803F80u);
  constexpr float DEFER = 8.f / SM_C;
#pragma unroll
  for (int hh = 0; hh < 2; ++hh) {
    float tmax = -1e30f;
    if (MASKED) {
#pragma unroll
      for (int mt = 0; mt < 4; ++mt)
#pragma unroll
        for (int j = 0; j < 4; ++j) {
          const float sc = ((vmask >> (mt * 4 + j)) & 1u) ? s[hh][mt][j] : -1e30f;
          s[hh][mt][j] = sc;
          tmax = fmaxf(tmax, sc);
        }
    } else {
#pragma unroll
      for (int mt = 0; mt < 4; ++mt)
#pragma unroll
        for (int j = 0; j < 4; ++j) tmax = fmaxf(tmax, s[hh][mt][j]);
      tmax = lanevalid ? tmax : -1e30f;
    }
    tmax = fmaxf(tmax, __shfl_xor(tmax, 16));
    tmax = fmaxf(tmax, __shfl_xor(tmax, 32));
    const bool upd = tmax > st.m[hh] + DEFER;
    if (__ballot(upd) != 0ull) {
      const float mnew = upd ? tmax : st.m[hh];
      const float alpha = __builtin_amdgcn_exp2f((st.m[hh] - mnew) * SM_C);
      st.m[hh] = mnew;
#pragma unroll
      for (int dm = 0; dm < 4; ++dm) st.acc[hh][dm] *= alpha;
      st.accL[hh] *= alpha;
    }
    const float nb = -st.m[hh] * SM_C;
#pragma unroll
    for (int k2 = 0; k2 < 2; ++k2) {
      uint32_t pw[4];
#pragma unroll
      for (int e2 = 0; e2 < 4; ++e2) {
        const int mt = 2 * k2 + (e2 >> 1), j = (e2 & 1) * 2;
        float p0 = __builtin_amdgcn_exp2f(__builtin_fmaf(s[hh][mt][j], SM_C, nb));
        float p1 = __builtin_amdgcn_exp2f(__builtin_fmaf(s[hh][mt][j + 1], SM_C, nb));
        if (MASKED) {
          p0 = ((vmask >> (mt * 4 + j)) & 1u) ? p0 : 0.f;
          p1 = ((vmask >> (mt * 4 + j + 1)) & 1u) ? p1 : 0.f;
        }
        pw[e2] = pack2(p0, p1);
        if (!MASKED) pw[e2] &= lmask;
      }
      pf[hh][k2] = mk_frag(pw[0], pw[1], pw[2], pw[3]);
      st.accL[hh] = mfma16(ones, pf[hh][k2], st.accL[hh]);
    }
#pragma unroll
    for (int k2 = 0; k2 < 2; ++k2)
#pragma unroll
      for (int dm = 0; dm < 4; ++dm) {
        const bf16x8 vf = *(const bf16x8*)(sV + (dm * 16 + fr) * LDSP + k2 * 32 + fq * 8);
        st.acc[hh][dm] = mfma16(vf, pf[hh][k2], st.acc[hh][dm]);
      }
  }
}

__device__ __forceinline__ void nsa_reset(NsaState& st) {
#pragma unroll
  for (int hh = 0; hh < 2; ++hh) {
    st.m[hh] = -1e30f; st.l[hh] = 0.f; st.accL[hh] = (f32x4){0.f, 0.f, 0.f, 0.f};
#pragma unroll
    for (int dm = 0; dm < 4; ++dm) st.acc[hh][dm] = (f32x4){0.f, 0.f, 0.f, 0.f};
  }
}

__device__ __forceinline__ void nsa_finish(NsaState& st, f32x4 (&out)[2][4], const float (&gate)[2]) {
#pragma unroll
  for (int hh = 0; hh < 2; ++hh) {
    const float l = st.accL[hh][0];
    const float sc = (l > 0.f) ? gate[hh] / l : 0.f;
#pragma unroll
    for (int dm = 0; dm < 4; ++dm) out[hh][dm] += st.acc[hh][dm] * sc;
  }
}

__device__ __forceinline__ void phase_nsa_cmp(const Params& p, u16* sm) {
  const int tid = threadIdx.x, lane = tid & 63, wave = tid >> 6, fr = lane & 15, fq = lane >> 4;
  const int wq = wave & 3, qh = wave >> 2;
  u16* sKall = sm; u16* sVall = sm + 4 * 64 * LDSP;
  unsigned* PsumU = (unsigned*)(sm + 8 * 64 * LDSP);
  float* Imp = (float*)(PsumU + 32 * 260);
  const int ntiles = 16 * 128;
  for (int tile = blockIdx.x; tile < ntiles; tile += gridDim.x) {
    int qb = 127 - (tile >> 4), bg = tile & 15;
    if (gridDim.x == 256) {
      const int k = 7 - (tile >> 8), r = (int)blockIdx.x >> 4;
      qb = 32 * (k >> 1) + ((k & 1) ? 31 - r : r);
      bg = (int)blockIdx.x & 15;
    }
    const int b = bg >> 1, g = bg & 1;
    const int t0 = qb * 32, myt = t0 + 16 * qh + fr;
    const size_t tokbase = (size_t)b * SEQ;
    const int hA = g * 8 + wq * 2;
    bf16x8 qf[2][2];
#pragma unroll
    for (int hh = 0; hh < 2; ++hh)
#pragma unroll
      for (int ks = 0; ks < 2; ++ks)
        qf[hh][ks] = *(const bf16x8*)(p.qn + (tokbase + myt) * DM + (hA + hh) * 64 + ks * 32 + fq * 8);
    float gate0[2];
#pragma unroll
    for (int hh = 0; hh < 2; ++hh) gate0[hh] = p.gbuf[(tokbase + myt) * 48 + (hA + hh) * 3 + 0];

#pragma unroll
    for (int i = 0; i < 17; ++i) { int idx = tid + 512 * i; if (idx < 32 * 260) PsumU[idx] = 0u; }

    const u16* kcb = p.kc + (size_t)(b * 2 + g) * 256 * 64;
    const u16* vcb = p.vcT + (size_t)(b * 2 + g) * 64 * 256;
    const int ncmp = (t0 >> 4) + 1;
    const int nct = (ncmp + 63) >> 6;
    NsaState st;
    f32x4 s[2][4];
    for (int kt = 0; kt < nct; ++kt) {
      load_tile64(sKall + kt * 64 * LDSP, kcb + (size_t)kt * 64 * 64, 64, true);
      load_tile64(sVall + kt * 64 * LDSP, vcb + kt * 64, 256, false);
    }
    __syncthreads();
    nsa_reset(st);
    for (int kt = 0; kt < nct; ++kt) {
      const u16* sK = sKall + kt * 64 * LDSP;
      nsa_qk(s, sK, qf, fr, fq);
      unsigned vmask = 0;
#pragma unroll
      for (int mt = 0; mt < 4; ++mt)
#pragma unroll
        for (int j = 0; j < 4; ++j) {
          const int c = kt * 64 + 32 * (mt >> 1) + 8 * fq + 4 * (mt & 1) + j;
          vmask |= ((16 * c + 31 <= myt) ? 1u : 0u) << (mt * 4 + j);
        }
#pragma unroll
      for (int hh = 0; hh < 2; ++hh) {
        float tmax = -1e30f;
#pragma unroll
        for (int mt = 0; mt < 4; ++mt)
#pragma unroll
          for (int j = 0; j < 4; ++j) {
            const float sc = ((vmask >> (mt * 4 + j)) & 1u) ? s[hh][mt][j] * 0.125f : -1e30f;
            s[hh][mt][j] = sc; tmax = fmaxf(tmax, sc);
          }
        tmax = fmaxf(tmax, __shfl_xor(tmax, 16));
        tmax = fmaxf(tmax, __shfl_xor(tmax, 32));
        const float mnew = fmaxf(st.m[hh], tmax);
        float psum = 0.f;
#pragma unroll
        for (int mt = 0; mt < 4; ++mt)
#pragma unroll
          for (int j = 0; j < 4; ++j) psum += ((vmask >> (mt * 4 + j)) & 1u) ? __expf(s[hh][mt][j] - mnew) : 0.f;
        st.l[hh] = st.l[hh] * __expf(st.m[hh] - mnew) + psum;
        st.m[hh] = mnew;
      }
    }
    float invl[2];
#pragma unroll
    for (int hh = 0; hh < 2; ++hh) {
      float l = st.l[hh];
      l += __shfl_xor(l, 16);
      l += __shfl_xor(l, 32);
      invl[hh] = (l > 0.f) ? 1.f / l : 0.f;
    }
    for (int kt = 0; kt < nct; ++kt) {
      const u16* sK = sKall + kt * 64 * LDSP;
      const u16* sV = sVall + kt * 64 * LDSP;
      nsa_qk(s, sK, qf, fr, fq);
      bf16x8 pf[2][2];
      float pp[4][4];
#pragma unroll
      for (int mt = 0; mt < 4; ++mt)
#pragma unroll
        for (int j = 0; j < 4; ++j) pp[mt][j] = 0.f;
#pragma unroll
      for (int hh = 0; hh < 2; ++hh) {
#pragma unroll
        for (int k2 = 0; k2 < 2; ++k2) {
          uint32_t pw[4];
#pragma unroll
          for (int e2 = 0; e2 < 4; ++e2) {
            const int mt = 2 * k2 + (e2 >> 1), j = (e2 & 1) * 2;
            const int c0 = kt * 64 + 32 * (mt >> 1) + 8 * fq + 4 * (mt & 1) + j;
            float p0 = (16 * c0 + 31 <= myt) ? __expf(s[hh][mt][j] * 0.125f - st.m[hh]) * invl[hh] : 0.f;
            float p1 = (16 * (c0 + 1) + 31 <= myt) ? __expf(s[hh][mt][j + 1] * 0.125f - st.m[hh]) * invl[hh] : 0.f;
            pp[mt][j] += p0; pp[mt][j + 1] += p1;
            pw[e2] = pack2(p0, p1);
          }
          pf[hh][k2] = mk_frag(pw[0], pw[1], pw[2], pw[3]);
        }
#pragma unroll
        for (int k2 = 0; k2 < 2; ++k2)
#pragma unroll
          for (int dm = 0; dm < 4; ++dm) {
            const bf16x8 vf = *(const bf16x8*)(sV + (dm * 16 + fr) * LDSP + k2 * 32 + fq * 8);
            st.acc[hh][dm] = mfma16(vf, pf[hh][k2], st.acc[hh][dm]);
          }
      }
#pragma unroll
      for (int mt = 0; mt < 4; ++mt)
#pragma unroll
        for (int j = 0; j < 4; ++j) {
          const int c = kt * 64 + 32 * (mt >> 1) + 8 * fq + 4 * (mt & 1) + j;
          atomicAdd(&PsumU[(16 * qh + fr) * 260 + c], (unsigned)(pp[mt][j] * 268435456.f + 0.5f));
        }
    }
#pragma unroll
    for (int hh = 0; hh < 2; ++hh)
#pragma unroll
      for (int dm = 0; dm < 4; ++dm)
        *(uint2*)(p.ocp + (tokbase + myt) * DM + (hA + hh) * 64 + dm * 16 + fq * 4) = pack4(st.acc[hh][dm] * gate0[hh]);
    __syncthreads();
#pragma unroll
    for (int e = 0; e < 4; ++e) {
      const int idx = tid + 512 * e, q = idx >> 6, n = idx & 63;
      const unsigned* Pq = PsumU + q * 260 + 4 * n;
      const float sc28 = 1.f / 268435456.f;
      float v = ((float)Pq[0] + (float)Pq[1] + (float)Pq[2] + 0.5f * ((float)Pq[3] + (n > 0 ? (float)Pq[-1] : 0.f))) * sc28;
      Imp[q * 64 + n] = v;
    }
    __syncthreads();
#pragma unroll
    for (int qi = 0; qi < 4; ++qi) {
      const int q = wave * 4 + qi, tq = t0 + q, cur = tq >> 6, n = lane;
      const bool causal = (n <= cur);
      const bool forced = (n == 0) || (n == cur) || (n == cur - 1);
      const float sc = causal ? (Imp[q * 64 + n] + (forced ? 1e4f : 0.f)) : -1e30f;
      int rank = 0;
      Imp[q * 64 + n] = sc;
      __builtin_amdgcn_wave_barrier();
#pragma unroll 8
      for (int n2 = 0; n2 < 64; ++n2) {
        const float s2 = Imp[q * 64 + n2];
        rank += ((s2 > sc) || (s2 == sc && n2 < n)) ? 1 : 0;
      }
      const unsigned long long mk = __ballot(causal && rank < 16);
      if (lane == 0) p.msk[(size_t)(b * 2 + g) * SEQ + tq] = mk;
    }
    __syncthreads();
  }
}

__device__ __forceinline__ void phase_nsa_sw(const Params& p, u16* sm) {
  const int tid = threadIdx.x, lane = tid & 63, wave = tid >> 6, fr = lane & 15, fq = lane >> 4;
  const int wq = wave & 3, qh = wave >> 2;
  u16* sK = sm; u16* sV = sm + 64 * LDSP;
  int* lst = (int*)(sm + 4 * 64 * LDSP);
  uint2* selL = (uint2*)(sm + 4 * 64 * LDSP + 256) + wave * 512 + lane;
  const int ntiles = 16 * 128;
  for (int tile = blockIdx.x; tile < ntiles; tile += gridDim.x) {
    int qb = 127 - (tile >> 4), bg = tile & 15;
    if (gridDim.x == 256) {
      const int k = 7 - (tile >> 8), r = (int)blockIdx.x >> 4;
      qb = 32 * (k >> 1) + ((k & 1) ? 31 - r : r);
      bg = (int)blockIdx.x & 15;
    }
    const int b = bg >> 1, g = bg & 1;
    const int t0 = qb * 32, myt = t0 + 16 * qh + fr;
    const size_t tokbase = (size_t)b * SEQ;
    const int hA = g * 8 + wq * 2;
    bf16x8 qf[2][2];
#pragma unroll
    for (int hh = 0; hh < 2; ++hh)
#pragma unroll
      for (int ks = 0; ks < 2; ++ks)
        qf[hh][ks] = *(const bf16x8*)(p.qn + (tokbase + myt) * DM + (hA + hh) * 64 + ks * 32 + fq * 8);
    float gates[2][3];
#pragma unroll
    for (int hh = 0; hh < 2; ++hh)
#pragma unroll
      for (int r = 0; r < 3; ++r) gates[hh][r] = p.gbuf[(tokbase + myt) * 48 + (hA + hh) * 3 + r];
    NsaState st;
    f32x4 s[2][4];
    const unsigned long long* mskp = p.msk + (size_t)(b * 2 + g) * SEQ + t0;
    const unsigned long long mymask = mskp[16 * qh + fr];
    unsigned long long um = 0;
#pragma unroll
    for (int q = 0; q < 32; ++q) um |= mskp[q];
    const u16* ksb = p.ksb + tokbase * 128 + g * 64;
    const u16* vsb = p.vsT + (size_t)(b * 2 + g) * 64 * SEQ;
    const u16* kwb = p.kwb + tokbase * 128 + g * 64;
    const u16* vwb = p.vwT + (size_t)(b * 2 + g) * 64 * SEQ;
    const int kt_lo = (t0 >= 511) ? ((t0 - 511) >> 6) : 0, kt_hi = (t0 + 31) >> 6;
    const int nsel = __popcll(um), ntl = nsel + (kt_hi - kt_lo + 1);
    if (tid < 64) {
      if ((um >> tid) & 1ull) lst[__popcll(um & ((1ull << tid) - 1ull))] = tid;
      if (tid <= kt_hi - kt_lo) lst[nsel + tid] = 64 + kt_lo + tid;
    }
    __syncthreads();
    const int pc = tid & 7, pr = tid >> 3, prl = rho_row(pr);
    uint4 rkA, rvA;
#define NSA_FETCH(rk, rv, e) do { const int v_ = lst[(e)]; \
      const u16* kp_ = (v_ < 64) ? ksb + (size_t)v_ * 64 * 128 : kwb + (size_t)(v_ - 64) * 64 * 128; \
      const u16* vp_ = (v_ < 64) ? vsb + v_ * 64 : vwb + (v_ - 64) * 64; \
      rk = *(const uint4*)(kp_ + (size_t)pr * 128 + pc * 8); rv = *(const uint4*)(vp_ + (size_t)pr * SEQ + pc * 8); } while (0)
#define NSA_PUT(rk, rv, buf) do { *(uint4*)(sK + (buf) * 2 * 64 * LDSP + prl * LDSP + pc * 8) = rk; \
      *(uint4*)(sV + (buf) * 2 * 64 * LDSP + pr * LDSP + pc * 8) = rv; } while (0)
    NSA_FETCH(rkA, rvA, 0);
    NSA_PUT(rkA, rvA, 0);
    if (ntl > 1) NSA_FETCH(rkA, rvA, 1);
    nsa_reset(st);
    for (int i = 0; i < ntl; ++i) {
      __syncthreads();
      const int v = lst[i];
      const u16* cK = sK + (i & 1) * 2 * 64 * LDSP;
      const u16* cV = sV + (i & 1) * 2 * 64 * LDSP;
      if (i == nsel) {
        f32x4 tmp[2][4];
#pragma unroll
        for (int hh = 0; hh < 2; ++hh)
#pragma unroll
          for (int dm = 0; dm < 4; ++dm) tmp[hh][dm] = (f32x4){0.f, 0.f, 0.f, 0.f};
        const float gg[2] = {gates[0][1], gates[1][1]};
        nsa_finish(st, tmp, gg);
#pragma unroll
        for (int hh = 0; hh < 2; ++hh)
#pragma unroll
          for (int dm = 0; dm < 4; ++dm) selL[(hh * 4 + dm) * 64] = pack4(tmp[hh][dm]);
        nsa_reset(st);
      }
      nsa_qk(s, cK, qf, fr, fq);
      {
        const bool is_sel = (v < 64);
        const int kt = is_sel ? v : v - 64;
        const bool lv = is_sel ? (bool)((mymask >> v) & 1ull) : true;
        const bool masked = is_sel ? (v == (t0 >> 6)) : !((64 * kt + 63 <= t0) && (64 * kt >= t0 - 480));
        if (masked) {
          const int wnd = is_sel ? (1 << 30) : 512;
          unsigned vmask = 0;
#pragma unroll
          for (int mt = 0; mt < 4; ++mt)
#pragma unroll
            for (int j = 0; j < 4; ++j) {
              const int key = kt * 64 + 32 * (mt >> 1) + 8 * fq + 4 * (mt & 1) + j;
              const int diff = myt - key;
              vmask |= ((lv && diff >= 0 && diff < wnd) ? 1u : 0u) << (mt * 4 + j);
            }
          nsa_online_step<true>(st, s, vmask, true, cV, fr, fq);
        } else {
          nsa_online_step<false>(st, s, 0u, lv, cV, fr, fq);
        }
      }
      if (i + 1 < ntl) NSA_PUT(rkA, rvA, (i + 1) & 1);
      if (i + 2 < ntl) NSA_FETCH(rkA, rvA, i + 2);
    }
#undef NSA_FETCH
#undef NSA_PUT
    f32x4 out[2][4];
#pragma unroll
    for (int hh = 0; hh < 2; ++hh)
#pragma unroll
      for (int dm = 0; dm < 4; ++dm) {
        const uint2 pv = *(const uint2*)(p.ocp + (tokbase + myt) * DM + (hA + hh) * 64 + dm * 16 + fq * 4);
        const uint2 sv = selL[(hh * 4 + dm) * 64];
        out[hh][dm] = (f32x4){bf2f((u16)(pv.x & 0xffff)) + bf2f((u16)(sv.x & 0xffff)), bf2f((u16)(pv.x >> 16)) + bf2f((u16)(sv.x >> 16)),
                              bf2f((u16)(pv.y & 0xffff)) + bf2f((u16)(sv.y & 0xffff)), bf2f((u16)(pv.y >> 16)) + bf2f((u16)(sv.y >> 16))};
      }
    {
      const float gg[2] = {gates[0][2], gates[1][2]};
      nsa_finish(st, out, gg);
    }
#pragma unroll
    for (int hh = 0; hh < 2; ++hh)
#pragma unroll
      for (int dm = 0; dm < 4; ++dm)
        *(uint2*)(p.ob + (tokbase + myt) * DM + (hA + hh) * 64 + dm * 16 + fq * 4) = pack4(out[hh][dm]);
    __syncthreads();
  }
}

__device__ __forceinline__ void run_phase(const Params& p, const int ph, u16* sm) {
  switch (ph) {
    case 0: phase_prep(p, sm); break;
    case 1: { EpiSbaQkv e; e.qb = p.qb; e.kb = p.kb; e.vT = p.vT; run_gemm(sm, p.hn, p.wt_sba_in, NTOK, 3072, DM, e); } break;
    case 2: phase_sba_attn(p, sm); break;
    case 3: { EpiResidB<true> e; e.resid32 = p.x; e.xb = p.xb; e.rowss = p.rowss; run_gemm(sm, p.ob, p.wt_sba_out, NTOK, DM, DM, e); } break;
    case 5: { EpiUpConv e; e.act = p.act; e.ub = p.ub; e.rowss = p.rowss; e.cw = p.conv_w; e.cb = p.conv_b; run_gemm(sm, p.xb, p.wt_up0, NTOK, NUP, DM, e); } break;
    case 6: phase_ffn_fix(p, 0); break;
    case 7: { EpiResidB<false> e; e.resid32 = nullptr; e.xb = p.xb; e.rowss = p.rowss + NTOK; run_gemm(sm, p.act, p.wt_down0, NTOK, DM, DFF, e); } break;
    case 12: { EpiNsaIn e; e.qn = p.qn; e.cbuf = p.cbuf; e.ksb = p.ksb; e.kwb = p.kwb; e.vsT = p.vsT; e.vwT = p.vwT; e.gbuf = p.gbuf; e.rope = p.rope; e.rowss = p.rowss + NTOK;
               run_gemm(sm, p.xb, p.wt_nsa_in, NTOK, NSAWP, DM, e); } break;
    case 13: phase_compress(p, sm); break;
    case 14: phase_nsa_cmp(p, sm); __threadfence(); __syncthreads(); phase_nsa_sw(p, sm); break;
    case 16: { EpiResidB<false> e; e.resid32 = nullptr; e.xb = p.xb; e.rowss = p.rowss + 2 * NTOK; run_gemm(sm, p.ob, p.wt_nsa_out, NTOK, DM, DM, e); } break;
    case 18: { EpiUpConv e; e.act = p.act; e.ub = p.ub; e.rowss = p.rowss + 2 * NTOK; e.cw = p.conv_w + (size_t)3 * NUP; e.cb = p.conv_b + NUP; run_gemm(sm, p.xb, p.wt_up1, NTOK, NUP, DM, e); } break;
    case 19: phase_ffn_fix(p, 1); break;
    case 20: { EpiResidLast e; e.xb = p.xb; e.out = p.out; run_gemm(sm, p.act, p.wt_down1, NTOK, DM, DFF, e); } break;
    case 24: phase_final_norm(p.out, p.norm_final); break;
    default: break;
  }
}

#ifndef PROBE_REP
#define PROBE_REP 0u
#endif
#define GRID_BAR() grid_barrier((unsigned*)(ka.ws + O_BAR), (volatile LAS unsigned*)&xb_words, bar_k++)
#define PHASE_SEQ(n) if (p.phase_lo <= (n) && (n) <= p.phase_hi) { \
    if ((PROBE_REP >> (n)) & 1u) { run_phase(p, (n), sm); GRID_BAR(); } \
    run_phase(p, (n), sm); if ((n) < p.phase_hi) { if ((n) == 0) { cg::this_grid().sync(); if (threadIdx.x == 0) xb_census((unsigned*)(ka.ws + O_BAR), (volatile LAS unsigned*)&xb_words); __syncthreads(); } else GRID_BAR(); } }
__global__ void __launch_bounds__(512, 2) hybrid_megakernel(KArgs ka) {
  const Params p = make_params(ka);
  __shared__ __attribute__((aligned(16))) u16 sm[SMEM_BYTES / 2];
  unsigned bar_k = 0;
  __shared__ uint4 xb_words;
  if (threadIdx.x == 0 && p.phase_lo < p.phase_hi) xb_post((unsigned*)(ka.ws + O_BAR));
  PHASE_SEQ(0) PHASE_SEQ(1) PHASE_SEQ(2) PHASE_SEQ(3) PHASE_SEQ(5) PHASE_SEQ(6) PHASE_SEQ(7)
  PHASE_SEQ(12) PHASE_SEQ(13) PHASE_SEQ(14)
  PHASE_SEQ(16) PHASE_SEQ(18) PHASE_SEQ(19) PHASE_SEQ(20)
  PHASE_SEQ(24)
}

extern "C" void kernel_launch(void* const* d_in, const int* in_sizes, int n_in, void* d_out, int out_size, void* d_ws,
                              size_t ws_size, hipStream_t stream) {
  KArgs p;
  memset(&p, 0, sizeof(p));
  for (int i = 0; i < 19; ++i) p.in[i] = d_in[i];
  p.out = (float*)d_out;
  p.ws = (char*)d_ws;
  if (ws_size < WS_NEEDED) fprintf(stderr, "workspace too small: %zu < %zu\n", ws_size, (size_t)WS_NEEDED);

  static int grid_blocks = 0;
  if (!grid_blocks) {
    int dev = 0, cus = 0, per_cu = 0;
    hipGetDevice(&dev);
    hipDeviceGetAttribute(&cus, hipDeviceAttributeMultiprocessorCount, dev);
    hipOccupancyMaxActiveBlocksPerMultiprocessor(&per_cu, hybrid_megakernel, NTHR, 0);
    if (per_cu > 1) per_cu = 1;
    if (per_cu < 1) per_cu = 1;
    grid_blocks = cus * per_cu;
  }
#if ONE_LAUNCH
  p.phase_lo = 0; p.phase_hi = NPHASE - 1;
  hipMemsetAsync((char*)d_ws + O_BAR, 0, XCD_BAR_WORDS * 4, stream);
  void* args[] = {&p};
  hipError_t e = hipLaunchCooperativeKernel((void*)hybrid_megakernel, dim3(grid_blocks), dim3(NTHR), args, 0, stream);
  if (e != hipSuccess) fprintf(stderr, "cooperative launch failed: %s (grid %d)\n", hipGetErrorString(e), grid_blocks);
#else
  for (int ph = 0; ph < NPHASE; ++ph) {
    p.phase_lo = ph; p.phase_hi = ph;
    hipLaunchKernelGGL(hybrid_megakernel, dim3(grid_blocks), dim3(NTHR), 0, stream, p);
  }
#endif
}
```

```cpp
#include <hip/hip_runtime.h>
#include <hip/hip_cooperative_groups.h>
#include <stdint.h>
#include <string.h>
#include <stdio.h>
namespace cg = cooperative_groups;

#ifndef ONE_LAUNCH
#define ONE_LAUNCH 1
#endif

typedef unsigned short u16;
typedef __attribute__((ext_vector_type(8))) short bf16x8;
typedef __attribute__((ext_vector_type(4))) float f32x4;

constexpr int SEQ = 4096, DM = 1024, NTOK = 8 * 4096, DFF = 2816, NUP = 5632;
constexpr int NSAWP = 2048;
constexpr int HALF_TOK = NTOK / 2;
constexpr int LDSP = 72;
constexpr int NPHASE = 25;
constexpr int SMEM_BYTES = 131072;
constexpr int NTHR = 512;


struct Params {
  const float* x; const int* pos; const float* norm_mix; const float* sba_w_in; const float* sba_w_out;
  const float* nsa_w_in; const float* pe_k; const float* pe_v; const float* ck_w1; const float* ck_w2;
  const float* cv_w1; const float* cv_w2; const float* nsa_w_out; const float* norm_ffn; const float* w_up;
  const float* conv_w; const float* conv_b; const float* w_down; const float* norm_final;
  float* out;
  u16 *wt_sba_in, *wt_sba_out, *wt_nsa_in, *wt_nsa_out, *wt_up0, *wt_up1, *wt_down0, *wt_down1, *wt_ck1, *wt_cv1, *wt_ck2, *wt_cv2;
  float *bpart; float2* rope; unsigned long long* rowss; u16* xb;
  u16* hn;
  u16 *qb, *kb, *vT;
  u16 *qn, *cbuf, *ksb, *kwb, *vsT, *vwT, *kc, *vcT; float* gbuf; unsigned long long* msk; u16* ocp;
  float* ub;
  u16* ob;
  u16* act;
  int phase_lo, phase_hi;
  int pad_;
};

__device__ __forceinline__ u16 f2bf(float f) {
  uint32_t u = __float_as_uint(f);
  u += 0x7fffu + ((u >> 16) & 1u);
  return (u16)(u >> 16);
}
typedef float f32x2_t __attribute__((ext_vector_type(2)));
typedef __bf16 bf16x2_t __attribute__((ext_vector_type(2)));
__device__ __forceinline__ uint32_t pack2(float a, float b) {
  f32x2_t v = {a, b};
  bf16x2_t h = __builtin_convertvector(v, bf16x2_t);
  return __builtin_bit_cast(uint32_t, h);
}
__device__ __forceinline__ float bf2f(u16 h) { return __uint_as_float(((uint32_t)h) << 16); }
__device__ __forceinline__ uint2 pack4(f32x4 v) { return make_uint2(pack2(v[0], v[1]), pack2(v[2], v[3])); }
__device__ __forceinline__ f32x4 mfma16(bf16x8 a, bf16x8 b, f32x4 c) {
  return __builtin_amdgcn_mfma_f32_16x16x32_bf16(a, b, c, 0, 0, 0);
}
__device__ __forceinline__ bf16x8 mk_frag(uint32_t a, uint32_t b, uint32_t c, uint32_t d) {
  union { uint4 u; bf16x8 v; } t; t.u = make_uint4(a, b, c, d); return t.v;
}

#define XCD_BAR_WORDS 3456
constexpr size_t al256(size_t x) { return (x + 255) & ~(size_t)255; }
constexpr size_t MB = 1024 * 1024;
constexpr size_t O_WT_SBA_IN = 0;
constexpr size_t O_WT_SBA_OUT = O_WT_SBA_IN + al256((size_t)3072 * 1024 * 2);
constexpr size_t O_WT_NSA_IN = O_WT_SBA_OUT + al256((size_t)1024 * 1024 * 2);
constexpr size_t O_WT_NSA_OUT = O_WT_NSA_IN + al256((size_t)NSAWP * 1024 * 2);
constexpr size_t O_WT_UP0 = O_WT_NSA_OUT + al256((size_t)1024 * 1024 * 2);
constexpr size_t O_WT_UP1 = O_WT_UP0 + al256((size_t)NUP * 1024 * 2);
constexpr size_t O_WT_DOWN0 = O_WT_UP1 + al256((size_t)NUP * 1024 * 2);
constexpr size_t O_WT_DOWN1 = O_WT_DOWN0 + al256((size_t)1024 * DFF * 2);
constexpr size_t O_WT_CK1 = O_WT_DOWN1 + al256((size_t)1024 * DFF * 2);
constexpr size_t O_WT_CV1 = O_WT_CK1 + al256((size_t)128 * 2048 * 2);
constexpr size_t O_WT_CK2 = O_WT_CV1 + al256((size_t)128 * 2048 * 2);
constexpr size_t O_WT_CV2 = O_WT_CK2 + al256((size_t)64 * 128 * 2);
constexpr size_t O_BIAS1K = O_WT_CV2 + al256((size_t)64 * 128 * 2);
constexpr size_t O_BIAS1V = O_BIAS1K + 512;
constexpr size_t O_ROPE = O_BIAS1V + 512;
constexpr size_t O_HN = O_ROPE + al256((size_t)NTOK * 32 * 8);
constexpr size_t O_BIG = O_HN + al256((size_t)NTOK * DM * 2);
constexpr size_t O_R2 = O_BIG + 192 * MB;
constexpr size_t O_BAR = O_R2 + al256((size_t)HALF_TOK * DFF * 2);
constexpr size_t O_BPART = O_BAR + al256((size_t)XCD_BAR_WORDS * 4);
constexpr size_t O_ROWSS = O_BPART + al256((size_t)2 * 32 * 128 * 4);
constexpr size_t O_XB = O_ROWSS + al256((size_t)3 * NTOK * 8);
constexpr size_t WS_NEEDED = O_XB + al256((size_t)NTOK * DM * 2);
constexpr size_t O_QN = O_BIG;
constexpr size_t O_CBUF = O_QN + al256((size_t)NTOK * DM * 2);
constexpr size_t O_KSB = O_CBUF + al256((size_t)NTOK * 256 * 2);
constexpr size_t O_KWB = O_KSB + al256((size_t)NTOK * 128 * 2);
constexpr size_t O_VST = O_KWB + al256((size_t)NTOK * 128 * 2);
constexpr size_t O_VWT = O_VST + al256((size_t)16 * 64 * SEQ * 2);
constexpr size_t O_KC = O_VWT + al256((size_t)16 * 64 * SEQ * 2);
constexpr size_t O_VCT = O_KC + al256((size_t)16 * 256 * 64 * 2);
constexpr size_t O_GBUF = O_VCT + al256((size_t)16 * 64 * 256 * 2);
constexpr size_t O_MSK = O_GBUF + al256((size_t)NTOK * 48 * 4);
static_assert(O_MSK + (size_t)16 * SEQ * 8 <= O_R2, "NSA buffers overflow BIG");
static_assert((size_t)NTOK * DFF * 2 <= 192 * MB, "act overflow");
static_assert((size_t)512 * 4 * NUP * 4 <= (size_t)HALF_TOK * DFF * 2, "ub overflow");

struct KArgs {
  const void* in[19];
  float* out;
  char* ws;
  int phase_lo, phase_hi;
};

__device__ __forceinline__ Params make_params(const KArgs& k) {
  Params p;
  p.x = (const float*)k.in[0]; p.pos = (const int*)k.in[1]; p.norm_mix = (const float*)k.in[2];
  p.sba_w_in = (const float*)k.in[3]; p.sba_w_out = (const float*)k.in[4]; p.nsa_w_in = (const float*)k.in[5];
  p.pe_k = (const float*)k.in[6]; p.pe_v = (const float*)k.in[7]; p.ck_w1 = (const float*)k.in[8];
  p.ck_w2 = (const float*)k.in[9]; p.cv_w1 = (const float*)k.in[10]; p.cv_w2 = (const float*)k.in[11];
  p.nsa_w_out = (const float*)k.in[12]; p.norm_ffn = (const float*)k.in[13]; p.w_up = (const float*)k.in[14];
  p.conv_w = (const float*)k.in[15]; p.conv_b = (const float*)k.in[16]; p.w_down = (const float*)k.in[17];
  p.norm_final = (const float*)k.in[18];
  p.out = k.out;
  char* ws = k.ws;
  p.wt_sba_in = (u16*)(ws + O_WT_SBA_IN); p.wt_sba_out = (u16*)(ws + O_WT_SBA_OUT);
  p.wt_nsa_in = (u16*)(ws + O_WT_NSA_IN); p.wt_nsa_out = (u16*)(ws + O_WT_NSA_OUT);
  p.wt_up0 = (u16*)(ws + O_WT_UP0); p.wt_up1 = (u16*)(ws + O_WT_UP1);
  p.wt_down0 = (u16*)(ws + O_WT_DOWN0); p.wt_down1 = (u16*)(ws + O_WT_DOWN1);
  p.wt_ck1 = (u16*)(ws + O_WT_CK1); p.wt_cv1 = (u16*)(ws + O_WT_CV1);
  p.wt_ck2 = (u16*)(ws + O_WT_CK2); p.wt_cv2 = (u16*)(ws + O_WT_CV2);
  p.bpart = (float*)(ws + O_BPART); p.rowss = (unsigned long long*)(ws + O_ROWSS); p.xb = (u16*)(ws + O_XB);
  p.rope = (float2*)(ws + O_ROPE);
  p.hn = (u16*)(ws + O_HN);
  p.qb = (u16*)(ws + O_BIG); p.kb = (u16*)(ws + O_BIG + 64 * MB); p.vT = (u16*)(ws + O_BIG + 128 * MB);
  p.qn = (u16*)(ws + O_QN); p.cbuf = (u16*)(ws + O_CBUF); p.ksb = (u16*)(ws + O_KSB); p.kwb = (u16*)(ws + O_KWB);
  p.vsT = (u16*)(ws + O_VST); p.vwT = (u16*)(ws + O_VWT); p.kc = (u16*)(ws + O_KC); p.vcT = (u16*)(ws + O_VCT);
  p.gbuf = (float*)(ws + O_GBUF); p.msk = (unsigned long long*)(ws + O_MSK);
  p.ocp = p.hn;
  p.act = (u16*)(ws + O_BIG);
  p.ob = (u16*)(ws + O_R2); p.ub = (float*)(ws + O_R2);
  p.phase_lo = k.phase_lo; p.phase_hi = k.phase_hi; p.pad_ = 0;
  return p;
}


#define LAS __attribute__((address_space(3)))
__device__ __forceinline__ unsigned xb_ld(unsigned* p)              { return __hip_atomic_load(p, __ATOMIC_RELAXED, __HIP_MEMORY_SCOPE_AGENT); }
__device__ __forceinline__ unsigned xb_add(unsigned* p, unsigned v) { return __hip_atomic_fetch_add(p, v, __ATOMIC_RELAXED, __HIP_MEMORY_SCOPE_AGENT); }
#define XB_XCNT(j)  (256  + 64 * (j))
#define XB_XSUB(j)  (1280 + 64 * (j))
#define XB_XGEN(j)  (2304 + 64 * (j))
#define XB_TOP      3328
#define XB_TOPGEN   3392
__device__ __forceinline__ unsigned xb_xcc_id() { return (unsigned)__builtin_amdgcn_s_getreg((3 << 11) | 20) & 0xFu; }
#define XB_SPIN(cond) do { unsigned _sp = 0; while (cond) { __builtin_amdgcn_s_sleep(1); if (++_sp > (1u << 24)) break; } } while (0)
__device__ __forceinline__ void xb_post(unsigned* bar) { (void)xb_add(&bar[XB_XCNT(xb_xcc_id())], 1u); }
__device__ __forceinline__ void xb_census(unsigned* bar, volatile LAS unsigned* st) {
  const unsigned x = xb_xcc_id();
  unsigned cnt = 0u, mine = 1u;
#pragma unroll 1
  for (unsigned j = 0; j < 16; ++j) { const unsigned c = xb_ld(&bar[XB_XCNT(j)]); cnt += (c > 0u) ? 1u : 0u; if (j == x) mine = c; }
  st[0] = mine > 0u ? mine : 1u; st[1] = cnt > 0u ? cnt : 1u; st[2] = x;
}
__device__ __forceinline__ void grid_barrier(unsigned* bar, volatile LAS unsigned* st, unsigned k) {
  asm volatile("s_waitcnt vmcnt(0)" ::: "memory");
  __syncthreads();
  if (threadIdx.x == 0) {
    __builtin_amdgcn_s_waitcnt(0);
    const unsigned nloc = st[0], nx = st[1], x = st[2];
    const unsigned old = xb_add(&bar[XB_XSUB(x)], 1u);
    if (old + 1u == (k + 1u) * nloc) {
      __builtin_amdgcn_fence(__ATOMIC_RELEASE, "agent");
      asm volatile("s_waitcnt vmcnt(0)" ::: "memory");
      const unsigned og = xb_add(&bar[XB_TOP], 1u);
      if (og + 1u == (k + 1u) * nx) xb_add(&bar[XB_TOPGEN], 1u);
      else XB_SPIN(xb_ld(&bar[XB_TOPGEN]) == k);
      __builtin_amdgcn_fence(__ATOMIC_ACQUIRE, "agent");
      xb_add(&bar[XB_XGEN(x)], 1u);
      asm volatile("s_waitcnt vmcnt(0)" ::: "memory");
    } else {
      XB_SPIN(xb_ld(&bar[XB_XGEN(x)]) == k);
      __builtin_amdgcn_fence(__ATOMIC_ACQUIRE, "agent");
      asm volatile("s_waitcnt vmcnt(0)" ::: "memory");
    }
  }
  __syncthreads();
}

__device__ __forceinline__ void transpose_tile2(const float* tsrc, u16* tdst, int tK, int tN, int tNpad, int tile, u16* sm, const bool rp0 = false, const bool rp1 = false, const bool upperm = false, const float* gk = nullptr) {
  const int nNt = tNpad >> 6;
  const int tid = threadIdx.x & 255;
  const int c4 = tid & 15, r = tid >> 4;
  float4 v[2][4];
  int k0s[2], n0s[2];
#pragma unroll
  for (int t = 0; t < 2; ++t) {
    const int kt = (tile + t) / nNt, nt = (tile + t) - kt * nNt;
    k0s[t] = kt * 64; n0s[t] = nt * 64;
#pragma unroll
    for (int i = 0; i < 4; ++i) {
      const int nsrc0 = upperm ? (((n0s[t] >> 7) & 1) * DFF + 128 * (n0s[t] >> 8) + (n0s[t] & 127)) : n0s[t];
      const int k = r + 16 * i, n = nsrc0 + c4 * 4;
      v[t][i] = make_float4(0.f, 0.f, 0.f, 0.f);
      if (n < tN) v[t][i] = *(const float4*)(tsrc + (size_t)(k0s[t] + k) * tN + n);
      if (gk) { const float gs = gk[k0s[t] + k]; v[t][i].x *= gs; v[t][i].y *= gs; v[t][i].z *= gs; v[t][i].w *= gs; }
    }
  }
#pragma unroll
  for (int t = 0; t < 2; ++t)
#pragma unroll
    for (int i = 0; i < 4; ++i) {
      const int k = r + 16 * i;
      u16* d = sm + t * 64 * LDSP;
      const uint32_t p01 = pack2(v[t][i].x, v[t][i].y), p23 = pack2(v[t][i].z, v[t][i].w);
      d[(c4 * 4 + 0) * LDSP + k] = (u16)(p01 & 0xffff);
      d[(c4 * 4 + 1) * LDSP + k] = (u16)(p01 >> 16);
      d[(c4 * 4 + 2) * LDSP + k] = (u16)(p23 & 0xffff);
      d[(c4 * 4 + 3) * LDSP + k] = (u16)(p23 >> 16);
    }
  __syncthreads();
  const int c8 = tid & 7, rn = tid >> 3;
#pragma unroll
  for (int t = 0; t < 2; ++t) {
    const bool ropeperm = t ? rp1 : rp0;
#pragma unroll
    for (int i = 0; i < 2; ++i) {
      const int n = rn + 32 * i;
      const int nsrc = ropeperm ? (16 * (n >> 5) + (n & 15) + 32 * ((n >> 4) & 1)) : n;
      const uint4 w = *(const uint4*)(sm + t * 64 * LDSP + nsrc * LDSP + c8 * 8);
      *(uint4*)(tdst + (size_t)(n0s[t] + n) * tK + k0s[t] + c8 * 8) = w;
    }
  }
  __syncthreads();
}

__device__ __forceinline__ void rmsnorm_row_bf16(const float* x, const float* g, u16* out, int row, int lane) {
  const float4* xr = (const float4*)(x + (size_t)row * DM);
  float4 v[4]; float ss = 0.f;
#pragma unroll
  for (int i = 0; i < 4; ++i) { v[i] = xr[lane + 64 * i]; ss += v[i].x * v[i].x + v[i].y * v[i].y + v[i].z * v[i].z + v[i].w * v[i].w; }
#pragma unroll
  for (int off = 32; off >= 1; off >>= 1) ss += __shfl_xor(ss, off);
  const float rs = rsqrtf(ss * (1.f / DM) + 1e-6f);
#pragma unroll
  for (int i = 0; i < 4; ++i) {
    float4 gg = ((const float4*)g)[lane + 64 * i];
    uint2 pk = make_uint2(pack2(v[i].x * rs * gg.x, v[i].y * rs * gg.y), pack2(v[i].z * rs * gg.z, v[i].w * rs * gg.w));
    *(uint2*)(out + (size_t)row * DM + (lane + 64 * i) * 4) = pk;
  }
}

__device__ __forceinline__ void rmsnorm_2rows_bf16(const float* x, const float* g, u16* out, int row, int lane) {
  const float4* xr = (const float4*)(x + (size_t)row * DM);
  float4 v[2][4]; float ss[2] = {0.f, 0.f};
#pragma unroll
  for (int t = 0; t < 2; ++t)
#pragma unroll
    for (int i = 0; i < 4; ++i) v[t][i] = xr[t * (DM / 4) + lane + 64 * i];
#pragma unroll
  for (int t = 0; t < 2; ++t)
#pragma unroll
    for (int i = 0; i < 4; ++i) ss[t] += v[t][i].x * v[t][i].x + v[t][i].y * v[t][i].y + v[t][i].z * v[t][i].z + v[t][i].w * v[t][i].w;
#pragma unroll
  for (int off = 32; off >= 1; off >>= 1) { ss[0] += __shfl_xor(ss[0], off); ss[1] += __shfl_xor(ss[1], off); }
#pragma unroll
  for (int t = 0; t < 2; ++t) {
    const float rs = rsqrtf(ss[t] * (1.f / DM) + 1e-6f);
#pragma unroll
    for (int i = 0; i < 4; ++i) {
      const float4 gg = ((const float4*)g)[lane + 64 * i];
      const uint2 pk = make_uint2(pack2(v[t][i].x * rs * gg.x, v[t][i].y * rs * gg.y), pack2(v[t][i].z * rs * gg.z, v[t][i].w * rs * gg.w));
      *(uint2*)(out + (size_t)(row + t) * DM + (lane + 64 * i) * 4) = pk;
    }
  }
}

__device__ __forceinline__ void phase_rmsnorm(const float* x, const float* g, u16* out) {
  const int lane = threadIdx.x & 63, wave = threadIdx.x >> 6;
  for (int it = blockIdx.x; it < NTOK / 8; it += gridDim.x) rmsnorm_row_bf16(x, g, out, it * 8 + wave, lane);
}

__device__ __forceinline__ void phase_final_norm(float* x, const float* g) {
  const int lane = threadIdx.x & 63, wave = threadIdx.x >> 6;
  for (int it = blockIdx.x; it < NTOK / 8; it += gridDim.x) {
    int row = it * 8 + wave;
    float4* xr = (float4*)(x + (size_t)row * DM);
    float4 v[4]; float ss = 0.f;
#pragma unroll
    for (int i = 0; i < 4; ++i) { v[i] = xr[lane + 64 * i]; ss += v[i].x * v[i].x + v[i].y * v[i].y + v[i].z * v[i].z + v[i].w * v[i].w; }
#pragma unroll
    for (int off = 32; off >= 1; off >>= 1) ss += __shfl_xor(ss, off);
    const float rs = rsqrtf(ss * (1.f / DM) + 1e-6f);
#pragma unroll
    for (int i = 0; i < 4; ++i) {
      float4 gg = ((const float4*)g)[lane + 64 * i];
      xr[lane + 64 * i] = make_float4(v[i].x * rs * gg.x, v[i].y * rs * gg.y, v[i].z * rs * gg.z, v[i].w * rs * gg.w);
    }
  }
}

__device__ __forceinline__ void phase_prep(const Params& p, u16* sm) {
  const int tid = threadIdx.x & 255, sub = threadIdx.x >> 8;
  sm += sub * 2 * 64 * LDSP;
  const int n_tr = (768 + 256 + 512 + 256 + 1408 * 2 + 704 * 2 + 64 * 2 + 2 * 2) / 2;
  const int n_rope = NTOK * 32 / 256;
  const int n_bias = 64;
  const int n_norm = NTOK / 8;
  const int total = n_tr + n_rope + n_bias + n_norm;
  for (int i = blockIdx.x * NTHR + threadIdx.x; i < 3 * NTOK; i += gridDim.x * NTHR) p.rowss[i] = 0ull;
  for (int it = 2 * blockIdx.x + sub; it < total; it += 2 * gridDim.x) {
    if (it < n_tr) {
      const int tl = it * 2;
      constexpr int T1 = 768, T2 = T1 + 256, T3 = T2 + 512, T4 = T3 + 256, T5 = T4 + 1408, T6 = T5 + 1408,
                    T7 = T6 + 704, T8 = T7 + 704, T9 = T8 + 64, T10 = T9 + 64, T11 = T10 + 2;
      if (tl < T1) { transpose_tile2(p.sba_w_in, p.wt_sba_in, 1024, 3072, 3072, tl - (0), sm); }
      else if (tl < T2) { transpose_tile2(p.sba_w_out, p.wt_sba_out, 1024, 1024, 1024, tl - (T1), sm); }
      else if (tl < T3) {
        const int nt0 = (tl - T2) & 31, nt1 = nt0 + 1;
        const bool rp0 = (nt0 < 16) || (nt0 == 20) || (nt0 == 21) || (nt0 == 24) || (nt0 == 25);
        const bool rp1 = (nt1 < 16) || (nt1 == 20) || (nt1 == 21) || (nt1 == 24) || (nt1 == 25);
        transpose_tile2(p.nsa_w_in, p.wt_nsa_in, 1024, 1840, NSAWP, tl - (T2), sm, rp0, rp1, false, p.norm_mix + DM);
      }
      else if (tl < T4) { transpose_tile2(p.nsa_w_out, p.wt_nsa_out, 1024, 1024, 1024, tl - (T3), sm); }
      else if (tl < T5) { transpose_tile2(p.w_up, p.wt_up0, 1024, NUP, NUP, tl - (T4), sm, false, false, true, p.norm_ffn); }
      else if (tl < T6) { transpose_tile2(p.w_up + (size_t)1024 * NUP, p.wt_up1, 1024, NUP, NUP, tl - (T5), sm, false, false, true, p.norm_ffn + DM); }
      else if (tl < T7) { transpose_tile2(p.w_down, p.wt_down0, DFF, 1024, 1024, tl - (T6), sm); }
      else if (tl < T8) { transpose_tile2(p.w_down + (size_t)DFF * 1024, p.wt_down1, DFF, 1024, 1024, tl - (T7), sm); }
      else if (tl < T9) { transpose_tile2(p.ck_w1, p.wt_ck1, 2048, 128, 128, tl - (T8), sm); }
      else if (tl < T10) { transpose_tile2(p.cv_w1, p.wt_cv1, 2048, 128, 128, tl - (T9), sm); }
      else if (tl < T11) { transpose_tile2(p.ck_w2, p.wt_ck2, 128, 64, 64, tl - (T10), sm); }
      else { transpose_tile2(p.cv_w2, p.wt_cv2, 128, 64, 64, tl - (T11), sm); }
    } else if (it < n_tr + n_rope) {
      int idx = (it - n_tr) * 256 + tid;
      int tok = idx >> 5, f = idx & 31;
      float inv = powf(10000.f, -(float)f / 32.f);
      float ang = (float)p.pos[tok] * inv;
      p.rope[idx] = make_float2(cosf(ang), sinf(ang));
    } else if (it < n_tr + n_rope + n_bias) {
      const int bi = it - n_tr - n_rope, which = bi >> 5, ch = bi & 31;
      const float* pe = which ? p.pe_v : p.pe_k;
      const float* w1 = which ? p.cv_w1 : p.ck_w1;
      const int n = tid & 127, hf = tid >> 7;
      const int kk0 = ch * 64 + hf * 32;
      float s0 = 0.f;
#pragma unroll 8
      for (int kk = 0; kk < 32; ++kk) s0 += pe[kk0 + kk] * w1[(size_t)(kk0 + kk) * 128 + n];
      float* red = (float*)sm;
      if (hf) red[n] = s0;
      __syncthreads();
      if (!hf) p.bpart[(which * 32 + ch) * 128 + n] = s0 + red[n];
      __syncthreads();
    } else {
      const int r = (it - n_tr - n_rope - n_bias) * 8 + (tid >> 6) * 2;
      rmsnorm_2rows_bf16(p.x, p.norm_mix, p.hn, r, tid & 63);
    }
  }
}

constexpr int PG_BM = 256, PG_BK = 64, PG_HALF = 128, PG_HTB = PG_HALF * PG_BK * 2, PG_NXCD = 8, PG_WGM = 8;
__device__ __forceinline__ int pg_lds_byte(int r, int c) { const int st = (r >> 4) * 2 + (c >> 5), rr = r & 15, cc = c & 31, ob = rr * 64 + cc * 2; return st * 1024 + (ob ^ (((ob >> 9) & 1) << 5)); }
__device__ __forceinline__ void pg_stage_rc(int b, int& R, int& C) { const int st = b / 1024, sb = b % 1024, swz = sb ^ (((sb >> 9) & 1) << 5); R = (st >> 1) * 16 + swz / 64; C = (st & 1) * 32 + (swz % 64) / 2; }
struct Unit { int pm, pn; };
struct Gemm { const u16* A; const u16* Bt; int M, N, K; };
struct StaticOrder {
  int nM, nN, nwg, G, c;
  __device__ void init(int M, int N, int G_, int c_) { nM = M / PG_BM; nN = N / PG_BM; nwg = nM * nN; G = G_; c = c_; }
  __device__ bool next(int i, Unit& u) const {
    const long L = (long)i * G + c; if (L >= nwg) return false;
    int wgid = (int)L; { const int q = nwg / PG_NXCD, r = nwg % PG_NXCD, xcd = wgid % PG_NXCD, off = wgid / PG_NXCD; wgid = (xcd < r ? xcd * (q + 1) : r * (q + 1) + (xcd - r) * q) + off; }
    const int nig = PG_WGM * nN, gid = wgid / nig, fm = gid * PG_WGM, gsz = (nM - fm) < PG_WGM ? (nM - fm) : PG_WGM;
    u.pm = fm + ((wgid % nig) % gsz); u.pn = (wgid % nig) / gsz; return true;
  }
};

template <class Epi>
__device__ __forceinline__ void gemm_phase(LAS unsigned char* lds, const Gemm g, const StaticOrder& S, const Epi& E) {
  const int tid = threadIdx.x, wid = __builtin_amdgcn_readfirstlane(tid >> 6), lane = tid & 63, wr = wid >> 2, wc = wid & 3, fr = lane & 15, fq = lane >> 4;
  const int K = g.K, nt = K / PG_BK;
  unsigned voffA[2];
#pragma unroll
  for (int i = 0; i < 2; ++i) { int R, C; pg_stage_rc(tid * 16 + i * 8192, R, C); voffA[i] = (unsigned)(R * K + C) * 2u; }
  const size_t kstep = (size_t)(PG_BK * 2);
  const size_t hstep = (size_t)PG_HALF * K * 2;
  const size_t tstep = 2 * hstep;
  const unsigned ldsw = (unsigned)wid * 1024u;
  const int aoff = pg_lds_byte(wr * 64 + fr, fq * 8), boff = pg_lds_byte(wc * 32 + fr, fq * 8);
  const unsigned lbase = (unsigned)(__UINTPTR_TYPE__)lds;
  const unsigned aaddr = lbase + (unsigned)aoff, baddr = lbase + 4u * PG_HTB + (unsigned)boff;
#define PG8_SA(b, h) (((b) * 2 + (h)) * PG_HTB)
#define PG8_SB(b, h) ((4 + (b) * 2 + (h)) * PG_HTB)
#define PG8_STAGE(bufoff, gbase, voff) do { _Pragma("unroll") for (int _i = 0; _i < 2; ++_i) \
    __builtin_amdgcn_global_load_lds((const unsigned*)((const char*)(gbase) + (voff)[_i]), (LAS unsigned*)(lds + (bufoff) + ldsw + _i * 8192), 16, 0, 0); } while (0)
#define PG8_DSR(dst, addr, imm) asm volatile("ds_read_b128 %0, %1 offset:%2" : "=v"(dst) : "v"(addr), "n"(imm) : "memory")
#define PG8_LDA(dst, b, h) do { \
    PG8_DSR(dst[0][0], aaddr, ((b) * 2 + (h)) * PG_HTB + 0 * 2048 + 0);    PG8_DSR(dst[0][1], aaddr, ((b) * 2 + (h)) * PG_HTB + 0 * 2048 + 1024); \
    PG8_DSR(dst[1][0], aaddr, ((b) * 2 + (h)) * PG_HTB + 1 * 2048 + 0);    PG8_DSR(dst[1][1], aaddr, ((b) * 2 + (h)) * PG_HTB + 1 * 2048 + 1024); \
    PG8_DSR(dst[2][0], aaddr, ((b) * 2 + (h)) * PG_HTB + 2 * 2048 + 0);    PG8_DSR(dst[2][1], aaddr, ((b) * 2 + (h)) * PG_HTB + 2 * 2048 + 1024); \
    PG8_DSR(dst[3][0], aaddr, ((b) * 2 + (h)) * PG_HTB + 3 * 2048 + 0);    PG8_DSR(dst[3][1], aaddr, ((b) * 2 + (h)) * PG_HTB + 3 * 2048 + 1024); } while (0)
#define PG8_LDB(dst, b, h) do { \
    PG8_DSR(dst[0][0], baddr, ((b) * 2 + (h)) * PG_HTB + 0 * 2048 + 0);    PG8_DSR(dst[0][1], baddr, ((b) * 2 + (h)) * PG_HTB + 0 * 2048 + 1024); \
    PG8_DSR(dst[1][0], baddr, ((b) * 2 + (h)) * PG_HTB + 1 * 2048 + 0);    PG8_DSR(dst[1][1], baddr, ((b) * 2 + (h)) * PG_HTB + 1 * 2048 + 1024); } while (0)
#define PG8_MMA(ai, bj, At, Bt) do { __builtin_amdgcn_s_setprio(1); _Pragma("unroll") for (int m = 0; m < 4; ++m) _Pragma("unroll") for (int n = 0; n < 2; ++n) _Pragma("unroll") for (int k = 0; k < 2; ++k) \
    acc[ai][bj][m][n] = __builtin_amdgcn_mfma_f32_16x16x32_bf16(Bt[n][k], At[m][k], acc[ai][bj][m][n], 0, 0, 0); __builtin_amdgcn_s_setprio(0); } while (0)
#define PG8_WAIT_V(n) asm volatile("s_waitcnt vmcnt(" #n ")" ::: "memory")
#define PG8_WAIT_L(n) asm volatile("s_waitcnt lgkmcnt(" #n ")" ::: "memory")
#define PG8_WAIT_L0 asm volatile("s_waitcnt lgkmcnt(0)" \
    : "+v"(At[0][0]), "+v"(At[0][1]), "+v"(At[1][0]), "+v"(At[1][1]), "+v"(At[2][0]), "+v"(At[2][1]), "+v"(At[3][0]), "+v"(At[3][1]), \
      "+v"(B0[0][0]), "+v"(B0[0][1]), "+v"(B0[1][0]), "+v"(B0[1][1]), "+v"(B1[0][0]), "+v"(B1[0][1]), "+v"(B1[1][0]), "+v"(B1[1][1]) :: "memory")
#define PG8_BAR __builtin_amdgcn_s_barrier()
#define PG8_SCHED __builtin_amdgcn_sched_barrier(0)
  Unit cur, nxt; int ui = 0;
  if (!S.next(0, cur)) return;
  f32x4 acc[2][2][4][2];
#pragma unroll
  for (int a = 0; a < 2; ++a)
#pragma unroll
    for (int b = 0; b < 2; ++b)
#pragma unroll
      for (int m = 0; m < 4; ++m)
#pragma unroll
        for (int n = 0; n < 2; ++n) acc[a][b][m][n] = (f32x4){0.f, 0.f, 0.f, 0.f};
  bf16x8 At[4][2] = {}, B0[2][2] = {}, B1[2][2] = {};
  const char* cA = (const char*)g.A + (size_t)cur.pm * tstep; const char* cB = (const char*)g.Bt + (size_t)cur.pn * tstep;
  PG8_STAGE(PG8_SB(0, 0), cB, voffA); PG8_STAGE(PG8_SA(0, 0), cA, voffA); PG8_STAGE(PG8_SB(0, 1), cB + hstep, voffA); PG8_STAGE(PG8_SA(0, 1), cA + hstep, voffA);
  if (wr == 1) PG8_BAR;
  PG8_WAIT_V(4); PG8_BAR;
  PG8_STAGE(PG8_SB(1, 0), cB + kstep, voffA); PG8_STAGE(PG8_SA(1, 0), cA + kstep, voffA); PG8_STAGE(PG8_SB(1, 1), cB + hstep + kstep, voffA);
  PG8_WAIT_V(6); PG8_BAR;
  for (;;) {
    const bool has_next = S.next(ui + 1, nxt);
    const char* nA = has_next ? (const char*)g.A + (size_t)nxt.pm * tstep : cA; const char* nB = has_next ? (const char*)g.Bt + (size_t)nxt.pn * tstep : cB;
    for (int t = 0; t < nt; t += 2) {
      const bool last = (t == nt - 2);
      const char* a1 = cA + (size_t)(t + 1) * kstep;
      const char* a2 = last ? nA : cA + (size_t)(t + 2) * kstep; const char* b2 = last ? nB : cB + (size_t)(t + 2) * kstep;
      const char* a3 = a2 + kstep; const char* b3 = b2 + kstep;
      PG8_LDB(B0, 0, 0); PG8_SCHED; PG8_LDA(At, 0, 0); PG8_STAGE(PG8_SA(1, 1), a1 + hstep, voffA);
      PG8_WAIT_L(8); PG8_BAR; PG8_WAIT_L0; PG8_MMA(0, 0, At, B0); PG8_BAR; PG8_SCHED;
      PG8_LDB(B1, 0, 1); PG8_STAGE(PG8_SB(0, 0), b2, voffA);
      PG8_BAR; PG8_WAIT_L0; PG8_MMA(0, 1, At, B1); PG8_BAR;
      PG8_LDA(At, 0, 1); PG8_STAGE(PG8_SA(0, 0), a2, voffA);
      PG8_BAR; PG8_WAIT_L0; PG8_MMA(1, 0, At, B0); PG8_BAR; PG8_SCHED;
      PG8_STAGE(PG8_SB(0, 1), b2 + hstep, voffA);
      PG8_WAIT_V(6); PG8_BAR; PG8_MMA(1, 1, At, B1); PG8_BAR;
      PG8_LDB(B0, 1, 0); PG8_SCHED; PG8_LDA(At, 1, 0); PG8_STAGE(PG8_SA(0, 1), a2 + hstep, voffA);
      PG8_WAIT_L(8); PG8_BAR; PG8_WAIT_L0; PG8_MMA(0, 0, At, B0); PG8_BAR; PG8_SCHED;
      PG8_LDB(B1, 1, 1); PG8_STAGE(PG8_SB(1, 0), b3, voffA);
      PG8_BAR; PG8_WAIT_L0; PG8_MMA(0, 1, At, B1); PG8_BAR;
      PG8_LDA(At, 1, 1); PG8_STAGE(PG8_SA(1, 0), a3, voffA);
      PG8_BAR; PG8_WAIT_L0; PG8_MMA(1, 0, At, B0); PG8_BAR; PG8_SCHED;
      PG8_STAGE(PG8_SB(1, 1), b3 + hstep, voffA);
      PG8_WAIT_V(6); PG8_BAR; PG8_MMA(1, 1, At, B1); PG8_BAR;
    }
    E(acc, cur, wr, wc, fr, fq);
    if (!has_next) break;
#pragma unroll
    for (int a = 0; a < 2; ++a)
#pragma unroll
      for (int b = 0; b < 2; ++b)
#pragma unroll
        for (int m = 0; m < 4; ++m)
#pragma unroll
          for (int n = 0; n < 2; ++n) acc[a][b][m][n] = (f32x4){0.f, 0.f, 0.f, 0.f};
    cur = nxt; cA = nA; cB = nB; ++ui;
  }
  PG8_WAIT_V(0);
  if (wr == 0) PG8_BAR;
  PG8_BAR;
#undef PG8_SA
#undef PG8_SB
#undef PG8_STAGE
#undef PG8_LDA
#undef PG8_DSR
#undef PG8_WAIT_L0
#undef PG8_LDB
#undef PG8_MMA
#undef PG8_WAIT_V
#undef PG8_WAIT_L
#undef PG8_BAR
#undef PG8_SCHED
}

typedef f32x4 AccT[2][2][4][2];
#define EPI_ROW(u, ai, m) ((u).pm * 256 + (ai) * 128 + wr * 64 + (m) * 16 + fr)
#define EPI_COL(u, bj, n) ((u).pn * 256 + (bj) * 128 + wc * 32 + (n) * 16 + fq * 4)

struct EpiSbaQkv {
  u16 *qb, *kb, *vT;
  __device__ __forceinline__ void operator()(const AccT& acc, const Unit& u, int wr, int wc, int fr, int fq) const {
    if (u.pn < 8) {
      u16* dst = (u.pn < 4) ? qb : kb;
#pragma unroll
      for (int ai = 0; ai < 2; ++ai)
#pragma unroll
        for (int m = 0; m < 4; ++m) {
          u16* rowp = dst + (size_t)EPI_ROW(u, ai, m) * DM;
#pragma unroll
          for (int bj = 0; bj < 2; ++bj)
#pragma unroll
            for (int n = 0; n < 2; ++n) *(uint2*)(rowp + (EPI_COL(u, bj, n) & 1023)) = pack4(acc[ai][bj][m][n]);
        }
    } else {
#pragma unroll
      for (int ai = 0; ai < 2; ++ai)
#pragma unroll
        for (int m = 0; m < 4; ++m) {
          const int tok = EPI_ROW(u, ai, m), b = tok >> 12, t = tok & 4095;
#pragma unroll
          for (int bj = 0; bj < 2; ++bj)
#pragma unroll
            for (int n = 0; n < 2; ++n) {
              const int c = EPI_COL(u, bj, n) - 2048, h = c >> 6, d = c & 63;
#pragma unroll
              for (int r = 0; r < 4; ++r) vT[((size_t)(b * 16 + h) * 64 + d + r) * SEQ + t] = f2bf(acc[ai][bj][m][n][r]);
            }
        }
    }
  }
};
constexpr float SS_FIX = 16777216.f;
template <bool RF32>
struct EpiResidB {
  const float* resid32; u16* xb; unsigned long long* rowss;
  __device__ __forceinline__ void operator()(const AccT& acc, const Unit& u, int wr, int wc, int fr, int fq) const {
#pragma unroll
    for (int ai = 0; ai < 2; ++ai) {
      f32x4 rv[4][2][2];
#pragma unroll
      for (int m = 0; m < 4; ++m) {
        const size_t ro = (size_t)EPI_ROW(u, ai, m) * DM;
#pragma unroll
        for (int bj = 0; bj < 2; ++bj)
#pragma unroll
          for (int n = 0; n < 2; ++n) {
            if (RF32) rv[m][bj][n] = *(const f32x4*)(resid32 + ro + EPI_COL(u, bj, n));
            else {
              const uint2 pk = *(const uint2*)(xb + ro + EPI_COL(u, bj, n));
              rv[m][bj][n] = (f32x4){__uint_as_float(pk.x << 16), __uint_as_float(pk.x & 0xffff0000u), __uint_as_float(pk.y << 16), __uint_as_float(pk.y & 0xffff0000u)};
            }
          }
      }
#pragma unroll
      for (int m = 0; m < 4; ++m) {
        const int row = EPI_ROW(u, ai, m);
        const size_t ro = (size_t)row * DM;
        float ss = 0.f;
#pragma unroll
        for (int bj = 0; bj < 2; ++bj)
#pragma unroll
          for (int n = 0; n < 2; ++n) {
            const f32x4 x = rv[m][bj][n] + acc[ai][bj][m][n];
            ss += x[0] * x[0] + x[1] * x[1] + x[2] * x[2] + x[3] * x[3];
            *(uint2*)(xb + ro + EPI_COL(u, bj, n)) = pack4(x);
          }
        ss += __shfl_xor(ss, 16);
        ss += __shfl_xor(ss, 32);
        if (fq == 0) atomicAdd(rowss + row, (unsigned long long)(ss * SS_FIX + 0.5f));
      }
    }
  }
};
struct EpiResidLast {
  const u16* xb; float* out;
  __device__ __forceinline__ void operator()(const AccT& acc, const Unit& u, int wr, int wc, int fr, int fq) const {
#pragma unroll
    for (int ai = 0; ai < 2; ++ai) {
      uint2 rv[4][2][2];
#pragma unroll
      for (int m = 0; m < 4; ++m) {
        const size_t ro = (size_t)EPI_ROW(u, ai, m) * DM;
#pragma unroll
        for (int bj = 0; bj < 2; ++bj)
#pragma unroll
          for (int n = 0; n < 2; ++n) rv[m][bj][n] = *(const uint2*)(xb + ro + EPI_COL(u, bj, n));
      }
#pragma unroll
      for (int m = 0; m < 4; ++m) {
        const size_t ro = (size_t)EPI_ROW(u, ai, m) * DM;
#pragma unroll
        for (int bj = 0; bj < 2; ++bj)
#pragma unroll
          for (int n = 0; n < 2; ++n) {
            const uint2 pk = rv[m][bj][n];
            const f32x4 a = acc[ai][bj][m][n];
            *(float4*)(out + ro + EPI_COL(u, bj, n)) = make_float4(__uint_as_float(pk.x << 16) + a[0], __uint_as_float(pk.x & 0xffff0000u) + a[1],
                                                                   __uint_as_float(pk.y << 16) + a[2], __uint_as_float(pk.y & 0xffff0000u) + a[3]);
          }
      }
    }
  }
};
__device__ __forceinline__ float rstd_of(const unsigned long long* rowss, int row) {
  return rsqrtf((float)rowss[row] * (1.f / (SS_FIX * DM)) + 1e-6f);
}
__device__ __forceinline__ float dpp_ror1(float v) { return __int_as_float(__builtin_amdgcn_update_dpp(0, __float_as_int(v), 0x121, 0xf, 0xf, false)); }
__device__ __forceinline__ float dpp_ror2(float v) { return __int_as_float(__builtin_amdgcn_update_dpp(0, __float_as_int(v), 0x122, 0xf, 0xf, false)); }
struct EpiUpConv {
  u16* act; float* ub; const unsigned long long* rowss; const float* cw; const float* cb;
  __device__ __forceinline__ void operator()(const AccT& acc, const Unit& u, int wr, int wc, int fr, int fq) const {
#pragma unroll
    for (int ai = 0; ai < 2; ++ai) {
      float rs[4];
#pragma unroll
      for (int m = 0; m < 4; ++m) rs[m] = rstd_of(rowss, EPI_ROW(u, ai, m));
      const int chunk = 4 * u.pm + 2 * ai + wr;
#pragma unroll
      for (int n = 0; n < 2; ++n) {
        const int f0 = 128 * u.pn + 32 * wc + 16 * n + 4 * fq;
        const int gc = u.pn * 256 + 32 * wc + 16 * n + 4 * fq;
        const f32x4 wg0 = *(const f32x4*)(cw + f0), wg1 = *(const f32x4*)(cw + NUP + f0), wg2 = *(const f32x4*)(cw + 2 * NUP + f0);
        const f32x4 wv0 = *(const f32x4*)(cw + DFF + f0), wv1 = *(const f32x4*)(cw + NUP + DFF + f0), wv2 = *(const f32x4*)(cw + 2 * NUP + DFF + f0);
        const f32x4 bg = *(const f32x4*)(cb + f0), bv = *(const f32x4*)(cb + DFF + f0);
        f32x4 xg[4], xv[4];
#pragma unroll
        for (int m = 0; m < 4; ++m) { xg[m] = acc[ai][0][m][n] * rs[m]; xv[m] = acc[ai][1][m][n] * rs[m]; }
        if (fr < 2) {
          float* d = ub + ((size_t)(chunk * 4 + fr) * NUP + gc);
          *(float4*)d = make_float4(xg[0][0], xg[0][1], xg[0][2], xg[0][3]);
          *(float4*)(d + 128) = make_float4(xv[0][0], xv[0][1], xv[0][2], xv[0][3]);
        }
        if (fr >= 14) {
          float* d = ub + ((size_t)(chunk * 4 + 2 + (fr - 14)) * NUP + gc);
          *(float4*)d = make_float4(xg[3][0], xg[3][1], xg[3][2], xg[3][3]);
          *(float4*)(d + 128) = make_float4(xv[3][0], xv[3][1], xv[3][2], xv[3][3]);
        }
#pragma unroll
        for (int m = 0; m < 4; ++m) {
          f32x4 res;
#pragma unroll
          for (int r = 0; r < 4; ++r) {
            const float g_cur = xg[m][r], v_cur = xv[m][r];
            const f32x4 xgp = xg[m > 0 ? m - 1 : 0], xvp = xv[m > 0 ? m - 1 : 0];
            const float g_pm = (m > 0) ? xgp[r] : 0.f, v_pm = (m > 0) ? xvp[r] : 0.f;
            const float g1 = dpp_ror1((fr == 15) ? g_pm : g_cur), g2 = dpp_ror2((fr >= 14) ? g_pm : g_cur);
            const float v1 = dpp_ror1((fr == 15) ? v_pm : v_cur), v2 = dpp_ror2((fr >= 14) ? v_pm : v_cur);
            const float cg_ = bg[r] + g2 * wg0[r] + g1 * wg1[r] + g_cur * wg2[r];
            const float cv_ = bv[r] + v2 * wv0[r] + v1 * wv1[r] + v_cur * wv2[r];
            res[r] = cg_ * __builtin_amdgcn_rcpf(1.f + __builtin_amdgcn_exp2f(-1.4426950408889634f * cg_)) * cv_;
          }
          if (m > 0 || fr >= 2)
            *(uint2*)(act + (size_t)EPI_ROW(u, ai, m) * DFF + f0) = pack4(res);
        }
      }
    }
  }
};

struct EpiNsaIn {
  u16 *qn, *cbuf, *ksb, *kwb, *vsT, *vwT; float* gbuf; const float2* rope; const unsigned long long* rowss;
  __device__ __forceinline__ void rope_store(const f32x4& x1, const f32x4& x2, int tok, int d1, u16* dst) const {
    const float4 cs01 = *(const float4*)(rope + (size_t)tok * 32 + d1);
    const float4 cs23 = *(const float4*)(rope + (size_t)tok * 32 + d1 + 2);
    const float cc[4] = {cs01.x, cs01.z, cs23.x, cs23.z};
    const float ss[4] = {cs01.y, cs01.w, cs23.y, cs23.w};
    f32x4 o1, o2;
#pragma unroll
    for (int r = 0; r < 4; ++r) { o1[r] = x1[r] * cc[r] - x2[r] * ss[r]; o2[r] = x2[r] * cc[r] + x1[r] * ss[r]; }
    *(uint2*)(dst + d1) = pack4(o1);
    *(uint2*)(dst + d1 + 32) = pack4(o2);
  }
  __device__ __forceinline__ void operator()(const AccT& acc_in, const Unit& u, int wr, int wc, int fr, int fq) const {
    const int d1 = 16 * (wc & 1) + 4 * fq;
#pragma unroll
    for (int ai = 0; ai < 2; ++ai)
#pragma unroll
      for (int m = 0; m < 4; ++m) {
        const int tok = EPI_ROW(u, ai, m);
        const float rs = rstd_of(rowss, tok);
        f32x4 acc[2][2][2];
#pragma unroll
        for (int bj = 0; bj < 2; ++bj)
#pragma unroll
          for (int n = 0; n < 2; ++n) acc[0][bj][n] = acc_in[ai][bj][m][n] * rs;
        if (u.pn < 4) {
#pragma unroll
          for (int bj = 0; bj < 2; ++bj) {
            const int head = 4 * u.pn + 2 * bj + (wc >> 1);
            rope_store(acc[0][bj][0], acc[0][bj][1], tok, d1, qn + (size_t)tok * DM + head * 64);
          }
        } else if (u.pn == 4) {
#pragma unroll
          for (int bj = 0; bj < 2; ++bj)
#pragma unroll
            for (int n = 0; n < 2; ++n) *(uint2*)(cbuf + (size_t)tok * 256 + (EPI_COL(u, bj, n) - 1024)) = pack4(acc[0][bj][n]);
        } else if (u.pn < 7) {
          u16* kdst = (u.pn == 5) ? ksb : kwb;
          u16* vdst = (u.pn == 5) ? vsT : vwT;
          const int gk = wc >> 1;
          rope_store(acc[0][0][0], acc[0][0][1], tok, d1, kdst + (size_t)tok * 128 + gk * 64);
          const int b = tok >> 12, t = tok & 4095;
#pragma unroll
          for (int n = 0; n < 2; ++n) {
            const int d = 32 * (wc & 1) + 16 * n + 4 * fq;
#pragma unroll
            for (int r = 0; r < 4; ++r) vdst[((size_t)(b * 2 + gk) * 64 + d + r) * SEQ + t] = f2bf(acc[0][1][n][r]);
          }
        } else {
#pragma unroll
          for (int n = 0; n < 2; ++n) {
            const int c = 32 * wc + 16 * n + 4 * fq;
            if (c < 48) {
              const f32x4 a = acc[0][0][n];
              float4 gv;
              gv.x = 1.f / (1.f + __expf(-a[0])); gv.y = 1.f / (1.f + __expf(-a[1]));
              gv.z = 1.f / (1.f + __expf(-a[2])); gv.w = 1.f / (1.f + __expf(-a[3]));
              *(float4*)(gbuf + (size_t)tok * 48 + c) = gv;
            }
          }
        }
      }
  }
};

template <class Epi>
__device__ __forceinline__ void run_gemm(u16* sm, const u16* A, const u16* Bt, int M, int N, int K, const Epi& E) {
  Gemm g; g.A = A; g.Bt = Bt; g.M = M; g.N = N; g.K = K;
  StaticOrder S; S.init(M, N, (int)gridDim.x, (int)blockIdx.x);
  gemm_phase(( LAS unsigned char*)sm, g, S, E);
}

template <class ARowF>
__device__ __forceinline__ void gemm_mainloop(f32x4 (&acc)[4][4], ARowF arow, int a_kstep, const u16* bt, int ldb, int nk, u16* sm) {
  const int tid = threadIdx.x, lane = tid & 63, wave = tid >> 6;
  const int wm = wave >> 1, wn = wave & 1;
  const int lc = tid & 7, lr = tid >> 3;
  const u16* pa[4]; const u16* pb[2];
#pragma unroll
  for (int i = 0; i < 4; ++i) pa[i] = arow(lr + 64 * i) + lc * 8;
#pragma unroll
  for (int i = 0; i < 2; ++i) pb[i] = bt + (size_t)(lr + 64 * i) * ldb + lc * 8;
  u16* sA = sm; u16* sB = sm + 2 * 256 * LDSP;
  uint4 ra[4], rb[2];
#pragma unroll
  for (int i = 0; i < 4; ++i) ra[i] = *(const uint4*)pa[i];
#pragma unroll
  for (int i = 0; i < 2; ++i) rb[i] = *(const uint4*)pb[i];
#pragma unroll
  for (int i = 0; i < 4; ++i) *(uint4*)(sA + (lr + 64 * i) * LDSP + lc * 8) = ra[i];
#pragma unroll
  for (int i = 0; i < 2; ++i) *(uint4*)(sB + (lr + 64 * i) * LDSP + lc * 8) = rb[i];
  __syncthreads();
  const int fr = lane & 15, fq = lane >> 4;
  for (int kt = 0; kt < nk; ++kt) {
    const bool more = (kt + 1 < nk);
    if (more) {
#pragma unroll
      for (int i = 0; i < 4; ++i) ra[i] = *(const uint4*)(pa[i] + (size_t)(kt + 1) * a_kstep);
#pragma unroll
      for (int i = 0; i < 2; ++i) rb[i] = *(const uint4*)(pb[i] + (size_t)(kt + 1) * 64);
    }
    const u16* cA = sA + (kt & 1) * 256 * LDSP + (wm * 64 + fr) * LDSP + fq * 8;
    const u16* cB = sB + (kt & 1) * 128 * LDSP + (wn * 64 + fr) * LDSP + fq * 8;
#pragma unroll
    for (int ks = 0; ks < 2; ++ks) {
      bf16x8 wf[4], xf[4];
#pragma unroll
      for (int i = 0; i < 4; ++i) {
        wf[i] = *(const bf16x8*)(cB + i * 16 * LDSP + ks * 32);
        xf[i] = *(const bf16x8*)(cA + i * 16 * LDSP + ks * 32);
      }
#pragma unroll
      for (int i = 0; i < 4; ++i)
#pragma unroll
        for (int j = 0; j < 4; ++j) acc[i][j] = mfma16(wf[i], xf[j], acc[i][j]);
    }
    if (more) {
      u16* dA = sA + ((kt + 1) & 1) * 256 * LDSP; u16* dB = sB + ((kt + 1) & 1) * 128 * LDSP;
#pragma unroll
      for (int i = 0; i < 4; ++i) *(uint4*)(dA + (lr + 64 * i) * LDSP + lc * 8) = ra[i];
#pragma unroll
      for (int i = 0; i < 2; ++i) *(uint4*)(dB + (lr + 64 * i) * LDSP + lc * 8) = rb[i];
    }
    __syncthreads();
  }
}

__device__ __forceinline__ void zero_acc(f32x4 (&acc)[4][4]) {
#pragma unroll
  for (int i = 0; i < 4; ++i)
#pragma unroll
    for (int j = 0; j < 4; ++j) acc[i][j] = (f32x4){0.f, 0.f, 0.f, 0.f};
}

__device__ __forceinline__ void phase_ffn_fix(const Params& p, int layer) {
  const float* cw = p.conv_w + (size_t)layer * 3 * NUP;
  const float* cb = p.conv_b + (size_t)layer * NUP;
  const int nitems = 512 * 2 * (DFF / 4);
  for (int it = blockIdx.x * NTHR + threadIdx.x; it < nitems; it += gridDim.x * NTHR) {
    const int f4 = it % (DFF / 4), cj = it / (DFF / 4), j = cj & 1, chunk = cj >> 1;
    const int f0 = f4 * 4;
    const int gc = 256 * (f0 >> 7) + (f0 & 127);
    const int t = chunk * 64 + j;
    const bool has_prev = ((chunk & 63) != 0);
    const float* cur = p.ub + (size_t)(chunk * 4) * NUP + gc;
    const float* prv = p.ub + (size_t)((has_prev ? chunk - 1 : chunk) * 4) * NUP + gc;
    const float pmask = has_prev ? 1.f : 0.f;
    const float* r1p = (j == 0) ? prv + (size_t)3 * NUP : cur;
    const float* r2p = (j == 0) ? prv + (size_t)2 * NUP : prv + (size_t)3 * NUP;
    const float m1 = (j == 0) ? pmask : 1.f, m2 = pmask;
    f32x4 g0 = *(const f32x4*)(cur + (size_t)j * NUP), v0 = *(const f32x4*)(cur + (size_t)j * NUP + 128);
    f32x4 g1 = *(const f32x4*)(r1p) * m1, v1 = *(const f32x4*)(r1p + 128) * m1;
    f32x4 g2 = *(const f32x4*)(r2p) * m2, v2 = *(const f32x4*)(r2p + 128) * m2;
    const f32x4 wg0 = *(const f32x4*)(cw + f0), wg1 = *(const f32x4*)(cw + NUP + f0), wg2 = *(const f32x4*)(cw + 2 * NUP + f0);
    const f32x4 wv0 = *(const f32x4*)(cw + DFF + f0), wv1 = *(const f32x4*)(cw + NUP + DFF + f0), wv2 = *(const f32x4*)(cw + 2 * NUP + DFF + f0);
    const f32x4 bg = *(const f32x4*)(cb + f0), bv = *(const f32x4*)(cb + DFF + f0);
    const f32x4 cg_ = bg + g2 * wg0 + g1 * wg1 + g0 * wg2;
    const f32x4 cv_ = bv + v2 * wv0 + v1 * wv1 + v0 * wv2;
    const float r0 = cg_[0] / (1.f + __expf(-cg_[0])) * cv_[0], r1 = cg_[1] / (1.f + __expf(-cg_[1])) * cv_[1];
    const float r2 = cg_[2] / (1.f + __expf(-cg_[2])) * cv_[2], r3 = cg_[3] / (1.f + __expf(-cg_[3])) * cv_[3];
    *(uint2*)(p.act + (size_t)t * DFF + f0) = make_uint2(pack2(r0, r1), pack2(r2, r3));
  }
}

__device__ __forceinline__ void phase_compress(const Params& p, u16* sm) {
  const int tid = threadIdx.x, lane = tid & 63, wave = tid >> 6, wm = wave >> 1, wn = wave & 1, fr = lane & 15, fq = lane >> 4;
  for (int tile = blockIdx.x; tile < 32; tile += gridDim.x) {
    const int which = tile & 1, mt = tile >> 1;
    const int m0 = mt * 256;
    const u16* w1t = which ? p.wt_cv1 : p.wt_ck1;
    const u16* w2t = which ? p.wt_cv2 : p.wt_ck2;
    const float* bias = p.bpart + which * 32 * 128;
    f32x4 acc[4][4]; zero_acc(acc);
    const u16* cb = p.cbuf + which * 128;
    gemm_mainloop(acc, [&](int r) {
      int row = m0 + r; int g = row & 1; int bc = row >> 1; int c = bc & 255; int b = bc >> 8;
      if (c > 254) c = 254;
      return cb + ((size_t)b * SEQ + c * 16) * 256 + g * 64;
    }, 256, w1t, 2048, 32, sm);
    u16* sH = sm; u16* sW = sm + 256 * 136;
#pragma unroll
    for (int i = 0; i < 4; ++i) {
      const int n = wn * 64 + i * 16 + fq * 4;
      float bb[4] = {0.f, 0.f, 0.f, 0.f};
#pragma unroll
      for (int c8 = 0; c8 < 32; ++c8) {
        const float4 bv = *(const float4*)(bias + c8 * 128 + n);
        bb[0] += bv.x; bb[1] += bv.y; bb[2] += bv.z; bb[3] += bv.w;
      }
#pragma unroll
      for (int j = 0; j < 4; ++j) {
        const int rl = wm * 64 + j * 16 + fr;
        f32x4 hv;
#pragma unroll
        for (int r = 0; r < 4; ++r) {
          float xv = acc[i][j][r] + bb[r];
          float inner = 0.7978845608028654f * (xv + 0.044715f * xv * xv * xv);
          hv[r] = 0.5f * xv * (1.f + tanhf(inner));
        }
        *(uint2*)(sH + rl * 136 + n) = pack4(hv);
      }
    }
    {
#pragma unroll
      for (int i = 0; i < 2; ++i) {
        int idx = tid + 512 * i; int r = idx >> 4, c = idx & 15;
        *(uint4*)(sW + r * 136 + c * 8) = *(const uint4*)(w2t + r * 128 + c * 8);
      }
    }
    __syncthreads();
    f32x4 o2[4][2];
#pragma unroll
    for (int dm = 0; dm < 4; ++dm) { o2[dm][0] = (f32x4){0.f, 0.f, 0.f, 0.f}; o2[dm][1] = (f32x4){0.f, 0.f, 0.f, 0.f}; }
#pragma unroll
    for (int ks = 0; ks < 4; ++ks) {
      bf16x8 hf[2];
#pragma unroll
      for (int j = 0; j < 2; ++j) hf[j] = *(const bf16x8*)(sH + (wave * 32 + j * 16 + fr) * 136 + ks * 32 + fq * 8);
#pragma unroll
      for (int dm = 0; dm < 4; ++dm) {
        bf16x8 wf = *(const bf16x8*)(sW + (dm * 16 + fr) * 136 + ks * 32 + fq * 8);
#pragma unroll
        for (int j = 0; j < 2; ++j) o2[dm][j] = mfma16(wf, hf[j], o2[dm][j]);
      }
    }
#pragma unroll
    for (int j = 0; j < 2; ++j) {
      const int row = m0 + wave * 32 + j * 16 + fr;
      const int g = row & 1, bc = row >> 1, c = bc & 255, b = bc >> 8;
      const bool valid = (c < 255);
      if (which == 0) {
        const int tok = b * SEQ + (valid ? c : 254) * 16 + 31;
        u16* dst = p.kc + ((size_t)(b * 2 + g) * 256 + c) * 64;
#pragma unroll
        for (int i = 0; i < 2; ++i) {
          const int d = i * 16 + fq * 4;
          const float4 cs01 = *(const float4*)(p.rope + (size_t)tok * 32 + d);
          const float4 cs23 = *(const float4*)(p.rope + (size_t)tok * 32 + d + 2);
          const float cc[4] = {cs01.x, cs01.z, cs23.x, cs23.z};
          const float ss[4] = {cs01.y, cs01.w, cs23.y, cs23.w};
          f32x4 o1, o2v;
#pragma unroll
          for (int r = 0; r < 4; ++r) {
            float x1 = o2[i][j][r], x2 = o2[i + 2][j][r];
            o1[r] = valid ? x1 * cc[r] - x2 * ss[r] : 0.f;
            o2v[r] = valid ? x2 * cc[r] + x1 * ss[r] : 0.f;
          }
          *(uint2*)(dst + d) = pack4(o1);
          *(uint2*)(dst + d + 32) = pack4(o2v);
        }
      } else {
#pragma unroll
        for (int dm = 0; dm < 4; ++dm)
#pragma unroll
          for (int r = 0; r < 4; ++r) {
            const int d = dm * 16 + fq * 4 + r;
            p.vcT[((size_t)(b * 2 + g) * 64 + d) * 256 + c] = valid ? f2bf(o2[dm][j][r]) : (u16)0;
          }
      }
    }
    __syncthreads();
  }
}

__device__ __forceinline__ int rho_row(int k) { return (k & 32) | ((k & 4) << 2) | ((k & 24) >> 1) | (k & 3); }

__device__ __forceinline__ void load_tile64(u16* s, const u16* src, size_t ld, bool perm) {
  const int c = threadIdx.x & 7, r0 = threadIdx.x >> 3;
  uint4 v0 = *(const uint4*)(src + (size_t)r0 * ld + c * 8);
  const int l0 = perm ? rho_row(r0) : r0;
  *(uint4*)(s + l0 * LDSP + c * 8) = v0;
}

__device__ __forceinline__ void phase_sba_attn(const Params& p, u16* sm) {
  const int tid = threadIdx.x, lane = tid & 63, wave = tid >> 6, fr = lane & 15, fq = lane >> 4;
  u16* sK0 = sm; u16* sV0 = sm + 64 * LDSP;
  bf16x8 tri[2], ones;
#pragma unroll
  for (int bb = 0; bb < 2; ++bb) {
    uint32_t w[4];
#pragma unroll
    for (int i2 = 0; i2 < 4; ++i2) {
      const int s_ = 8 * (fr >> 2) + 4 * bb + (fr & 3);
      const int j0 = 8 * fq + 2 * i2, j1 = j0 + 1;
      w[i2] = (j0 > s_ ? 0x3F80u : 0u) | ((j1 > s_ ? 0x3F80u : 0u) << 16);
    }
    tri[bb] = mk_frag(w[0], w[1], w[2], w[3]);
  }
  ones = mk_frag(0x3F803F80u, 0x3F803F80u, 0x3F803F80u, 0x3F803F80u);

  const int ntiles = 128 * 32;
  for (int tile = blockIdx.x; tile < ntiles; tile += gridDim.x) {
    const int qt = 31 - (tile >> 7), bh = tile & 127;
    const int b = bh >> 4, h = bh & 15;
    const int myq = qt * 128 + wave * 16 + fr;
    bf16x8 qf[2];
#pragma unroll
    for (int ks = 0; ks < 2; ++ks) qf[ks] = *(const bf16x8*)(p.qb + ((size_t)b * SEQ + myq) * DM + h * 64 + ks * 32 + fq * 8);
    f32x4 o[4];
#pragma unroll
    for (int dm = 0; dm < 4; ++dm) o[dm] = (f32x4){0.f, 0.f, 0.f, 0.f};
    float carry = 0.f;
    const int pc = tid & 7, pr = tid >> 3, prl = rho_row(pr);
    const u16* kbase = p.kb + ((size_t)b * SEQ) * DM + h * 64 + (size_t)pr * DM + pc * 8;
    const u16* vbase = p.vT + ((size_t)(b * 16 + h) * 64 + pr) * SEQ + pc * 8;
    uint4 rk = *(const uint4*)(kbase + (size_t)(2 * qt + 1) * 64 * DM);
    uint4 rv = *(const uint4*)(vbase + (2 * qt + 1) * 64);
    int buf = 0;
    for (int kt = 2 * qt + 1; kt >= 0; --kt) {
      u16* sK = sK0 + buf * 2 * 64 * LDSP; u16* sV = sV0 + buf * 2 * 64 * LDSP;
      *(uint4*)(sK + prl * LDSP + pc * 8) = rk;
      *(uint4*)(sV + pr * LDSP + pc * 8) = rv;
      if (kt > 0) { rk = *(const uint4*)(kbase + (size_t)(kt - 1) * 64 * DM); rv = *(const uint4*)(vbase + (kt - 1) * 64); }
      buf ^= 1;
      __syncthreads();
      const bool wave_idle = (kt * 64 >= qt * 128 + wave * 16 + 15) || (__ballot(carry >= -150.1f) == 0ull);
      if (!wave_idle) {
      f32x4 s[4];
#pragma unroll
      for (int mt = 0; mt < 4; ++mt) {
        s[mt] = (f32x4){0.f, 0.f, 0.f, 0.f};
#pragma unroll
        for (int ks = 0; ks < 2; ++ks) {
          bf16x8 kf = *(const bf16x8*)(sK + (mt * 16 + fr) * LDSP + ks * 32 + fq * 8);
          s[mt] = mfma16(kf, qf[ks], s[mt]);
        }
      }
      const bool tile_masked = (kt * 64 + 63 >= qt * 128 + wave * 16);
      constexpr float SBA_C = 0.125f * 1.4426950408889634f;
      float L[4][4], lb[4][4];
      unsigned vmask = 0xffffu;
      if (tile_masked) {
        vmask = 0;
#pragma unroll
        for (int mt = 0; mt < 4; ++mt)
#pragma unroll
          for (int j = 0; j < 4; ++j) {
            const float z = s[mt][j] * SBA_C;
            const int key = kt * 64 + 32 * (mt >> 1) + 8 * fq + 4 * (mt & 1) + j;
            const bool valid = key < myq;
            const float e = __builtin_amdgcn_exp2f(-fabsf(z));
            const float sp = fmaxf(z, 0.f) + __builtin_amdgcn_logf(1.f + e);
            L[mt][j] = valid ? -sp : 0.f;
            lb[mt][j] = z - sp;
            vmask |= (valid ? 1u : 0u) << (mt * 4 + j);
          }
      } else {
#pragma unroll
        for (int mt = 0; mt < 4; ++mt)
#pragma unroll
          for (int j = 0; j < 4; ++j) {
            const float z = s[mt][j] * SBA_C;
            const float e = __builtin_amdgcn_exp2f(-fabsf(z));
            const float sp = fmaxf(z, 0.f) + __builtin_amdgcn_logf(1.f + e);
            L[mt][j] = -sp;
            lb[mt][j] = z - sp;
          }
      }
      bf16x8 Lh[2], Ll[2];
#pragma unroll
      for (int k2 = 0; k2 < 2; ++k2) {
        uint32_t hw[4], lw[4];
#pragma unroll
        for (int e2 = 0; e2 < 4; ++e2) {
          const int mt = 2 * k2 + (e2 >> 1), j = (e2 & 1) * 2;
          hw[e2] = pack2(L[mt][j], L[mt][j + 1]);
          const float r0 = L[mt][j] - __uint_as_float(hw[e2] << 16), r1 = L[mt][j + 1] - __uint_as_float(hw[e2] & 0xffff0000u);
          lw[e2] = pack2(r0, r1);
        }
        Lh[k2] = mk_frag(hw[0], hw[1], hw[2], hw[3]);
        Ll[k2] = mk_frag(lw[0], lw[1], lw[2], lw[3]);
      }
      f32x4 cum[4];
#pragma unroll
      for (int ms = 0; ms < 4; ++ms) {
        const int a = ms >> 1, bb = ms & 1;
        f32x4 c = (f32x4){0.f, 0.f, 0.f, 0.f};
        c = mfma16(tri[bb], Lh[a], c);
        c = mfma16(tri[bb], Ll[a], c);
        if (a == 0) { c = mfma16(ones, Lh[1], c); c = mfma16(ones, Ll[1], c); }
        cum[ms] = c;
      }
      float tot = cum[0][0] + L[0][0];
      tot = __shfl(tot, fr);
      bf16x8 pf[2];
#pragma unroll
      for (int k2 = 0; k2 < 2; ++k2) {
        uint32_t pw[4];
#pragma unroll
        for (int e2 = 0; e2 < 4; ++e2) {
          const int mt = 2 * k2 + (e2 >> 1), j = (e2 & 1) * 2;
          float p0 = __builtin_amdgcn_exp2f(lb[mt][j] + cum[mt][j] + carry);
          float p1 = __builtin_amdgcn_exp2f(lb[mt][j + 1] + cum[mt][j + 1] + carry);
          if (tile_masked) {
            p0 = ((vmask >> (mt * 4 + j)) & 1u) ? p0 : 0.f;
            p1 = ((vmask >> (mt * 4 + j + 1)) & 1u) ? p1 : 0.f;
          }
          pw[e2] = pack2(p0, p1);
        }
        pf[k2] = mk_frag(pw[0], pw[1], pw[2], pw[3]);
      }
#pragma unroll
      for (int k2 = 0; k2 < 2; ++k2)
#pragma unroll
        for (int dm = 0; dm < 4; ++dm) {
          bf16x8 vf = *(const bf16x8*)(sV + (dm * 16 + fr) * LDSP + k2 * 32 + fq * 8);
          o[dm] = mfma16(vf, pf[k2], o[dm]);
        }
      carry += tot;
      }
      if (__syncthreads_and(carry < -150.1f)) break;
    }
#pragma unroll
    for (int dm = 0; dm < 4; ++dm)
      *(uint2*)(p.ob + ((size_t)b * SEQ + myq) * DM + h * 64 + dm * 16 + fq * 4) = pack4(o[dm]);
  }
}

struct NsaState {
  f32x4 acc[2][4];
  f32x4 accL[2];
  float m[2], l[2];
};

__device__ __forceinline__ void nsa_qk(f32x4 (&s)[2][4], const u16* sK, const bf16x8 (&qf)[2][2], int fr, int fq) {
#pragma unroll
  for (int mt = 0; mt < 4; ++mt) {
    s[0][mt] = (f32x4){0.f, 0.f, 0.f, 0.f}; s[1][mt] = (f32x4){0.f, 0.f, 0.f, 0.f};
#pragma unroll
    for (int ks = 0; ks < 2; ++ks) {
      bf16x8 kf = *(const bf16x8*)(sK + (mt * 16 + fr) * LDSP + ks * 32 + fq * 8);
      s[0][mt] = mfma16(kf, qf[0][ks], s[0][mt]);
      s[1][mt] = mfma16(kf, qf[1][ks], s[1][mt]);
    }
  }
}

__device__ __forceinline__ void nsa_pv(f32x4 (&acc)[2][4], const u16* sV, const bf16x8 (&pf)[2][2], int fr, int fq) {
#pragma unroll
  for (int k2 = 0; k2 < 2; ++k2)
#pragma unroll
    for (int dm = 0; dm < 4; ++dm) {
      bf16x8 vf = *(const bf16x8*)(sV + (dm * 16 + fr) * LDSP + k2 * 32 + fq * 8);
      acc[0][dm] = mfma16(vf, pf[0][k2], acc[0][dm]);
      acc[1][dm] = mfma16(vf, pf[1][k2], acc[1][dm]);
    }
}

constexpr float SM_C = 0.125f * 1.4426950408889634f;
template <bool MASKED>
__device__ __forceinline__ void nsa_online_step(NsaState& st, f32x4 (&s)[2][4], unsigned vmask, bool lanevalid, const u16* sV, int fr, int fq) {
  bf16x8 pf[2][2];
  const uint32_t lmask = lanevalid ? 0xffffffffu : 0u;
  const bf16x8 ones = mk_frag(0x3F803F80u, 0x3F803F80u, 0x3F803F80u, 0x3F803F80u);
  constexpr float DEFER = 8.f / SM_C;
#pragma unroll
  for (int hh = 0; hh < 2; ++hh) {
    float tmax = -1e30f;
    if (MASKED) {
#pragma unroll
      for (int mt = 0; mt < 4; ++mt)
#pragma unroll
        for (int j = 0; j < 4; ++j) {
          const float sc = ((vmask >> (mt * 4 + j)) & 1u) ? s[hh][mt][j] : -1e30f;
          s[hh][mt][j] = sc;
          tmax = fmaxf(tmax, sc);
        }
    } else {
#pragma unroll
      for (int mt = 0; mt < 4; ++mt)
#pragma unroll
        for (int j = 0; j < 4; ++j) tmax = fmaxf(tmax, s[hh][mt][j]);
      tmax = lanevalid ? tmax : -1e30f;
    }
    tmax = fmaxf(tmax, __shfl_xor(tmax, 16));
    tmax = fmaxf(tmax, __shfl_xor(tmax, 32));
    const bool upd = tmax > st.m[hh] + DEFER;
    if (__ballot(upd) != 0ull) {
      const float mnew = upd ? tmax : st.m[hh];
      const float alpha = __builtin_amdgcn_exp2f((st.m[hh] - mnew) * SM_C);
      st.m[hh] = mnew;
#pragma unroll
      for (int dm = 0; dm < 4; ++dm) st.acc[hh][dm] *= alpha;
      st.accL[hh] *= alpha;
    }
    const float nb = -st.m[hh] * SM_C;
#pragma unroll
    for (int k2 = 0; k2 < 2; ++k2) {
      uint32_t pw[4];
#pragma unroll
      for (int e2 = 0; e2 < 4; ++e2) {
        const int mt = 2 * k2 + (e2 >> 1), j = (e2 & 1) * 2;
        float p0 = __builtin_amdgcn_exp2f(__builtin_fmaf(s[hh][mt][j], SM_C, nb));
        float p1 = __builtin_amdgcn_exp2f(__builtin_fmaf(s[hh][mt][j + 1], SM_C, nb));
        if (MASKED) {
          p0 = ((vmask >> (mt * 4 + j)) & 1u) ? p0 : 0.f;
          p1 = ((vmask >> (mt * 4 + j + 1)) & 1u) ? p1 : 0.f;
        }
        pw[e2] = pack2(p0, p1);
        if (!MASKED) pw[e2] &= lmask;
      }
      pf[hh][k2] = mk_frag(pw[0], pw[1], pw[2], pw[3]);
      st.accL[hh] = mfma16(ones, pf[hh][k2], st.accL[hh]);
    }
#pragma unroll
    for (int k2 = 0; k2 < 2; ++k2)
#pragma unroll
      for (int dm = 0; dm < 4; ++dm) {
        const bf16x8 vf = *(const bf16x8*)(sV + (dm * 16 + fr) * LDSP + k2 * 32 + fq * 8);
        st.acc[hh][dm] = mfma16(vf, pf[hh][k2], st.acc[hh][dm]);
      }
  }
}

__device__ __forceinline__ void nsa_reset(NsaState& st) {
#pragma unroll
  for (int hh = 0; hh < 2; ++hh) {
    st.m[hh] = -1e30f; st.l[hh] = 0.f; st.accL[hh] = (f32x4){0.f, 0.f, 0.f, 0.f};
#pragma unroll
    for (int dm = 0; dm < 4; ++dm) st.acc[hh][dm] = (f32x4){0.f, 0.f, 0.f, 0.f};
  }
}

__device__ __forceinline__ void nsa_finish(NsaState& st, f32x4 (&out)[2][4], const float (&gate)[2]) {
#pragma unroll
  for (int hh = 0; hh < 2; ++hh) {
    const float l = st.accL[hh][0];
    const float sc = (l > 0.f) ? gate[hh] / l : 0.f;
#pragma unroll
    for (int dm = 0; dm < 4; ++dm) out[hh][dm] += st.acc[hh][dm] * sc;
  }
}

__device__ __forceinline__ void phase_nsa_cmp(const Params& p, u16* sm) {
  const int tid = threadIdx.x, lane = tid & 63, wave = tid >> 6, fr = lane & 15, fq = lane >> 4;
  const int wq = wave & 3, qh = wave >> 2;
  u16* sKall = sm; u16* sVall = sm + 4 * 64 * LDSP;
  unsigned* PsumU = (unsigned*)(sm + 8 * 64 * LDSP);
  float* Imp = (float*)(PsumU + 32 * 260);
  const int ntiles = 16 * 128;
  for (int tile = blockIdx.x; tile < ntiles; tile += gridDim.x) {
    int qb = 127 - (tile >> 4), bg = tile & 15;
    if (gridDim.x == 256) {
      const int k = 7 - (tile >> 8), r = (int)blockIdx.x >> 4;
      qb = 32 * (k >> 1) + ((k & 1) ? 31 - r : r);
      bg = (int)blockIdx.x & 15;
    }
    const int b = bg >> 1, g = bg & 1;
    const int t0 = qb * 32, myt = t0 + 16 * qh + fr;
    const size_t tokbase = (size_t)b * SEQ;
    const int hA = g * 8 + wq * 2;
    bf16x8 qf[2][2];
#pragma unroll
    for (int hh = 0; hh < 2; ++hh)
#pragma unroll
      for (int ks = 0; ks < 2; ++ks)
        qf[hh][ks] = *(const bf16x8*)(p.qn + (tokbase + myt) * DM + (hA + hh) * 64 + ks * 32 + fq * 8);
    float gate0[2];
#pragma unroll
    for (int hh = 0; hh < 2; ++hh) gate0[hh] = p.gbuf[(tokbase + myt) * 48 + (hA + hh) * 3 + 0];

#pragma unroll
    for (int i = 0; i < 17; ++i) { int idx = tid + 512 * i; if (idx < 32 * 260) PsumU[idx] = 0u; }

    const u16* kcb = p.kc + (size_t)(b * 2 + g) * 256 * 64;
    const u16* vcb = p.vcT + (size_t)(b * 2 + g) * 64 * 256;
    const int ncmp = (t0 >> 4) + 1;
    const int nct = (ncmp + 63) >> 6;
    NsaState st;
    f32x4 s[2][4];
    for (int kt = 0; kt < nct; ++kt) {
      load_tile64(sKall + kt * 64 * LDSP, kcb + (size_t)kt * 64 * 64, 64, true);
      load_tile64(sVall + kt * 64 * LDSP, vcb + kt * 64, 256, false);
    }
    __syncthreads();
    nsa_reset(st);
    for (int kt = 0; kt < nct; ++kt) {
      const u16* sK = sKall + kt * 64 * LDSP;
      nsa_qk(s, sK, qf, fr, fq);
      unsigned vmask = 0;
#pragma unroll
      for (int mt = 0; mt < 4; ++mt)
#pragma unroll
        for (int j = 0; j < 4; ++j) {
          const int c = kt * 64 + 32 * (mt >> 1) + 8 * fq + 4 * (mt & 1) + j;
          vmask |= ((16 * c + 31 <= myt) ? 1u : 0u) << (mt * 4 + j);
        }
#pragma unroll
      for (int hh = 0; hh < 2; ++hh) {
        float tmax = -1e30f;
#pragma unroll
        for (int mt = 0; mt < 4; ++mt)
#pragma unroll
          for (int j = 0; j < 4; ++j) {
            const float sc = ((vmask >> (mt * 4 + j)) & 1u) ? s[hh][mt][j] * 0.125f : -1e30f;
            s[hh][mt][j] = sc; tmax = fmaxf(tmax, sc);
          }
        tmax = fmaxf(tmax, __shfl_xor(tmax, 16));
        tmax = fmaxf(tmax, __shfl_xor(tmax, 32));
        const float mnew = fmaxf(st.m[hh], tmax);
        float psum = 0.f;
#pragma unroll
        for (int mt = 0; mt < 4; ++mt)
#pragma unroll
          for (int j = 0; j < 4; ++j) psum += ((vmask >> (mt * 4 + j)) & 1u) ? __expf(s[hh][mt][j] - mnew) : 0.f;
        st.l[hh] = st.l[hh] * __expf(st.m[hh] - mnew) + psum;
        st.m[hh] = mnew;
      }
    }
    float invl[2];
#pragma unroll
    for (int hh = 0; hh < 2; ++hh) {
      float l = st.l[hh];
      l += __shfl_xor(l, 16);
      l += __shfl_xor(l, 32);
      invl[hh] = (l > 0.f) ? 1.f / l : 0.f;
    }
    for (int kt = 0; kt < nct; ++kt) {
      const u16* sK = sKall + kt * 64 * LDSP;
      const u16* sV = sVall + kt * 64 * LDSP;
      nsa_qk(s, sK, qf, fr, fq);
      bf16x8 pf[2][2];
      float pp[4][4];
#pragma unroll
      for (int mt = 0; mt < 4; ++mt)
#pragma unroll
        for (int j = 0; j < 4; ++j) pp[mt][j] = 0.f;
#pragma unroll
      for (int hh = 0; hh < 2; ++hh) {
#pragma unroll
        for (int k2 = 0; k2 < 2; ++k2) {
          uint32_t pw[4];
#pragma unroll
          for (int e2 = 0; e2 < 4; ++e2) {
            const int mt = 2 * k2 + (e2 >> 1), j = (e2 & 1) * 2;
            const int c0 = kt * 64 + 32 * (mt >> 1) + 8 * fq + 4 * (mt & 1) + j;
            float p0 = (16 * c0 + 31 <= myt) ? __expf(s[hh][mt][j] * 0.125f - st.m[hh]) * invl[hh] : 0.f;
            float p1 = (16 * (c0 + 1) + 31 <= myt) ? __expf(s[hh][mt][j + 1] * 0.125f - st.m[hh]) * invl[hh] : 0.f;
            pp[mt][j] += p0; pp[mt][j + 1] += p1;
            pw[e2] = pack2(p0, p1);
          }
          pf[hh][k2] = mk_frag(pw[0], pw[1], pw[2], pw[3]);
        }
#pragma unroll
        for (int k2 = 0; k2 < 2; ++k2)
#pragma unroll
          for (int dm = 0; dm < 4; ++dm) {
            const bf16x8 vf = *(const bf16x8*)(sV + (dm * 16 + fr) * LDSP + k2 * 32 + fq * 8);
            st.acc[hh][dm] = mfma16(vf, pf[hh][k2], st.acc[hh][dm]);
          }
      }
#pragma unroll
      for (int mt = 0; mt < 4; ++mt)
#pragma unroll
        for (int j = 0; j < 4; ++j) {
          const int c = kt * 64 + 32 * (mt >> 1) + 8 * fq + 4 * (mt & 1) + j;
          atomicAdd(&PsumU[(16 * qh + fr) * 260 + c], (unsigned)(pp[mt][j] * 268435456.f + 0.5f));
        }
    }
#pragma unroll
    for (int hh = 0; hh < 2; ++hh)
#pragma unroll
      for (int dm = 0; dm < 4; ++dm)
        *(uint2*)(p.ocp + (tokbase + myt) * DM + (hA + hh) * 64 + dm * 16 + fq * 4) = pack4(st.acc[hh][dm] * gate0[hh]);
    __syncthreads();
#pragma unroll
    for (int e = 0; e < 4; ++e) {
      const int idx = tid + 512 * e, q = idx >> 6, n = idx & 63;
      const unsigned* Pq = PsumU + q * 260 + 4 * n;
      const float sc28 = 1.f / 268435456.f;
      float v = ((float)Pq[0] + (float)Pq[1] + (float)Pq[2] + 0.5f * ((float)Pq[3] + (n > 0 ? (float)Pq[-1] : 0.f))) * sc28;
      Imp[q * 64 + n] = v;
    }
    __syncthreads();
#pragma unroll
    for (int qi = 0; qi < 4; ++qi) {
      const int q = wave * 4 + qi, tq = t0 + q, cur = tq >> 6, n = lane;
      const bool causal = (n <= cur);
      const bool forced = (n == 0) || (n == cur) || (n == cur - 1);
      const float sc = causal ? (Imp[q * 64 + n] + (forced ? 1e4f : 0.f)) : -1e30f;
      int rank = 0;
      Imp[q * 64 + n] = sc;
      __builtin_amdgcn_wave_barrier();
#pragma unroll 8
      for (int n2 = 0; n2 < 64; ++n2) {
        const float s2 = Imp[q * 64 + n2];
        rank += ((s2 > sc) || (s2 == sc && n2 < n)) ? 1 : 0;
      }
      const unsigned long long mk = __ballot(causal && rank < 16);
      if (lane == 0) p.msk[(size_t)(b * 2 + g) * SEQ + tq] = mk;
    }
    __syncthreads();
  }
}

__device__ __forceinline__ void phase_nsa_sw(const Params& p, u16* sm) {
  const int tid = threadIdx.x, lane = tid & 63, wave = tid >> 6, fr = lane & 15, fq = lane >> 4;
  const int wq = wave & 3, qh = wave >> 2;
  u16* sK = sm; u16* sV = sm + 64 * LDSP;
  int* lst = (int*)(sm + 4 * 64 * LDSP);
  uint2* selL = (uint2*)(sm + 4 * 64 * LDSP + 256) + wave * 512 + lane;
  const int ntiles = 16 * 128;
  for (int tile = blockIdx.x; tile < ntiles; tile += gridDim.x) {
    int qb = 127 - (tile >> 4), bg = tile & 15;
    if (gridDim.x == 256) {
      const int k = 7 - (tile >> 8), r = (int)blockIdx.x >> 4;
      qb = 32 * (k >> 1) + ((k & 1) ? 31 - r : r);
      bg = (int)blockIdx.x & 15;
    }
    const int b = bg >> 1, g = bg & 1;
    const int t0 = qb * 32, myt = t0 + 16 * qh + fr;
    const size_t tokbase = (size_t)b * SEQ;
    const int hA = g * 8 + wq * 2;
    bf16x8 qf[2][2];
#pragma unroll
    for (int hh = 0; hh < 2; ++hh)
#pragma unroll
      for (int ks = 0; ks < 2; ++ks)
        qf[hh][ks] = *(const bf16x8*)(p.qn + (tokbase + myt) * DM + (hA + hh) * 64 + ks * 32 + fq * 8);
    float gates[2][3];
#pragma unroll
    for (int hh = 0; hh < 2; ++hh)
#pragma unroll
      for (int r = 0; r < 3; ++r) gates[hh][r] = p.gbuf[(tokbase + myt) * 48 + (hA + hh) * 3 + r];
    NsaState st;
    f32x4 s[2][4];
    const unsigned long long* mskp = p.msk + (size_t)(b * 2 + g) * SEQ + t0;
    const unsigned long long mymask = mskp[16 * qh + fr];
    unsigned long long um = 0;
#pragma unroll
    for (int q = 0; q < 32; ++q) um |= mskp[q];
    const u16* ksb = p.ksb + tokbase * 128 + g * 64;
    const u16* vsb = p.vsT + (size_t)(b * 2 + g) * 64 * SEQ;
    const u16* kwb = p.kwb + tokbase * 128 + g * 64;
    const u16* vwb = p.vwT + (size_t)(b * 2 + g) * 64 * SEQ;
    const int kt_lo = (t0 >= 511) ? ((t0 - 511) >> 6) : 0, kt_hi = (t0 + 31) >> 6;
    const int nsel = __popcll(um), ntl = nsel + (kt_hi - kt_lo + 1);
    if (tid < 64) {
      if ((um >> tid) & 1ull) lst[__popcll(um & ((1ull << tid) - 1ull))] = tid;
      if (tid <= kt_hi - kt_lo) lst[nsel + tid] = 64 + kt_lo + tid;
    }
    __syncthreads();
    const int pc = tid & 7, pr = tid >> 3, prl = rho_row(pr);
    uint4 rkA, rvA;
#define NSA_FETCH(rk, rv, e) do { const int v_ = lst[(e)]; \
      const u16* kp_ = (v_ < 64) ? ksb + (size_t)v_ * 64 * 128 : kwb + (size_t)(v_ - 64) * 64 * 128; \
      const u16* vp_ = (v_ < 64) ? vsb + v_ * 64 : vwb + (v_ - 64) * 64; \
      rk = *(const uint4*)(kp_ + (size_t)pr * 128 + pc * 8); rv = *(const uint4*)(vp_ + (size_t)pr * SEQ + pc * 8); } while (0)
#define NSA_PUT(rk, rv, buf) do { *(uint4*)(sK + (buf) * 2 * 64 * LDSP + prl * LDSP + pc * 8) = rk; \
      *(uint4*)(sV + (buf) * 2 * 64 * LDSP + pr * LDSP + pc * 8) = rv; } while (0)
    NSA_FETCH(rkA, rvA, 0);
    NSA_PUT(rkA, rvA, 0);
    if (ntl > 1) NSA_FETCH(rkA, rvA, 1);
    nsa_reset(st);
    for (int i = 0; i < ntl; ++i) {
      __syncthreads();
      const int v = lst[i];
      const u16* cK = sK + (i & 1) * 2 * 64 * LDSP;
      const u16* cV = sV + (i & 1) * 2 * 64 * LDSP;
      if (i == nsel) {
        f32x4 tmp[2][4];
#pragma unroll
        for (int hh = 0; hh < 2; ++hh)
#pragma unroll
          for (int dm = 0; dm < 4; ++dm) tmp[hh][dm] = (f32x4){0.f, 0.f, 0.f, 0.f};
        const float gg[2] = {gates[0][1], gates[1][1]};
        nsa_finish(st, tmp, gg);
#pragma unroll
        for (int hh = 0; hh < 2; ++hh)
#pragma unroll
          for (int dm = 0; dm < 4; ++dm) selL[(hh * 4 + dm) * 64] = pack4(tmp[hh][dm]);
        nsa_reset(st);
      }
      nsa_qk(s, cK, qf, fr, fq);
      {
        const bool is_sel = (v < 64);
        const int kt = is_sel ? v : v - 64;
        const bool lv = is_sel ? (bool)((mymask >> v) & 1ull) : true;
        const bool masked = is_sel ? (v == (t0 >> 6)) : !((64 * kt + 63 <= t0) && (64 * kt >= t0 - 480));
        if (masked) {
          const int wnd = is_sel ? (1 << 30) : 512;
          unsigned vmask = 0;
#pragma unroll
          for (int mt = 0; mt < 4; ++mt)
#pragma unroll
            for (int j = 0; j < 4; ++j) {
              const int key = kt * 64 + 32 * (mt >> 1) + 8 * fq + 4 * (mt & 1) + j;
              const int diff = myt - key;
              vmask |= ((lv && diff >= 0 && diff < wnd) ? 1u : 0u) << (mt * 4 + j);
            }
          nsa_online_step<true>(st, s, vmask, true, cV, fr, fq);
        } else {
          nsa_online_step<false>(st, s, 0u, lv, cV, fr, fq);
        }
      }
      if (i + 1 < ntl) NSA_PUT(rkA, rvA, (i + 1) & 1);
      if (i + 2 < ntl) NSA_FETCH(rkA, rvA, i + 2);
    }
#undef NSA_FETCH
#undef NSA_PUT
    f32x4 out[2][4];
#pragma unroll
    for (int hh = 0; hh < 2; ++hh)
#pragma unroll
      for (int dm = 0; dm < 4; ++dm) {
        const uint2 pv = *(const uint2*)(p.ocp + (tokbase + myt) * DM + (hA + hh) * 64 + dm * 16 + fq * 4);
        const uint2 sv = selL[(hh * 4 + dm) * 64];
        out[hh][dm] = (f32x4){bf2f((u16)(pv.x & 0xffff)) + bf2f((u16)(sv.x & 0xffff)), bf2f((u16)(pv.x >> 16)) + bf2f((u16)(sv.x >> 16)),
                              bf2f((u16)(pv.y & 0xffff)) + bf2f((u16)(sv.y & 0xffff)), bf2f((u16)(pv.y >> 16)) + bf2f((u16)(sv.y >> 16))};
      }
    {
      const float gg[2] = {gates[0][2], gates[1][2]};
      nsa_finish(st, out, gg);
    }
#pragma unroll
    for (int hh = 0; hh < 2; ++hh)
#pragma unroll
      for (int dm = 0; dm < 4; ++dm)
        *(uint2*)(p.ob + (tokbase + myt) * DM + (hA + hh) * 64 + dm * 16 + fq * 4) = pack4(out[hh][dm]);
    __syncthreads();
  }
}

__device__ __forceinline__ void run_phase(const Params& p, const int ph, u16* sm) {
  switch (ph) {
    case 0: phase_prep(p, sm); break;
    case 1: { EpiSbaQkv e; e.qb = p.qb; e.kb = p.kb; e.vT = p.vT; run_gemm(sm, p.hn, p.wt_sba_in, NTOK, 3072, DM, e); } break;
    case 2: phase_sba_attn(p, sm); break;
    case 3: { EpiResidB<true> e; e.resid32 = p.x; e.xb = p.xb; e.rowss = p.rowss; run_gemm(sm, p.ob, p.wt_sba_out, NTOK, DM, DM, e); } break;
    case 5: { EpiUpConv e; e.act = p.act; e.ub = p.ub; e.rowss = p.rowss; e.cw = p.conv_w; e.cb = p.conv_b; run_gemm(sm, p.xb, p.wt_up0, NTOK, NUP, DM, e); } break;
    case 6: phase_ffn_fix(p, 0); break;
    case 7: { EpiResidB<false> e; e.resid32 = nullptr; e.xb = p.xb; e.rowss = p.rowss + NTOK; run_gemm(sm, p.act, p.wt_down0, NTOK, DM, DFF, e); } break;
    case 12: { EpiNsaIn e; e.qn = p.qn; e.cbuf = p.cbuf; e.ksb = p.ksb; e.kwb = p.kwb; e.vsT = p.vsT; e.vwT = p.vwT; e.gbuf = p.gbuf; e.rope = p.rope; e.rowss = p.rowss + NTOK;
               run_gemm(sm, p.xb, p.wt_nsa_in, NTOK, NSAWP, DM, e); } break;
    case 13: phase_compress(p, sm); break;
    case 14: phase_nsa_cmp(p, sm); break;
    case 15: phase_nsa_sw(p, sm); break;
    case 16: { EpiResidB<false> e; e.resid32 = nullptr; e.xb = p.xb; e.rowss = p.rowss + 2 * NTOK; run_gemm(sm, p.ob, p.wt_nsa_out, NTOK, DM, DM, e); } break;
    case 18: { EpiUpConv e; e.act = p.act; e.ub = p.ub; e.rowss = p.rowss + 2 * NTOK; e.cw = p.conv_w + (size_t)3 * NUP; e.cb = p.conv_b + NUP; run_gemm(sm, p.xb, p.wt_up1, NTOK, NUP, DM, e); } break;
    case 19: phase_ffn_fix(p, 1); break;
    case 20: { EpiResidLast e; e.xb = p.xb; e.out = p.out; run_gemm(sm, p.act, p.wt_down1, NTOK, DM, DFF, e); } break;
    case 24: phase_final_norm(p.out, p.norm_final); break;
    default: break;
  }
}

#ifndef PROBE_REP
#define PROBE_REP 0u
#endif
#define GRID_BAR() grid_barrier((unsigned*)(ka.ws + O_BAR), (volatile LAS unsigned*)&xb_words, bar_k++)
#define PHASE_SEQ(n) if (p.phase_lo <= (n) && (n) <= p.phase_hi) { \
    if ((PROBE_REP >> (n)) & 1u) { run_phase(p, (n), sm); GRID_BAR(); } \
    run_phase(p, (n), sm); if ((n) < p.phase_hi) { if ((n) == 0) { cg::this_grid().sync(); if (threadIdx.x == 0) xb_census((unsigned*)(ka.ws + O_BAR), (volatile LAS unsigned*)&xb_words); __syncthreads(); } else GRID_BAR(); } }
__global__ void __launch_bounds__(512, 2) hybrid_megakernel(KArgs ka) {
  const Params p = make_params(ka);
  __shared__ __attribute__((aligned(16))) u16 sm[SMEM_BYTES / 2];
  unsigned bar_k = 0;
  __shared__ uint4 xb_words;
  if (threadIdx.x == 0 && p.phase_lo < p.phase_hi) xb_post((unsigned*)(ka.ws + O_BAR));
  PHASE_SEQ(0) PHASE_SEQ(1) PHASE_SEQ(2) PHASE_SEQ(3) PHASE_SEQ(5) PHASE_SEQ(6) PHASE_SEQ(7)
  PHASE_SEQ(12) PHASE_SEQ(13) PHASE_SEQ(14) PHASE_SEQ(15)
  PHASE_SEQ(16) PHASE_SEQ(18) PHASE_SEQ(19) PHASE_SEQ(20)
  PHASE_SEQ(24)
}

extern "C" void kernel_launch(void* const* d_in, const int* in_sizes, int n_in, void* d_out, int out_size, void* d_ws,
                              size_t ws_size, hipStream_t stream) {
  KArgs p;
  memset(&p, 0, sizeof(p));
  for (int i = 0; i < 19; ++i) p.in[i] = d_in[i];
  p.out = (float*)d_out;
  p.ws = (char*)d_ws;
  if (ws_size < WS_NEEDED) fprintf(stderr, "workspace too small: %zu < %zu\n", ws_size, (size_t)WS_NEEDED);

  static int grid_blocks = 0;
  if (!grid_blocks) {
    int dev = 0, cus = 0, per_cu = 0;
    hipGetDevice(&dev);
    hipDeviceGetAttribute(&cus, hipDeviceAttributeMultiprocessorCount, dev);
    hipOccupancyMaxActiveBlocksPerMultiprocessor(&per_cu, hybrid_megakernel, NTHR, 0);
    if (per_cu > 1) per_cu = 1;
    if (per_cu < 1) per_cu = 1;
    grid_blocks = cus * per_cu;
  }
#if ONE_LAUNCH
  p.phase_lo = 0; p.phase_hi = NPHASE - 1;
  hipMemsetAsync((char*)d_ws + O_BAR, 0, XCD_BAR_WORDS * 4, stream);
  void* args[] = {&p};
  hipError_t e = hipLaunchCooperativeKernel((void*)hybrid_megakernel, dim3(grid_blocks), dim3(NTHR), args, 0, stream);
  if (e != hipSuccess) fprintf(stderr, "cooperative launch failed: %s (grid %d)\n", hipGetErrorString(e), grid_blocks);
#else
  for (int ph = 0; ph < NPHASE; ++ph) {
    p.phase_lo = ph; p.phase_hi = ph;
    hipLaunchKernelGGL(hybrid_megakernel, dim3(grid_blocks), dim3(NTHR), 0, stream, p);
  }
#endif
}
```

```cpp
#include <hip/hip_runtime.h>
#include <hip/hip_cooperative_groups.h>
#include <stdint.h>
#include <string.h>
#include <stdio.h>
namespace cg = cooperative_groups;

#ifndef ONE_LAUNCH
#define ONE_LAUNCH 1
#endif

typedef unsigned short u16;
typedef __attribute__((ext_vector_type(8))) short bf16x8;
typedef __attribute__((ext_vector_type(4))) float f32x4;

constexpr int SEQ = 4096, DM = 1024, NTOK = 8 * 4096, DFF = 2816, NUP = 5632;
constexpr int NSAWP = 2048;
constexpr int HALF_TOK = NTOK / 2;
constexpr int LDSP = 72;
constexpr int NPHASE = 25;
constexpr int SMEM_BYTES = 131072;
constexpr int NTHR = 512;


struct Params {
  const float* x; const int* pos; const float* norm_mix; const float* sba_w_in; const float* sba_w_out;
  const float* nsa_w_in; const float* pe_k; const float* pe_v; const float* ck_w1; const float* ck_w2;
  const float* cv_w1; const float* cv_w2; const float* nsa_w_out; const float* norm_ffn; const float* w_up;
  const float* conv_w; const float* conv_b; const float* w_down; const float* norm_final;
  float* out;
  u16 *wt_sba_in, *wt_sba_out, *wt_nsa_in, *wt_nsa_out, *wt_up0, *wt_up1, *wt_down0, *wt_down1, *wt_ck1, *wt_cv1, *wt_ck2, *wt_cv2;
  float *bpart; float2* rope; unsigned long long* rowss; u16* xb;
  u16* hn;
  u16 *qb, *kb, *vT;
  u16 *qn, *cbuf, *ksb, *kwb, *vsT, *vwT, *kc, *vcT; float* gbuf; unsigned long long* msk; u16* ocp;
  float* ub;
  u16* ob;
  u16* act;
  int phase_lo, phase_hi;
  int pad_;
};

__device__ __forceinline__ u16 f2bf(float f) {
  uint32_t u = __float_as_uint(f);
  u += 0x7fffu + ((u >> 16) & 1u);
  return (u16)(u >> 16);
}
typedef float f32x2_t __attribute__((ext_vector_type(2)));
typedef __bf16 bf16x2_t __attribute__((ext_vector_type(2)));
__device__ __forceinline__ uint32_t pack2(float a, float b) {
  f32x2_t v = {a, b};
  bf16x2_t h = __builtin_convertvector(v, bf16x2_t);
  return __builtin_bit_cast(uint32_t, h);
}
__device__ __forceinline__ float bf2f(u16 h) { return __uint_as_float(((uint32_t)h) << 16); }
__device__ __forceinline__ uint2 pack4(f32x4 v) { return make_uint2(pack2(v[0], v[1]), pack2(v[2], v[3])); }
__device__ __forceinline__ f32x4 mfma16(bf16x8 a, bf16x8 b, f32x4 c) {
  return __builtin_amdgcn_mfma_f32_16x16x32_bf16(a, b, c, 0, 0, 0);
}
__device__ __forceinline__ bf16x8 mk_frag(uint32_t a, uint32_t b, uint32_t c, uint32_t d) {
  union { uint4 u; bf16x8 v; } t; t.u = make_uint4(a, b, c, d); return t.v;
}

#define XCD_BAR_WORDS 3456
constexpr size_t al256(size_t x) { return (x + 255) & ~(size_t)255; }
constexpr size_t MB = 1024 * 1024;
constexpr size_t O_WT_SBA_IN = 0;
constexpr size_t O_WT_SBA_OUT = O_WT_SBA_IN + al256((size_t)3072 * 1024 * 2);
constexpr size_t O_WT_NSA_IN = O_WT_SBA_OUT + al256((size_t)1024 * 1024 * 2);
constexpr size_t O_WT_NSA_OUT = O_WT_NSA_IN + al256((size_t)NSAWP * 1024 * 2);
constexpr size_t O_WT_UP0 = O_WT_NSA_OUT + al256((size_t)1024 * 1024 * 2);
constexpr size_t O_WT_UP1 = O_WT_UP0 + al256((size_t)NUP * 1024 * 2);
constexpr size_t O_WT_DOWN0 = O_WT_UP1 + al256((size_t)NUP * 1024 * 2);
constexpr size_t O_WT_DOWN1 = O_WT_DOWN0 + al256((size_t)1024 * DFF * 2);
constexpr size_t O_WT_CK1 = O_WT_DOWN1 + al256((size_t)1024 * DFF * 2);
constexpr size_t O_WT_CV1 = O_WT_CK1 + al256((size_t)128 * 2048 * 2);
constexpr size_t O_WT_CK2 = O_WT_CV1 + al256((size_t)128 * 2048 * 2);
constexpr size_t O_WT_CV2 = O_WT_CK2 + al256((size_t)64 * 128 * 2);
constexpr size_t O_BIAS1K = O_WT_CV2 + al256((size_t)64 * 128 * 2);
constexpr size_t O_BIAS1V = O_BIAS1K + 512;
constexpr size_t O_ROPE = O_BIAS1V + 512;
constexpr size_t O_HN = O_ROPE + al256((size_t)NTOK * 32 * 8);
constexpr size_t O_BIG = O_HN + al256((size_t)NTOK * DM * 2);
constexpr size_t O_R2 = O_BIG + 192 * MB;
constexpr size_t O_BAR = O_R2 + al256((size_t)HALF_TOK * DFF * 2);
constexpr size_t O_BPART = O_BAR + al256((size_t)XCD_BAR_WORDS * 4);
constexpr size_t O_ROWSS = O_BPART + al256((size_t)2 * 32 * 128 * 4);
constexpr size_t O_XB = O_ROWSS + al256((size_t)4 * NTOK * 8);
constexpr size_t WS_NEEDED = O_XB + al256((size_t)NTOK * DM * 2);
constexpr size_t O_QN = O_BIG;
constexpr size_t O_CBUF = O_QN + al256((size_t)NTOK * DM * 2);
constexpr size_t O_KSB = O_CBUF + al256((size_t)NTOK * 256 * 2);
constexpr size_t O_KWB = O_KSB + al256((size_t)NTOK * 128 * 2);
constexpr size_t O_VST = O_KWB + al256((size_t)NTOK * 128 * 2);
constexpr size_t O_VWT = O_VST + al256((size_t)16 * 64 * SEQ * 2);
constexpr size_t O_KC = O_VWT + al256((size_t)16 * 64 * SEQ * 2);
constexpr size_t O_VCT = O_KC + al256((size_t)16 * 256 * 64 * 2);
constexpr size_t O_GBUF = O_VCT + al256((size_t)16 * 64 * 256 * 2);
constexpr size_t O_MSK = O_GBUF + al256((size_t)NTOK * 48 * 4);
static_assert(O_MSK + (size_t)16 * SEQ * 8 <= O_R2, "NSA buffers overflow BIG");
static_assert((size_t)NTOK * DFF * 2 <= 192 * MB, "act overflow");
static_assert((size_t)512 * 4 * NUP * 4 <= (size_t)HALF_TOK * DFF * 2, "ub overflow");

struct KArgs {
  const void* in[19];
  float* out;
  char* ws;
  int phase_lo, phase_hi;
};

__device__ __forceinline__ Params make_params(const KArgs& k) {
  Params p;
  p.x = (const float*)k.in[0]; p.pos = (const int*)k.in[1]; p.norm_mix = (const float*)k.in[2];
  p.sba_w_in = (const float*)k.in[3]; p.sba_w_out = (const float*)k.in[4]; p.nsa_w_in = (const float*)k.in[5];
  p.pe_k = (const float*)k.in[6]; p.pe_v = (const float*)k.in[7]; p.ck_w1 = (const float*)k.in[8];
  p.ck_w2 = (const float*)k.in[9]; p.cv_w1 = (const float*)k.in[10]; p.cv_w2 = (const float*)k.in[11];
  p.nsa_w_out = (const float*)k.in[12]; p.norm_ffn = (const float*)k.in[13]; p.w_up = (const float*)k.in[14];
  p.conv_w = (const float*)k.in[15]; p.conv_b = (const float*)k.in[16]; p.w_down = (const float*)k.in[17];
  p.norm_final = (const float*)k.in[18];
  p.out = k.out;
  char* ws = k.ws;
  p.wt_sba_in = (u16*)(ws + O_WT_SBA_IN); p.wt_sba_out = (u16*)(ws + O_WT_SBA_OUT);
  p.wt_nsa_in = (u16*)(ws + O_WT_NSA_IN); p.wt_nsa_out = (u16*)(ws + O_WT_NSA_OUT);
  p.wt_up0 = (u16*)(ws + O_WT_UP0); p.wt_up1 = (u16*)(ws + O_WT_UP1);
  p.wt_down0 = (u16*)(ws + O_WT_DOWN0); p.wt_down1 = (u16*)(ws + O_WT_DOWN1);
  p.wt_ck1 = (u16*)(ws + O_WT_CK1); p.wt_cv1 = (u16*)(ws + O_WT_CV1);
  p.wt_ck2 = (u16*)(ws + O_WT_CK2); p.wt_cv2 = (u16*)(ws + O_WT_CV2);
  p.bpart = (float*)(ws + O_BPART); p.rowss = (unsigned long long*)(ws + O_ROWSS); p.xb = (u16*)(ws + O_XB);
  p.rope = (float2*)(ws + O_ROPE);
  p.hn = (u16*)(ws + O_HN);
  p.qb = (u16*)(ws + O_BIG); p.kb = (u16*)(ws + O_BIG + 64 * MB); p.vT = (u16*)(ws + O_BIG + 128 * MB);
  p.qn = (u16*)(ws + O_QN); p.cbuf = (u16*)(ws + O_CBUF); p.ksb = (u16*)(ws + O_KSB); p.kwb = (u16*)(ws + O_KWB);
  p.vsT = (u16*)(ws + O_VST); p.vwT = (u16*)(ws + O_VWT); p.kc = (u16*)(ws + O_KC); p.vcT = (u16*)(ws + O_VCT);
  p.gbuf = (float*)(ws + O_GBUF); p.msk = (unsigned long long*)(ws + O_MSK);
  p.ocp = p.hn;
  p.act = (u16*)(ws + O_BIG);
  p.ob = (u16*)(ws + O_R2); p.ub = (float*)(ws + O_R2);
  p.phase_lo = k.phase_lo; p.phase_hi = k.phase_hi; p.pad_ = 0;
  return p;
}


#define LAS __attribute__((address_space(3)))
__device__ __forceinline__ unsigned xb_ld(unsigned* p)              { return __hip_atomic_load(p, __ATOMIC_RELAXED, __HIP_MEMORY_SCOPE_AGENT); }
__device__ __forceinline__ unsigned xb_add(unsigned* p, unsigned v) { return __hip_atomic_fetch_add(p, v, __ATOMIC_RELAXED, __HIP_MEMORY_SCOPE_AGENT); }
#define XB_XCNT(j)  (256  + 64 * (j))
#define XB_XSUB(j)  (1280 + 64 * (j))
#define XB_XGEN(j)  (2304 + 64 * (j))
#define XB_TOP      3328
#define XB_TOPGEN   3392
__device__ __forceinline__ unsigned xb_xcc_id() { return (unsigned)__builtin_amdgcn_s_getreg((3 << 11) | 20) & 0xFu; }
#define XB_SPIN(cond) do { unsigned _sp = 0; while (cond) { __builtin_amdgcn_s_sleep(1); if (++_sp > (1u << 24)) break; } } while (0)
__device__ __forceinline__ void xb_post(unsigned* bar) { (void)xb_add(&bar[XB_XCNT(xb_xcc_id())], 1u); }
__device__ __forceinline__ void xb_census(unsigned* bar, volatile LAS unsigned* st) {
  const unsigned x = xb_xcc_id();
  unsigned cnt = 0u, mine = 1u;
#pragma unroll 1
  for (unsigned j = 0; j < 16; ++j) { const unsigned c = xb_ld(&bar[XB_XCNT(j)]); cnt += (c > 0u) ? 1u : 0u; if (j == x) mine = c; }
  st[0] = mine > 0u ? mine : 1u; st[1] = cnt > 0u ? cnt : 1u; st[2] = x;
}
__device__ __forceinline__ void grid_barrier(unsigned* bar, volatile LAS unsigned* st, unsigned k) {
  asm volatile("s_waitcnt vmcnt(0)" ::: "memory");
  __syncthreads();
  if (threadIdx.x == 0) {
    __builtin_amdgcn_s_waitcnt(0);
    const unsigned nloc = st[0], nx = st[1], x = st[2];
    const unsigned old = xb_add(&bar[XB_XSUB(x)], 1u);
    if (old + 1u == (k + 1u) * nloc) {
      __builtin_amdgcn_fence(__ATOMIC_RELEASE, "agent");
      asm volatile("s_waitcnt vmcnt(0)" ::: "memory");
      const unsigned og = xb_add(&bar[XB_TOP], 1u);
      if (og + 1u == (k + 1u) * nx) xb_add(&bar[XB_TOPGEN], 1u);
      else XB_SPIN(xb_ld(&bar[XB_TOPGEN]) == k);
      __builtin_amdgcn_fence(__ATOMIC_ACQUIRE, "agent");
      xb_add(&bar[XB_XGEN(x)], 1u);
      asm volatile("s_waitcnt vmcnt(0)" ::: "memory");
    } else {
      XB_SPIN(xb_ld(&bar[XB_XGEN(x)]) == k);
      __builtin_amdgcn_fence(__ATOMIC_ACQUIRE, "agent");
      asm volatile("s_waitcnt vmcnt(0)" ::: "memory");
    }
  }
  __syncthreads();
}

__device__ __forceinline__ void transpose_tile2(const float* tsrc, u16* tdst, int tK, int tN, int tNpad, int tile, u16* sm, const bool rp0 = false, const bool rp1 = false, const bool upperm = false, const float* gk = nullptr) {
  const int nNt = tNpad >> 6;
  const int tid = threadIdx.x & 255;
  const int c4 = tid & 15, r = tid >> 4;
  float4 v[2][4];
  int k0s[2], n0s[2];
#pragma unroll
  for (int t = 0; t < 2; ++t) {
    const int kt = (tile + t) / nNt, nt = (tile + t) - kt * nNt;
    k0s[t] = kt * 64; n0s[t] = nt * 64;
#pragma unroll
    for (int i = 0; i < 4; ++i) {
      const int nsrc0 = upperm ? (((n0s[t] >> 7) & 1) * DFF + 128 * (n0s[t] >> 8) + (n0s[t] & 127)) : n0s[t];
      const int k = r + 16 * i, n = nsrc0 + c4 * 4;
      v[t][i] = make_float4(0.f, 0.f, 0.f, 0.f);
      if (n < tN) v[t][i] = *(const float4*)(tsrc + (size_t)(k0s[t] + k) * tN + n);
      if (gk) { const float gs = gk[k0s[t] + k]; v[t][i].x *= gs; v[t][i].y *= gs; v[t][i].z *= gs; v[t][i].w *= gs; }
    }
  }
#pragma unroll
  for (int t = 0; t < 2; ++t)
#pragma unroll
    for (int i = 0; i < 4; ++i) {
      const int k = r + 16 * i;
      u16* d = sm + t * 64 * LDSP;
      const uint32_t p01 = pack2(v[t][i].x, v[t][i].y), p23 = pack2(v[t][i].z, v[t][i].w);
      d[(c4 * 4 + 0) * LDSP + k] = (u16)(p01 & 0xffff);
      d[(c4 * 4 + 1) * LDSP + k] = (u16)(p01 >> 16);
      d[(c4 * 4 + 2) * LDSP + k] = (u16)(p23 & 0xffff);
      d[(c4 * 4 + 3) * LDSP + k] = (u16)(p23 >> 16);
    }
  __syncthreads();
  const int c8 = tid & 7, rn = tid >> 3;
#pragma unroll
  for (int t = 0; t < 2; ++t) {
    const bool ropeperm = t ? rp1 : rp0;
#pragma unroll
    for (int i = 0; i < 2; ++i) {
      const int n = rn + 32 * i;
      const int nsrc = ropeperm ? (16 * (n >> 5) + (n & 15) + 32 * ((n >> 4) & 1)) : n;
      const uint4 w = *(const uint4*)(sm + t * 64 * LDSP + nsrc * LDSP + c8 * 8);
      *(uint4*)(tdst + (size_t)(n0s[t] + n) * tK + k0s[t] + c8 * 8) = w;
    }
  }
  __syncthreads();
}

__device__ __forceinline__ void rmsnorm_row_bf16(const float* x, const float* g, u16* out, int row, int lane) {
  const float4* xr = (const float4*)(x + (size_t)row * DM);
  float4 v[4]; float ss = 0.f;
#pragma unroll
  for (int i = 0; i < 4; ++i) { v[i] = xr[lane + 64 * i]; ss += v[i].x * v[i].x + v[i].y * v[i].y + v[i].z * v[i].z + v[i].w * v[i].w; }
#pragma unroll
  for (int off = 32; off >= 1; off >>= 1) ss += __shfl_xor(ss, off);
  const float rs = rsqrtf(ss * (1.f / DM) + 1e-6f);
#pragma unroll
  for (int i = 0; i < 4; ++i) {
    float4 gg = ((const float4*)g)[lane + 64 * i];
    uint2 pk = make_uint2(pack2(v[i].x * rs * gg.x, v[i].y * rs * gg.y), pack2(v[i].z * rs * gg.z, v[i].w * rs * gg.w));
    *(uint2*)(out + (size_t)row * DM + (lane + 64 * i) * 4) = pk;
  }
}

__device__ __forceinline__ void rmsnorm_2rows_bf16(const float* x, const float* g, u16* out, int row, int lane) {
  const float4* xr = (const float4*)(x + (size_t)row * DM);
  float4 v[2][4]; float ss[2] = {0.f, 0.f};
#pragma unroll
  for (int t = 0; t < 2; ++t)
#pragma unroll
    for (int i = 0; i < 4; ++i) v[t][i] = xr[t * (DM / 4) + lane + 64 * i];
#pragma unroll
  for (int t = 0; t < 2; ++t)
#pragma unroll
    for (int i = 0; i < 4; ++i) ss[t] += v[t][i].x * v[t][i].x + v[t][i].y * v[t][i].y + v[t][i].z * v[t][i].z + v[t][i].w * v[t][i].w;
#pragma unroll
  for (int off = 32; off >= 1; off >>= 1) { ss[0] += __shfl_xor(ss[0], off); ss[1] += __shfl_xor(ss[1], off); }
#pragma unroll
  for (int t = 0; t < 2; ++t) {
    const float rs = rsqrtf(ss[t] * (1.f / DM) + 1e-6f);
#pragma unroll
    for (int i = 0; i < 4; ++i) {
      const float4 gg = ((const float4*)g)[lane + 64 * i];
      const uint2 pk = make_uint2(pack2(v[t][i].x * rs * gg.x, v[t][i].y * rs * gg.y), pack2(v[t][i].z * rs * gg.z, v[t][i].w * rs * gg.w));
      *(uint2*)(out + (size_t)(row + t) * DM + (lane + 64 * i) * 4) = pk;
    }
  }
}

__device__ __forceinline__ void phase_rmsnorm(const float* x, const float* g, u16* out) {
  const int lane = threadIdx.x & 63, wave = threadIdx.x >> 6;
  for (int it = blockIdx.x; it < NTOK / 8; it += gridDim.x) rmsnorm_row_bf16(x, g, out, it * 8 + wave, lane);
}

__device__ __forceinline__ void phase_final_norm(float* x, const float* g) {
  const int lane = threadIdx.x & 63, wave = threadIdx.x >> 6;
  for (int it = blockIdx.x; it < NTOK / 8; it += gridDim.x) {
    int row = it * 8 + wave;
    float4* xr = (float4*)(x + (size_t)row * DM);
    float4 v[4]; float ss = 0.f;
#pragma unroll
    for (int i = 0; i < 4; ++i) { v[i] = xr[lane + 64 * i]; ss += v[i].x * v[i].x + v[i].y * v[i].y + v[i].z * v[i].z + v[i].w * v[i].w; }
#pragma unroll
    for (int off = 32; off >= 1; off >>= 1) ss += __shfl_xor(ss, off);
    const float rs = rsqrtf(ss * (1.f / DM) + 1e-6f);
#pragma unroll
    for (int i = 0; i < 4; ++i) {
      float4 gg = ((const float4*)g)[lane + 64 * i];
      xr[lane + 64 * i] = make_float4(v[i].x * rs * gg.x, v[i].y * rs * gg.y, v[i].z * rs * gg.z, v[i].w * rs * gg.w);
    }
  }
}

__device__ __forceinline__ void phase_prep(const Params& p, u16* sm) {
  const int tid = threadIdx.x & 255, sub = threadIdx.x >> 8;
  sm += sub * 2 * 64 * LDSP;
  const int n_tr = (768 + 256 + 512 + 256 + 1408 * 2 + 704 * 2 + 64 * 2 + 2 * 2) / 2;
  const int n_rope = NTOK * 32 / 256;
  const int n_bias = 64;
  const int n_norm = NTOK / 8;
  const int total = n_tr + n_rope + n_bias + n_norm;
  for (int i = blockIdx.x * NTHR + threadIdx.x; i < 4 * NTOK; i += gridDim.x * NTHR) p.rowss[i] = 0ull;
  for (int it = 2 * blockIdx.x + sub; it < total; it += 2 * gridDim.x) {
    if (it < n_tr) {
      const int tl = it * 2;
      constexpr int T1 = 768, T2 = T1 + 256, T3 = T2 + 512, T4 = T3 + 256, T5 = T4 + 1408, T6 = T5 + 1408,
                    T7 = T6 + 704, T8 = T7 + 704, T9 = T8 + 64, T10 = T9 + 64, T11 = T10 + 2;
      if (tl < T1) { transpose_tile2(p.sba_w_in, p.wt_sba_in, 1024, 3072, 3072, tl - (0), sm); }
      else if (tl < T2) { transpose_tile2(p.sba_w_out, p.wt_sba_out, 1024, 1024, 1024, tl - (T1), sm); }
      else if (tl < T3) {
        const int nt0 = (tl - T2) & 31, nt1 = nt0 + 1;
        const bool rp0 = (nt0 < 16) || (nt0 == 20) || (nt0 == 21) || (nt0 == 24) || (nt0 == 25);
        const bool rp1 = (nt1 < 16) || (nt1 == 20) || (nt1 == 21) || (nt1 == 24) || (nt1 == 25);
        transpose_tile2(p.nsa_w_in, p.wt_nsa_in, 1024, 1840, NSAWP, tl - (T2), sm, rp0, rp1, false, p.norm_mix + DM);
      }
      else if (tl < T4) { transpose_tile2(p.nsa_w_out, p.wt_nsa_out, 1024, 1024, 1024, tl - (T3), sm); }
      else if (tl < T5) { transpose_tile2(p.w_up, p.wt_up0, 1024, NUP, NUP, tl - (T4), sm, false, false, true, p.norm_ffn); }
      else if (tl < T6) { transpose_tile2(p.w_up + (size_t)1024 * NUP, p.wt_up1, 1024, NUP, NUP, tl - (T5), sm, false, false, true, p.norm_ffn + DM); }
      else if (tl < T7) { transpose_tile2(p.w_down, p.wt_down0, DFF, 1024, 1024, tl - (T6), sm); }
      else if (tl < T8) { transpose_tile2(p.w_down + (size_t)DFF * 1024, p.wt_down1, DFF, 1024, 1024, tl - (T7), sm); }
      else if (tl < T9) { transpose_tile2(p.ck_w1, p.wt_ck1, 2048, 128, 128, tl - (T8), sm); }
      else if (tl < T10) { transpose_tile2(p.cv_w1, p.wt_cv1, 2048, 128, 128, tl - (T9), sm); }
      else if (tl < T11) { transpose_tile2(p.ck_w2, p.wt_ck2, 128, 64, 64, tl - (T10), sm); }
      else { transpose_tile2(p.cv_w2, p.wt_cv2, 128, 64, 64, tl - (T11), sm); }
    } else if (it < n_tr + n_rope) {
      int idx = (it - n_tr) * 256 + tid;
      int tok = idx >> 5, f = idx & 31;
      float inv = powf(10000.f, -(float)f / 32.f);
      float ang = (float)p.pos[tok] * inv;
      p.rope[idx] = make_float2(cosf(ang), sinf(ang));
    } else if (it < n_tr + n_rope + n_bias) {
      const int bi = it - n_tr - n_rope, which = bi >> 5, ch = bi & 31;
      const float* pe = which ? p.pe_v : p.pe_k;
      const float* w1 = which ? p.cv_w1 : p.ck_w1;
      const int n = tid & 127, hf = tid >> 7;
      const int kk0 = ch * 64 + hf * 32;
      float s0 = 0.f;
#pragma unroll 8
      for (int kk = 0; kk < 32; ++kk) s0 += pe[kk0 + kk] * w1[(size_t)(kk0 + kk) * 128 + n];
      float* red = (float*)sm;
      if (hf) red[n] = s0;
      __syncthreads();
      if (!hf) p.bpart[(which * 32 + ch) * 128 + n] = s0 + red[n];
      __syncthreads();
    } else {
      const int r = (it - n_tr - n_rope - n_bias) * 8 + (tid >> 6) * 2;
      rmsnorm_2rows_bf16(p.x, p.norm_mix, p.hn, r, tid & 63);
    }
  }
}

constexpr int PG_BM = 256, PG_BK = 64, PG_HALF = 128, PG_HTB = PG_HALF * PG_BK * 2, PG_NXCD = 8, PG_WGM = 8;
__device__ __forceinline__ int pg_lds_byte(int r, int c) { const int st = (r >> 4) * 2 + (c >> 5), rr = r & 15, cc = c & 31, ob = rr * 64 + cc * 2; return st * 1024 + (ob ^ (((ob >> 9) & 1) << 5)); }
__device__ __forceinline__ void pg_stage_rc(int b, int& R, int& C) { const int st = b / 1024, sb = b % 1024, swz = sb ^ (((sb >> 9) & 1) << 5); R = (st >> 1) * 16 + swz / 64; C = (st & 1) * 32 + (swz % 64) / 2; }
struct Unit { int pm, pn; };
struct Gemm { const u16* A; const u16* Bt; int M, N, K; };
struct StaticOrder {
  int nM, nN, nwg, G, c;
  __device__ void init(int M, int N, int G_, int c_) { nM = M / PG_BM; nN = N / PG_BM; nwg = nM * nN; G = G_; c = c_; }
  __device__ bool next(int i, Unit& u) const {
    const long L = (long)i * G + c; if (L >= nwg) return false;
    int wgid = (int)L; { const int q = nwg / PG_NXCD, r = nwg % PG_NXCD, xcd = wgid % PG_NXCD, off = wgid / PG_NXCD; wgid = (xcd < r ? xcd * (q + 1) : r * (q + 1) + (xcd - r) * q) + off; }
    const int nig = PG_WGM * nN, gid = wgid / nig, fm = gid * PG_WGM, gsz = (nM - fm) < PG_WGM ? (nM - fm) : PG_WGM;
    u.pm = fm + ((wgid % nig) % gsz); u.pn = (wgid % nig) / gsz; return true;
  }
};

template <class Epi>
__device__ __forceinline__ void gemm_phase(LAS unsigned char* lds, const Gemm g, const StaticOrder& S, const Epi& E) {
  const int tid = threadIdx.x, wid = __builtin_amdgcn_readfirstlane(tid >> 6), lane = tid & 63, wr = wid >> 2, wc = wid & 3, fr = lane & 15, fq = lane >> 4;
  const int K = g.K, nt = K / PG_BK;
  unsigned voffA[2];
#pragma unroll
  for (int i = 0; i < 2; ++i) { int R, C; pg_stage_rc(tid * 16 + i * 8192, R, C); voffA[i] = (unsigned)(R * K + C) * 2u; }
  const size_t kstep = (size_t)(PG_BK * 2);
  const size_t hstep = (size_t)PG_HALF * K * 2;
  const size_t tstep = 2 * hstep;
  const unsigned ldsw = (unsigned)wid * 1024u;
  const int aoff = pg_lds_byte(wr * 64 + fr, fq * 8), boff = pg_lds_byte(wc * 32 + fr, fq * 8);
  const unsigned lbase = (unsigned)(__UINTPTR_TYPE__)lds;
  const unsigned aaddr = lbase + (unsigned)aoff, baddr = lbase + 4u * PG_HTB + (unsigned)boff;
#define PG8_SA(b, h) (((b) * 2 + (h)) * PG_HTB)
#define PG8_SB(b, h) ((4 + (b) * 2 + (h)) * PG_HTB)
#define PG8_STAGE(bufoff, gbase, voff) do { _Pragma("unroll") for (int _i = 0; _i < 2; ++_i) \
    __builtin_amdgcn_global_load_lds((const unsigned*)((const char*)(gbase) + (voff)[_i]), (LAS unsigned*)(lds + (bufoff) + ldsw + _i * 8192), 16, 0, 0); } while (0)
#define PG8_DSR(dst, addr, imm) asm volatile("ds_read_b128 %0, %1 offset:%2" : "=v"(dst) : "v"(addr), "n"(imm) : "memory")
#define PG8_LDA(dst, b, h) do { \
    PG8_DSR(dst[0][0], aaddr, ((b) * 2 + (h)) * PG_HTB + 0 * 2048 + 0);    PG8_DSR(dst[0][1], aaddr, ((b) * 2 + (h)) * PG_HTB + 0 * 2048 + 1024); \
    PG8_DSR(dst[1][0], aaddr, ((b) * 2 + (h)) * PG_HTB + 1 * 2048 + 0);    PG8_DSR(dst[1][1], aaddr, ((b) * 2 + (h)) * PG_HTB + 1 * 2048 + 1024); \
    PG8_DSR(dst[2][0], aaddr, ((b) * 2 + (h)) * PG_HTB + 2 * 2048 + 0);    PG8_DSR(dst[2][1], aaddr, ((b) * 2 + (h)) * PG_HTB + 2 * 2048 + 1024); \
    PG8_DSR(dst[3][0], aaddr, ((b) * 2 + (h)) * PG_HTB + 3 * 2048 + 0);    PG8_DSR(dst[3][1], aaddr, ((b) * 2 + (h)) * PG_HTB + 3 * 2048 + 1024); } while (0)
#define PG8_LDB(dst, b, h) do { \
    PG8_DSR(dst[0][0], baddr, ((b) * 2 + (h)) * PG_HTB + 0 * 2048 + 0);    PG8_DSR(dst[0][1], baddr, ((b) * 2 + (h)) * PG_HTB + 0 * 2048 + 1024); \
    PG8_DSR(dst[1][0], baddr, ((b) * 2 + (h)) * PG_HTB + 1 * 2048 + 0);    PG8_DSR(dst[1][1], baddr, ((b) * 2 + (h)) * PG_HTB + 1 * 2048 + 1024); } while (0)
#define PG8_MMA(ai, bj, At, Bt) do { __builtin_amdgcn_s_setprio(1); _Pragma("unroll") for (int m = 0; m < 4; ++m) _Pragma("unroll") for (int n = 0; n < 2; ++n) _Pragma("unroll") for (int k = 0; k < 2; ++k) \
    acc[ai][bj][m][n] = __builtin_amdgcn_mfma_f32_16x16x32_bf16(Bt[n][k], At[m][k], acc[ai][bj][m][n], 0, 0, 0); __builtin_amdgcn_s_setprio(0); } while (0)
#define PG8_WAIT_V(n) asm volatile("s_waitcnt vmcnt(" #n ")" ::: "memory")
#define PG8_WAIT_L(n) asm volatile("s_waitcnt lgkmcnt(" #n ")" ::: "memory")
#define PG8_WAIT_L0 asm volatile("s_waitcnt lgkmcnt(0)" \
    : "+v"(At[0][0]), "+v"(At[0][1]), "+v"(At[1][0]), "+v"(At[1][1]), "+v"(At[2][0]), "+v"(At[2][1]), "+v"(At[3][0]), "+v"(At[3][1]), \
      "+v"(B0[0][0]), "+v"(B0[0][1]), "+v"(B0[1][0]), "+v"(B0[1][1]), "+v"(B1[0][0]), "+v"(B1[0][1]), "+v"(B1[1][0]), "+v"(B1[1][1]) :: "memory")
#define PG8_BAR __builtin_amdgcn_s_barrier()
#define PG8_SCHED __builtin_amdgcn_sched_barrier(0)
  Unit cur, nxt; int ui = 0;
  if (!S.next(0, cur)) return;
  f32x4 acc[2][2][4][2];
#pragma unroll
  for (int a = 0; a < 2; ++a)
#pragma unroll
    for (int b = 0; b < 2; ++b)
#pragma unroll
      for (int m = 0; m < 4; ++m)
#pragma unroll
        for (int n = 0; n < 2; ++n) acc[a][b][m][n] = (f32x4){0.f, 0.f, 0.f, 0.f};
  bf16x8 At[4][2] = {}, B0[2][2] = {}, B1[2][2] = {};
  const char* cA = (const char*)g.A + (size_t)cur.pm * tstep; const char* cB = (const char*)g.Bt + (size_t)cur.pn * tstep;
  PG8_STAGE(PG8_SB(0, 0), cB, voffA); PG8_STAGE(PG8_SA(0, 0), cA, voffA); PG8_STAGE(PG8_SB(0, 1), cB + hstep, voffA); PG8_STAGE(PG8_SA(0, 1), cA + hstep, voffA);
  if (wr == 1) PG8_BAR;
  PG8_WAIT_V(4); PG8_BAR;
  PG8_STAGE(PG8_SB(1, 0), cB + kstep, voffA); PG8_STAGE(PG8_SA(1, 0), cA + kstep, voffA); PG8_STAGE(PG8_SB(1, 1), cB + hstep + kstep, voffA);
  PG8_WAIT_V(6); PG8_BAR;
  for (;;) {
    const bool has_next = S.next(ui + 1, nxt);
    const char* nA = has_next ? (const char*)g.A + (size_t)nxt.pm * tstep : cA; const char* nB = has_next ? (const char*)g.Bt + (size_t)nxt.pn * tstep : cB;
    for (int t = 0; t < nt; t += 2) {
      const bool last = (t == nt - 2);
      const char* a1 = cA + (size_t)(t + 1) * kstep;
      const char* a2 = last ? nA : cA + (size_t)(t + 2) * kstep; const char* b2 = last ? nB : cB + (size_t)(t + 2) * kstep;
      const char* a3 = a2 + kstep; const char* b3 = b2 + kstep;
      PG8_LDB(B0, 0, 0); PG8_SCHED; PG8_LDA(At, 0, 0); PG8_STAGE(PG8_SA(1, 1), a1 + hstep, voffA);
      PG8_WAIT_L(8); PG8_BAR; PG8_WAIT_L0; PG8_MMA(0, 0, At, B0); PG8_BAR; PG8_SCHED;
      PG8_LDB(B1, 0, 1); PG8_STAGE(PG8_SB(0, 0), b2, voffA);
      PG8_BAR; PG8_WAIT_L0; PG8_MMA(0, 1, At, B1); PG8_BAR;
      PG8_LDA(At, 0, 1); PG8_STAGE(PG8_SA(0, 0), a2, voffA);
      PG8_BAR; PG8_WAIT_L0; PG8_MMA(1, 0, At, B0); PG8_BAR; PG8_SCHED;
      PG8_STAGE(PG8_SB(0, 1), b2 + hstep, voffA);
      PG8_WAIT_V(6); PG8_BAR; PG8_MMA(1, 1, At, B1); PG8_BAR;
      PG8_LDB(B0, 1, 0); PG8_SCHED; PG8_LDA(At, 1, 0); PG8_STAGE(PG8_SA(0, 1), a2 + hstep, voffA);
      PG8_WAIT_L(8); PG8_BAR; PG8_WAIT_L0; PG8_MMA(0, 0, At, B0); PG8_BAR; PG8_SCHED;
      PG8_LDB(B1, 1, 1); PG8_STAGE(PG8_SB(1, 0), b3, voffA);
      PG8_BAR; PG8_WAIT_L0; PG8_MMA(0, 1, At, B1); PG8_BAR;
      PG8_LDA(At, 1, 1); PG8_STAGE(PG8_SA(1, 0), a3, voffA);
      PG8_BAR; PG8_WAIT_L0; PG8_MMA(1, 0, At, B0); PG8_BAR; PG8_SCHED;
      PG8_STAGE(PG8_SB(1, 1), b3 + hstep, voffA);
      PG8_WAIT_V(6); PG8_BAR; PG8_MMA(1, 1, At, B1); PG8_BAR;
    }
    E(acc, cur, wr, wc, fr, fq);
    if (!has_next) break;
#pragma unroll
    for (int a = 0; a < 2; ++a)
#pragma unroll
      for (int b = 0; b < 2; ++b)
#pragma unroll
        for (int m = 0; m < 4; ++m)
#pragma unroll
          for (int n = 0; n < 2; ++n) acc[a][b][m][n] = (f32x4){0.f, 0.f, 0.f, 0.f};
    cur = nxt; cA = nA; cB = nB; ++ui;
  }
  PG8_WAIT_V(0);
  if (wr == 0) PG8_BAR;
  PG8_BAR;
#undef PG8_SA
#undef PG8_SB
#undef PG8_STAGE
#undef PG8_LDA
#undef PG8_DSR
#undef PG8_WAIT_L0
#undef PG8_LDB
#undef PG8_MMA
#undef PG8_WAIT_V
#undef PG8_WAIT_L
#undef PG8_BAR
#undef PG8_SCHED
}

typedef f32x4 AccT[2][2][4][2];
#define EPI_ROW(u, ai, m) ((u).pm * 256 + (ai) * 128 + wr * 64 + (m) * 16 + fr)
#define EPI_COL(u, bj, n) ((u).pn * 256 + (bj) * 128 + wc * 32 + (n) * 16 + fq * 4)

struct EpiSbaQkv {
  u16 *qb, *kb, *vT;
  __device__ __forceinline__ void operator()(const AccT& acc, const Unit& u, int wr, int wc, int fr, int fq) const {
    if (u.pn < 8) {
      u16* dst = (u.pn < 4) ? qb : kb;
#pragma unroll
      for (int ai = 0; ai < 2; ++ai)
#pragma unroll
        for (int m = 0; m < 4; ++m) {
          u16* rowp = dst + (size_t)EPI_ROW(u, ai, m) * DM;
#pragma unroll
          for (int bj = 0; bj < 2; ++bj)
#pragma unroll
            for (int n = 0; n < 2; ++n) *(uint2*)(rowp + (EPI_COL(u, bj, n) & 1023)) = pack4(acc[ai][bj][m][n]);
        }
    } else {
#pragma unroll
      for (int ai = 0; ai < 2; ++ai)
#pragma unroll
        for (int m = 0; m < 4; ++m) {
          const int tok = EPI_ROW(u, ai, m), b = tok >> 12, t = tok & 4095;
#pragma unroll
          for (int bj = 0; bj < 2; ++bj)
#pragma unroll
            for (int n = 0; n < 2; ++n) {
              const int c = EPI_COL(u, bj, n) - 2048, h = c >> 6, d = c & 63;
#pragma unroll
              for (int r = 0; r < 4; ++r) vT[((size_t)(b * 16 + h) * 64 + d + r) * SEQ + t] = f2bf(acc[ai][bj][m][n][r]);
            }
        }
    }
  }
};
constexpr float SS_FIX = 16777216.f;
template <bool RF32>
struct EpiResidB {
  const float* resid32; u16* xb; unsigned long long* rowss;
  __device__ __forceinline__ void operator()(const AccT& acc, const Unit& u, int wr, int wc, int fr, int fq) const {
#pragma unroll
    for (int ai = 0; ai < 2; ++ai) {
      f32x4 rv[4][2][2];
#pragma unroll
      for (int m = 0; m < 4; ++m) {
        const size_t ro = (size_t)EPI_ROW(u, ai, m) * DM;
#pragma unroll
        for (int bj = 0; bj < 2; ++bj)
#pragma unroll
          for (int n = 0; n < 2; ++n) {
            if (RF32) rv[m][bj][n] = *(const f32x4*)(resid32 + ro + EPI_COL(u, bj, n));
            else {
              const uint2 pk = *(const uint2*)(xb + ro + EPI_COL(u, bj, n));
              rv[m][bj][n] = (f32x4){__uint_as_float(pk.x << 16), __uint_as_float(pk.x & 0xffff0000u), __uint_as_float(pk.y << 16), __uint_as_float(pk.y & 0xffff0000u)};
            }
          }
      }
#pragma unroll
      for (int m = 0; m < 4; ++m) {
        const int row = EPI_ROW(u, ai, m);
        const size_t ro = (size_t)row * DM;
        float ss = 0.f;
#pragma unroll
        for (int bj = 0; bj < 2; ++bj)
#pragma unroll
          for (int n = 0; n < 2; ++n) {
            const f32x4 x = rv[m][bj][n] + acc[ai][bj][m][n];
            ss += x[0] * x[0] + x[1] * x[1] + x[2] * x[2] + x[3] * x[3];
            *(uint2*)(xb + ro + EPI_COL(u, bj, n)) = pack4(x);
          }
        ss += __shfl_xor(ss, 16);
        ss += __shfl_xor(ss, 32);
        if (fq == 0) atomicAdd(rowss + row, (unsigned long long)(ss * SS_FIX + 0.5f));
      }
    }
  }
};
struct EpiResidLast {
  const u16* xb; float* out;
  __device__ __forceinline__ void operator()(const AccT& acc, const Unit& u, int wr, int wc, int fr, int fq) const {
#pragma unroll
    for (int ai = 0; ai < 2; ++ai) {
      uint2 rv[4][2][2];
#pragma unroll
      for (int m = 0; m < 4; ++m) {
        const size_t ro = (size_t)EPI_ROW(u, ai, m) * DM;
#pragma unroll
        for (int bj = 0; bj < 2; ++bj)
#pragma unroll
          for (int n = 0; n < 2; ++n) rv[m][bj][n] = *(const uint2*)(xb + ro + EPI_COL(u, bj, n));
      }
#pragma unroll
      for (int m = 0; m < 4; ++m) {
        const size_t ro = (size_t)EPI_ROW(u, ai, m) * DM;
#pragma unroll
        for (int bj = 0; bj < 2; ++bj)
#pragma unroll
          for (int n = 0; n < 2; ++n) {
            const uint2 pk = rv[m][bj][n];
            const f32x4 a = acc[ai][bj][m][n];
            *(float4*)(out + ro + EPI_COL(u, bj, n)) = make_float4(__uint_as_float(pk.x << 16) + a[0], __uint_as_float(pk.x & 0xffff0000u) + a[1],
                                                                   __uint_as_float(pk.y << 16) + a[2], __uint_as_float(pk.y & 0xffff0000u) + a[3]);
          }
      }
    }
  }
};
__device__ __forceinline__ float rstd_of(const unsigned long long* rowss, int row) {
  return rsqrtf((float)rowss[row] * (1.f / (SS_FIX * DM)) + 1e-6f);
}
__device__ __forceinline__ float dpp_ror1(float v) { return __int_as_float(__builtin_amdgcn_update_dpp(0, __float_as_int(v), 0x121, 0xf, 0xf, false)); }
__device__ __forceinline__ float dpp_ror2(float v) { return __int_as_float(__builtin_amdgcn_update_dpp(0, __float_as_int(v), 0x122, 0xf, 0xf, false)); }
struct EpiUpConv {
  u16* act; float* ub; const unsigned long long* rowss; const float* cw; const float* cb;
  __device__ __forceinline__ void operator()(const AccT& acc, const Unit& u, int wr, int wc, int fr, int fq) const {
#pragma unroll
    for (int ai = 0; ai < 2; ++ai) {
      float rs[4];
#pragma unroll
      for (int m = 0; m < 4; ++m) rs[m] = rstd_of(rowss, EPI_ROW(u, ai, m));
      const int chunk = 4 * u.pm + 2 * ai + wr;
#pragma unroll
      for (int n = 0; n < 2; ++n) {
        const int f0 = 128 * u.pn + 32 * wc + 16 * n + 4 * fq;
        const int gc = u.pn * 256 + 32 * wc + 16 * n + 4 * fq;
        const f32x4 wg0 = *(const f32x4*)(cw + f0), wg1 = *(const f32x4*)(cw + NUP + f0), wg2 = *(const f32x4*)(cw + 2 * NUP + f0);
        const f32x4 wv0 = *(const f32x4*)(cw + DFF + f0), wv1 = *(const f32x4*)(cw + NUP + DFF + f0), wv2 = *(const f32x4*)(cw + 2 * NUP + DFF + f0);
        const f32x4 bg = *(const f32x4*)(cb + f0), bv = *(const f32x4*)(cb + DFF + f0);
        f32x4 xg[4], xv[4];
#pragma unroll
        for (int m = 0; m < 4; ++m) { xg[m] = acc[ai][0][m][n] * rs[m]; xv[m] = acc[ai][1][m][n] * rs[m]; }
        if (fr < 2) {
          float* d = ub + ((size_t)(chunk * 4 + fr) * NUP + gc);
          *(float4*)d = make_float4(xg[0][0], xg[0][1], xg[0][2], xg[0][3]);
          *(float4*)(d + 128) = make_float4(xv[0][0], xv[0][1], xv[0][2], xv[0][3]);
        }
        if (fr >= 14) {
          float* d = ub + ((size_t)(chunk * 4 + 2 + (fr - 14)) * NUP + gc);
          *(float4*)d = make_float4(xg[3][0], xg[3][1], xg[3][2], xg[3][3]);
          *(float4*)(d + 128) = make_float4(xv[3][0], xv[3][1], xv[3][2], xv[3][3]);
        }
#pragma unroll
        for (int m = 0; m < 4; ++m) {
          f32x4 res;
#pragma unroll
          for (int r = 0; r < 4; ++r) {
            const float g_cur = xg[m][r], v_cur = xv[m][r];
            const f32x4 xgp = xg[m > 0 ? m - 1 : 0], xvp = xv[m > 0 ? m - 1 : 0];
            const float g_pm = (m > 0) ? xgp[r] : 0.f, v_pm = (m > 0) ? xvp[r] : 0.f;
            const float g1 = dpp_ror1((fr == 15) ? g_pm : g_cur), g2 = dpp_ror2((fr >= 14) ? g_pm : g_cur);
            const float v1 = dpp_ror1((fr == 15) ? v_pm : v_cur), v2 = dpp_ror2((fr >= 14) ? v_pm : v_cur);
            const float cg_ = bg[r] + g2 * wg0[r] + g1 * wg1[r] + g_cur * wg2[r];
            const float cv_ = bv[r] + v2 * wv0[r] + v1 * wv1[r] + v_cur * wv2[r];
            res[r] = cg_ * __builtin_amdgcn_rcpf(1.f + __builtin_amdgcn_exp2f(-1.4426950408889634f * cg_)) * cv_;
          }
          if (m > 0 || fr >= 2)
            *(uint2*)(act + (size_t)EPI_ROW(u, ai, m) * DFF + f0) = pack4(res);
        }
      }
    }
  }
};

struct EpiNsaIn {
  u16 *qn, *cbuf, *ksb, *kwb, *vsT, *vwT; float* gbuf; const float2* rope; const unsigned long long* rowss;
  __device__ __forceinline__ void rope_store(const f32x4& x1, const f32x4& x2, int tok, int d1, u16* dst) const {
    const float4 cs01 = *(const float4*)(rope + (size_t)tok * 32 + d1);
    const float4 cs23 = *(const float4*)(rope + (size_t)tok * 32 + d1 + 2);
    const float cc[4] = {cs01.x, cs01.z, cs23.x, cs23.z};
    const float ss[4] = {cs01.y, cs01.w, cs23.y, cs23.w};
    f32x4 o1, o2;
#pragma unroll
    for (int r = 0; r < 4; ++r) { o1[r] = x1[r] * cc[r] - x2[r] * ss[r]; o2[r] = x2[r] * cc[r] + x1[r] * ss[r]; }
    *(uint2*)(dst + d1) = pack4(o1);
    *(uint2*)(dst + d1 + 32) = pack4(o2);
  }
  __device__ __forceinline__ void operator()(const AccT& acc_in, const Unit& u, int wr, int wc, int fr, int fq) const {
    const int d1 = 16 * (wc & 1) + 4 * fq;
#pragma unroll
    for (int ai = 0; ai < 2; ++ai)
#pragma unroll
      for (int m = 0; m < 4; ++m) {
        const int tok = EPI_ROW(u, ai, m);
        const float rs = rstd_of(rowss, tok);
        f32x4 acc[2][2][2];
#pragma unroll
        for (int bj = 0; bj < 2; ++bj)
#pragma unroll
          for (int n = 0; n < 2; ++n) acc[0][bj][n] = acc_in[ai][bj][m][n] * rs;
        if (u.pn < 4) {
#pragma unroll
          for (int bj = 0; bj < 2; ++bj) {
            const int head = 4 * u.pn + 2 * bj + (wc >> 1);
            rope_store(acc[0][bj][0], acc[0][bj][1], tok, d1, qn + (size_t)tok * DM + head * 64);
          }
        } else if (u.pn == 4) {
#pragma unroll
          for (int bj = 0; bj < 2; ++bj)
#pragma unroll
            for (int n = 0; n < 2; ++n) *(uint2*)(cbuf + (size_t)tok * 256 + (EPI_COL(u, bj, n) - 1024)) = pack4(acc[0][bj][n]);
        } else if (u.pn < 7) {
          u16* kdst = (u.pn == 5) ? ksb : kwb;
          u16* vdst = (u.pn == 5) ? vsT : vwT;
          const int gk = wc >> 1;
          rope_store(acc[0][0][0], acc[0][0][1], tok, d1, kdst + (size_t)tok * 128 + gk * 64);
          const int b = tok >> 12, t = tok & 4095;
#pragma unroll
          for (int n = 0; n < 2; ++n) {
            const int d = 32 * (wc & 1) + 16 * n + 4 * fq;
#pragma unroll
            for (int r = 0; r < 4; ++r) vdst[((size_t)(b * 2 + gk) * 64 + d + r) * SEQ + t] = f2bf(acc[0][1][n][r]);
          }
        } else {
#pragma unroll
          for (int n = 0; n < 2; ++n) {
            const int c = 32 * wc + 16 * n + 4 * fq;
            if (c < 48) {
              const f32x4 a = acc[0][0][n];
              float4 gv;
              gv.x = 1.f / (1.f + __expf(-a[0])); gv.y = 1.f / (1.f + __expf(-a[1]));
              gv.z = 1.f / (1.f + __expf(-a[2])); gv.w = 1.f / (1.f + __expf(-a[3]));
              *(float4*)(gbuf + (size_t)tok * 48 + c) = gv;
            }
          }
        }
      }
  }
};

template <class Epi>
__device__ __forceinline__ void run_gemm(u16* sm, const u16* A, const u16* Bt, int M, int N, int K, const Epi& E) {
  Gemm g; g.A = A; g.Bt = Bt; g.M = M; g.N = N; g.K = K;
  StaticOrder S; S.init(M, N, (int)gridDim.x, (int)blockIdx.x);
  gemm_phase(( LAS unsigned char*)sm, g, S, E);
}

template <class ARowF>
__device__ __forceinline__ void gemm_mainloop(f32x4 (&acc)[4][4], ARowF arow, int a_kstep, const u16* bt, int ldb, int nk, u16* sm) {
  const int tid = threadIdx.x, lane = tid & 63, wave = tid >> 6;
  const int wm = wave >> 1, wn = wave & 1;
  const int lc = tid & 7, lr = tid >> 3;
  const u16* pa[4]; const u16* pb[2];
#pragma unroll
  for (int i = 0; i < 4; ++i) pa[i] = arow(lr + 64 * i) + lc * 8;
#pragma unroll
  for (int i = 0; i < 2; ++i) pb[i] = bt + (size_t)(lr + 64 * i) * ldb + lc * 8;
  u16* sA = sm; u16* sB = sm + 2 * 256 * LDSP;
  uint4 ra[4], rb[2];
#pragma unroll
  for (int i = 0; i < 4; ++i) ra[i] = *(const uint4*)pa[i];
#pragma unroll
  for (int i = 0; i < 2; ++i) rb[i] = *(const uint4*)pb[i];
#pragma unroll
  for (int i = 0; i < 4; ++i) *(uint4*)(sA + (lr + 64 * i) * LDSP + lc * 8) = ra[i];
#pragma unroll
  for (int i = 0; i < 2; ++i) *(uint4*)(sB + (lr + 64 * i) * LDSP + lc * 8) = rb[i];
  __syncthreads();
  const int fr = lane & 15, fq = lane >> 4;
  for (int kt = 0; kt < nk; ++kt) {
    const bool more = (kt + 1 < nk);
    if (more) {
#pragma unroll
      for (int i = 0; i < 4; ++i) ra[i] = *(const uint4*)(pa[i] + (size_t)(kt + 1) * a_kstep);
#pragma unroll
      for (int i = 0; i < 2; ++i) rb[i] = *(const uint4*)(pb[i] + (size_t)(kt + 1) * 64);
    }
    const u16* cA = sA + (kt & 1) * 256 * LDSP + (wm * 64 + fr) * LDSP + fq * 8;
    const u16* cB = sB + (kt & 1) * 128 * LDSP + (wn * 64 + fr) * LDSP + fq * 8;
#pragma unroll
    for (int ks = 0; ks < 2; ++ks) {
      bf16x8 wf[4], xf[4];
#pragma unroll
      for (int i = 0; i < 4; ++i) {
        wf[i] = *(const bf16x8*)(cB + i * 16 * LDSP + ks * 32);
        xf[i] = *(const bf16x8*)(cA + i * 16 * LDSP + ks * 32);
      }
#pragma unroll
      for (int i = 0; i < 4; ++i)
#pragma unroll
        for (int j = 0; j < 4; ++j) acc[i][j] = mfma16(wf[i], xf[j], acc[i][j]);
    }
    if (more) {
      u16* dA = sA + ((kt + 1) & 1) * 256 * LDSP; u16* dB = sB + ((kt + 1) & 1) * 128 * LDSP;
#pragma unroll
      for (int i = 0; i < 4; ++i) *(uint4*)(dA + (lr + 64 * i) * LDSP + lc * 8) = ra[i];
#pragma unroll
      for (int i = 0; i < 2; ++i) *(uint4*)(dB + (lr + 64 * i) * LDSP + lc * 8) = rb[i];
    }
    __syncthreads();
  }
}

__device__ __forceinline__ void zero_acc(f32x4 (&acc)[4][4]) {
#pragma unroll
  for (int i = 0; i < 4; ++i)
#pragma unroll
    for (int j = 0; j < 4; ++j) acc[i][j] = (f32x4){0.f, 0.f, 0.f, 0.f};
}

__device__ __forceinline__ void phase_ffn_fix(const Params& p, int layer) {
  const float* cw = p.conv_w + (size_t)layer * 3 * NUP;
  const float* cb = p.conv_b + (size_t)layer * NUP;
  const int nitems = 512 * 2 * (DFF / 4);
  for (int it = blockIdx.x * NTHR + threadIdx.x; it < nitems; it += gridDim.x * NTHR) {
    const int f4 = it % (DFF / 4), cj = it / (DFF / 4), j = cj & 1, chunk = cj >> 1;
    const int f0 = f4 * 4;
    const int gc = 256 * (f0 >> 7) + (f0 & 127);
    const int t = chunk * 64 + j;
    const bool has_prev = ((chunk & 63) != 0);
    const float* cur = p.ub + (size_t)(chunk * 4) * NUP + gc;
    const float* prv = p.ub + (size_t)((has_prev ? chunk - 1 : chunk) * 4) * NUP + gc;
    const float pmask = has_prev ? 1.f : 0.f;
    const float* r1p = (j == 0) ? prv + (size_t)3 * NUP : cur;
    const float* r2p = (j == 0) ? prv + (size_t)2 * NUP : prv + (size_t)3 * NUP;
    const float m1 = (j == 0) ? pmask : 1.f, m2 = pmask;
    f32x4 g0 = *(const f32x4*)(cur + (size_t)j * NUP), v0 = *(const f32x4*)(cur + (size_t)j * NUP + 128);
    f32x4 g1 = *(const f32x4*)(r1p) * m1, v1 = *(const f32x4*)(r1p + 128) * m1;
    f32x4 g2 = *(const f32x4*)(r2p) * m2, v2 = *(const f32x4*)(r2p + 128) * m2;
    const f32x4 wg0 = *(const f32x4*)(cw + f0), wg1 = *(const f32x4*)(cw + NUP + f0), wg2 = *(const f32x4*)(cw + 2 * NUP + f0);
    const f32x4 wv0 = *(const f32x4*)(cw + DFF + f0), wv1 = *(const f32x4*)(cw + NUP + DFF + f0), wv2 = *(const f32x4*)(cw + 2 * NUP + DFF + f0);
    const f32x4 bg = *(const f32x4*)(cb + f0), bv = *(const f32x4*)(cb + DFF + f0);
    const f32x4 cg_ = bg + g2 * wg0 + g1 * wg1 + g0 * wg2;
    const f32x4 cv_ = bv + v2 * wv0 + v1 * wv1 + v0 * wv2;
    const float r0 = cg_[0] / (1.f + __expf(-cg_[0])) * cv_[0], r1 = cg_[1] / (1.f + __expf(-cg_[1])) * cv_[1];
    const float r2 = cg_[2] / (1.f + __expf(-cg_[2])) * cv_[2], r3 = cg_[3] / (1.f + __expf(-cg_[3])) * cv_[3];
    *(uint2*)(p.act + (size_t)t * DFF + f0) = make_uint2(pack2(r0, r1), pack2(r2, r3));
  }
}

__device__ __forceinline__ void phase_compress(const Params& p, u16* sm) {
  const int tid = threadIdx.x, lane = tid & 63, wave = tid >> 6, wm = wave >> 1, wn = wave & 1, fr = lane & 15, fq = lane >> 4;
  for (int tile = blockIdx.x; tile < 32; tile += gridDim.x) {
    const int which = tile & 1, mt = tile >> 1;
    const int m0 = mt * 256;
    const u16* w1t = which ? p.wt_cv1 : p.wt_ck1;
    const u16* w2t = which ? p.wt_cv2 : p.wt_ck2;
    const float* bias = p.bpart + which * 32 * 128;
    f32x4 acc[4][4]; zero_acc(acc);
    const u16* cb = p.cbuf + which * 128;
    gemm_mainloop(acc, [&](int r) {
      int row = m0 + r; int g = row & 1; int bc = row >> 1; int c = bc & 255; int b = bc >> 8;
      if (c > 254) c = 254;
      return cb + ((size_t)b * SEQ + c * 16) * 256 + g * 64;
    }, 256, w1t, 2048, 32, sm);
    u16* sH = sm; u16* sW = sm + 256 * 136;
#pragma unroll
    for (int i = 0; i < 4; ++i) {
      const int n = wn * 64 + i * 16 + fq * 4;
      float bb[4] = {0.f, 0.f, 0.f, 0.f};
#pragma unroll
      for (int c8 = 0; c8 < 32; ++c8) {
        const float4 bv = *(const float4*)(bias + c8 * 128 + n);
        bb[0] += bv.x; bb[1] += bv.y; bb[2] += bv.z; bb[3] += bv.w;
      }
#pragma unroll
      for (int j = 0; j < 4; ++j) {
        const int rl = wm * 64 + j * 16 + fr;
        f32x4 hv;
#pragma unroll
        for (int r = 0; r < 4; ++r) {
          float xv = acc[i][j][r] + bb[r];
          float inner = 0.7978845608028654f * (xv + 0.044715f * xv * xv * xv);
          hv[r] = 0.5f * xv * (1.f + tanhf(inner));
        }
        *(uint2*)(sH + rl * 136 + n) = pack4(hv);
      }
    }
    {
#pragma unroll
      for (int i = 0; i < 2; ++i) {
        int idx = tid + 512 * i; int r = idx >> 4, c = idx & 15;
        *(uint4*)(sW + r * 136 + c * 8) = *(const uint4*)(w2t + r * 128 + c * 8);
      }
    }
    __syncthreads();
    f32x4 o2[4][2];
#pragma unroll
    for (int dm = 0; dm < 4; ++dm) { o2[dm][0] = (f32x4){0.f, 0.f, 0.f, 0.f}; o2[dm][1] = (f32x4){0.f, 0.f, 0.f, 0.f}; }
#pragma unroll
    for (int ks = 0; ks < 4; ++ks) {
      bf16x8 hf[2];
#pragma unroll
      for (int j = 0; j < 2; ++j) hf[j] = *(const bf16x8*)(sH + (wave * 32 + j * 16 + fr) * 136 + ks * 32 + fq * 8);
#pragma unroll
      for (int dm = 0; dm < 4; ++dm) {
        bf16x8 wf = *(const bf16x8*)(sW + (dm * 16 + fr) * 136 + ks * 32 + fq * 8);
#pragma unroll
        for (int j = 0; j < 2; ++j) o2[dm][j] = mfma16(wf, hf[j], o2[dm][j]);
      }
    }
#pragma unroll
    for (int j = 0; j < 2; ++j) {
      const int row = m0 + wave * 32 + j * 16 + fr;
      const int g = row & 1, bc = row >> 1, c = bc & 255, b = bc >> 8;
      const bool valid = (c < 255);
      if (which == 0) {
        const int tok = b * SEQ + (valid ? c : 254) * 16 + 31;
        u16* dst = p.kc + ((size_t)(b * 2 + g) * 256 + c) * 64;
#pragma unroll
        for (int i = 0; i < 2; ++i) {
          const int d = i * 16 + fq * 4;
          const float4 cs01 = *(const float4*)(p.rope + (size_t)tok * 32 + d);
          const float4 cs23 = *(const float4*)(p.rope + (size_t)tok * 32 + d + 2);
          const float cc[4] = {cs01.x, cs01.z, cs23.x, cs23.z};
          const float ss[4] = {cs01.y, cs01.w, cs23.y, cs23.w};
          f32x4 o1, o2v;
#pragma unroll
          for (int r = 0; r < 4; ++r) {
            float x1 = o2[i][j][r], x2 = o2[i + 2][j][r];
            o1[r] = valid ? x1 * cc[r] - x2 * ss[r] : 0.f;
            o2v[r] = valid ? x2 * cc[r] + x1 * ss[r] : 0.f;
          }
          *(uint2*)(dst + d) = pack4(o1);
          *(uint2*)(dst + d + 32) = pack4(o2v);
        }
      } else {
#pragma unroll
        for (int dm = 0; dm < 4; ++dm)
#pragma unroll
          for (int r = 0; r < 4; ++r) {
            const int d = dm * 16 + fq * 4 + r;
            p.vcT[((size_t)(b * 2 + g) * 64 + d) * 256 + c] = valid ? f2bf(o2[dm][j][r]) : (u16)0;
          }
      }
    }
    __syncthreads();
  }
}

__device__ __forceinline__ int rho_row(int k) { return (k & 32) | ((k & 4) << 2) | ((k & 24) >> 1) | (k & 3); }

__device__ __forceinline__ void load_tile64(u16* s, const u16* src, size_t ld, bool perm) {
  const int c = threadIdx.x & 7, r0 = threadIdx.x >> 3;
  uint4 v0 = *(const uint4*)(src + (size_t)r0 * ld + c * 8);
  const int l0 = perm ? rho_row(r0) : r0;
  *(uint4*)(s + l0 * LDSP + c * 8) = v0;
}

__device__ __forceinline__ void phase_sba_attn(const Params& p, u16* sm) {
  const int tid = threadIdx.x, lane = tid & 63, wave = tid >> 6, fr = lane & 15, fq = lane >> 4;
  u16* sK0 = sm; u16* sV0 = sm + 64 * LDSP;
  bf16x8 tri[2], ones;
#pragma unroll
  for (int bb = 0; bb < 2; ++bb) {
    uint32_t w[4];
#pragma unroll
    for (int i2 = 0; i2 < 4; ++i2) {
      const int s_ = 8 * (fr >> 2) + 4 * bb + (fr & 3);
      const int j0 = 8 * fq + 2 * i2, j1 = j0 + 1;
      w[i2] = (j0 > s_ ? 0x3F80u : 0u) | ((j1 > s_ ? 0x3F80u : 0u) << 16);
    }
    tri[bb] = mk_frag(w[0], w[1], w[2], w[3]);
  }
  ones = mk_frag(0x3F803F80u, 0x3F803F80u, 0x3F803F80u, 0x3F803F80u);

  const int ntiles = 128 * 32;
  for (int tile = blockIdx.x; tile < ntiles; tile += gridDim.x) {
    const int qt = 31 - (tile >> 7), bh = tile & 127;
    const int b = bh >> 4, h = bh & 15;
    const int myq = qt * 128 + wave * 16 + fr;
    bf16x8 qf[2];
#pragma unroll
    for (int ks = 0; ks < 2; ++ks) qf[ks] = *(const bf16x8*)(p.qb + ((size_t)b * SEQ + myq) * DM + h * 64 + ks * 32 + fq * 8);
    f32x4 o[4];
#pragma unroll
    for (int dm = 0; dm < 4; ++dm) o[dm] = (f32x4){0.f, 0.f, 0.f, 0.f};
    float carry = 0.f;
    const int pc = tid & 7, pr = tid >> 3, prl = rho_row(pr);
    const u16* kbase = p.kb + ((size_t)b * SEQ) * DM + h * 64 + (size_t)pr * DM + pc * 8;
    const u16* vbase = p.vT + ((size_t)(b * 16 + h) * 64 + pr) * SEQ + pc * 8;
    uint4 rk = *(const uint4*)(kbase + (size_t)(2 * qt + 1) * 64 * DM);
    uint4 rv = *(const uint4*)(vbase + (2 * qt + 1) * 64);
    int buf = 0;
    for (int kt = 2 * qt + 1; kt >= 0; --kt) {
      u16* sK = sK0 + buf * 2 * 64 * LDSP; u16* sV = sV0 + buf * 2 * 64 * LDSP;
      *(uint4*)(sK + prl * LDSP + pc * 8) = rk;
      *(uint4*)(sV + pr * LDSP + pc * 8) = rv;
      if (kt > 0) { rk = *(const uint4*)(kbase + (size_t)(kt - 1) * 64 * DM); rv = *(const uint4*)(vbase + (kt - 1) * 64); }
      buf ^= 1;
      __syncthreads();
      const bool wave_idle = (kt * 64 >= qt * 128 + wave * 16 + 15) || (__ballot(carry >= -150.1f) == 0ull);
      if (!wave_idle) {
      f32x4 s[4];
#pragma unroll
      for (int mt = 0; mt < 4; ++mt) {
        s[mt] = (f32x4){0.f, 0.f, 0.f, 0.f};
#pragma unroll
        for (int ks = 0; ks < 2; ++ks) {
          bf16x8 kf = *(const bf16x8*)(sK + (mt * 16 + fr) * LDSP + ks * 32 + fq * 8);
          s[mt] = mfma16(kf, qf[ks], s[mt]);
        }
      }
      const bool tile_masked = (kt * 64 + 63 >= qt * 128 + wave * 16);
      constexpr float SBA_C = 0.125f * 1.4426950408889634f;
      float L[4][4], lb[4][4];
      unsigned vmask = 0xffffu;
      if (tile_masked) {
        vmask = 0;
#pragma unroll
        for (int mt = 0; mt < 4; ++mt)
#pragma unroll
          for (int j = 0; j < 4; ++j) {
            const float z = s[mt][j] * SBA_C;
            const int key = kt * 64 + 32 * (mt >> 1) + 8 * fq + 4 * (mt & 1) + j;
            const bool valid = key < myq;
            const float e = __builtin_amdgcn_exp2f(-fabsf(z));
            const float sp = fmaxf(z, 0.f) + __builtin_amdgcn_logf(1.f + e);
            L[mt][j] = valid ? -sp : 0.f;
            lb[mt][j] = z - sp;
            vmask |= (valid ? 1u : 0u) << (mt * 4 + j);
          }
      } else {
#pragma unroll
        for (int mt = 0; mt < 4; ++mt)
#pragma unroll
          for (int j = 0; j < 4; ++j) {
            const float z = s[mt][j] * SBA_C;
            const float e = __builtin_amdgcn_exp2f(-fabsf(z));
            const float sp = fmaxf(z, 0.f) + __builtin_amdgcn_logf(1.f + e);
            L[mt][j] = -sp;
            lb[mt][j] = z - sp;
          }
      }
      bf16x8 Lh[2], Ll[2];
#pragma unroll
      for (int k2 = 0; k2 < 2; ++k2) {
        uint32_t hw[4], lw[4];
#pragma unroll
        for (int e2 = 0; e2 < 4; ++e2) {
          const int mt = 2 * k2 + (e2 >> 1), j = (e2 & 1) * 2;
          hw[e2] = pack2(L[mt][j], L[mt][j + 1]);
          const float r0 = L[mt][j] - __uint_as_float(hw[e2] << 16), r1 = L[mt][j + 1] - __uint_as_float(hw[e2] & 0xffff0000u);
          lw[e2] = pack2(r0, r1);
        }
        Lh[k2] = mk_frag(hw[0], hw[1], hw[2], hw[3]);
        Ll[k2] = mk_frag(lw[0], lw[1], lw[2], lw[3]);
      }
      f32x4 cum[4];
#pragma unroll
      for (int ms = 0; ms < 4; ++ms) {
        const int a = ms >> 1, bb = ms & 1;
        f32x4 c = (f32x4){0.f, 0.f, 0.f, 0.f};
        c = mfma16(tri[bb], Lh[a], c);
        c = mfma16(tri[bb], Ll[a], c);
        if (a == 0) { c = mfma16(ones, Lh[1], c); c = mfma16(ones, Ll[1], c); }
        cum[ms] = c;
      }
      float tot = cum[0][0] + L[0][0];
      tot = __shfl(tot, fr);
      bf16x8 pf[2];
#pragma unroll
      for (int k2 = 0; k2 < 2; ++k2) {
        uint32_t pw[4];
#pragma unroll
        for (int e2 = 0; e2 < 4; ++e2) {
          const int mt = 2 * k2 + (e2 >> 1), j = (e2 & 1) * 2;
          float p0 = __builtin_amdgcn_exp2f(lb[mt][j] + cum[mt][j] + carry);
          float p1 = __builtin_amdgcn_exp2f(lb[mt][j + 1] + cum[mt][j + 1] + carry);
          if (tile_masked) {
            p0 = ((vmask >> (mt * 4 + j)) & 1u) ? p0 : 0.f;
            p1 = ((vmask >> (mt * 4 + j + 1)) & 1u) ? p1 : 0.f;
          }
          pw[e2] = pack2(p0, p1);
        }
        pf[k2] = mk_frag(pw[0], pw[1], pw[2], pw[3]);
      }
#pragma unroll
      for (int k2 = 0; k2 < 2; ++k2)
#pragma unroll
        for (int dm = 0; dm < 4; ++dm) {
          bf16x8 vf = *(const bf16x8*)(sV + (dm * 16 + fr) * LDSP + k2 * 32 + fq * 8);
          o[dm] = mfma16(vf, pf[k2], o[dm]);
        }
      carry += tot;
      }
      if (__syncthreads_and(carry < -150.1f)) break;
    }
#pragma unroll
    for (int dm = 0; dm < 4; ++dm)
      *(uint2*)(p.ob + ((size_t)b * SEQ + myq) * DM + h * 64 + dm * 16 + fq * 4) = pack4(o[dm]);
  }
}

struct NsaState {
  f32x4 acc[2][4];
  f32x4 accL[2];
  float m[2], l[2];
};

__device__ __forceinline__ void nsa_qk(f32x4 (&s)[2][4], const u16* sK, const bf16x8 (&qf)[2][2], int fr, int fq) {
#pragma unroll
  for (int mt = 0; mt < 4; ++mt) {
    s[0][mt] = (f32x4){0.f, 0.f, 0.f, 0.f}; s[1][mt] = (f32x4){0.f, 0.f, 0.f, 0.f};
#pragma unroll
    for (int ks = 0; ks < 2; ++ks) {
      bf16x8 kf = *(const bf16x8*)(sK + (mt * 16 + fr) * LDSP + ks * 32 + fq * 8);
      s[0][mt] = mfma16(kf, qf[0][ks], s[0][mt]);
      s[1][mt] = mfma16(kf, qf[1][ks], s[1][mt]);
    }
  }
}

__device__ __forceinline__ void nsa_pv(f32x4 (&acc)[2][4], const u16* sV, const bf16x8 (&pf)[2][2], int fr, int fq) {
#pragma unroll
  for (int k2 = 0; k2 < 2; ++k2)
#pragma unroll
    for (int dm = 0; dm < 4; ++dm) {
      bf16x8 vf = *(const bf16x8*)(sV + (dm * 16 + fr) * LDSP + k2 * 32 + fq * 8);
      acc[0][dm] = mfma16(vf, pf[0][k2], acc[0][dm]);
      acc[1][dm] = mfma16(vf, pf[1][k2], acc[1][dm]);
    }
}

constexpr float SM_C = 0.125f * 1.4426950408889634f;
template <bool MASKED>
__device__ __forceinline__ void nsa_online_step(NsaState& st, f32x4 (&s)[2][4], unsigned vmask, bool lanevalid, const u16* sV, int fr, int fq) {
  bf16x8 pf[2][2];
  const uint32_t lmask = lanevalid ? 0xffffffffu : 0u;
  const bf16x8 ones = mk_frag(0x3F803F80u, 0x3F803F80u, 0x3F803F80u, 0x3F803F80u);
  constexpr float DEFER = 8.f / SM_C;
#pragma unroll
  for (int hh = 0; hh < 2; ++hh) {
    float tmax = -1e30f;
    if (MASKED) {
#pragma unroll
      for (int mt = 0; mt < 4; ++mt)
#pragma unroll
        for (int j = 0; j < 4; ++j) {
          const float sc = ((vmask >> (mt * 4 + j)) & 1u) ? s[hh][mt][j] : -1e30f;
          s[hh][mt][j] = sc;
          tmax = fmaxf(tmax, sc);
        }
    } else {
#pragma unroll
      for (int mt = 0; mt < 4; ++mt)
#pragma unroll
        for (int j = 0; j < 4; ++j) tmax = fmaxf(tmax, s[hh][mt][j]);
      tmax = lanevalid ? tmax : -1e30f;
    }
    tmax = fmaxf(tmax, __shfl_xor(tmax, 16));
    tmax = fmaxf(tmax, __shfl_xor(tmax, 32));
    const bool upd = tmax > st.m[hh] + DEFER;
    if (__ballot(upd) != 0ull) {
      const float mnew = upd ? tmax : st.m[hh];
      const float alpha = __builtin_amdgcn_exp2f((st.m[hh] - mnew) * SM_C);
      st.m[hh] = mnew;
#pragma unroll
      for (int dm = 0; dm < 4; ++dm) st.acc[hh][dm] *= alpha;
      st.accL[hh] *= alpha;
    }
    const float nb = -st.m[hh] * SM_C;
#pragma unroll
    for (int k2 = 0; k2 < 2; ++k2) {
      uint32_t pw[4];
#pragma unroll
      for (int e2 = 0; e2 < 4; ++e2) {
        const int mt = 2 * k2 + (e2 >> 1), j = (e2 & 1) * 2;
        float p0 = __builtin_amdgcn_exp2f(__builtin_fmaf(s[hh][mt][j], SM_C, nb));
        float p1 = __builtin_amdgcn_exp2f(__builtin_fmaf(s[hh][mt][j + 1], SM_C, nb));
        if (MASKED) {
          p0 = ((vmask >> (mt * 4 + j)) & 1u) ? p0 : 0.f;
          p1 = ((vmask >> (mt * 4 + j + 1)) & 1u) ? p1 : 0.f;
        }
        pw[e2] = pack2(p0, p1);
        if (!MASKED) pw[e2] &= lmask;
      }
      pf[hh][k2] = mk_frag(pw[0], pw[1], pw[2], pw[3]);
      st.accL[hh] = mfma16(ones, pf[hh][k2], st.accL[hh]);
    }
#pragma unroll
    for (int k2 = 0; k2 < 2; ++k2)
#pragma unroll
      for (int dm = 0; dm < 4; ++dm) {
        const bf16x8 vf = *(const bf16x8*)(sV + (dm * 16 + fr) * LDSP + k2 * 32 + fq * 8);
        st.acc[hh][dm] = mfma16(vf, pf[hh][k2], st.acc[hh][dm]);
      }
  }
}

__device__ __forceinline__ void nsa_reset(NsaState& st) {
#pragma unroll
  for (int hh = 0; hh < 2; ++hh) {
    st.m[hh] = -1e30f; st.l[hh] = 0.f; st.accL[hh] = (f32x4){0.f, 0.f, 0.f, 0.f};
#pragma unroll
    for (int dm = 0; dm < 4; ++dm) st.acc[hh][dm] = (f32x4){0.f, 0.f, 0.f, 0.f};
  }
}

__device__ __forceinline__ void nsa_finish(NsaState& st, f32x4 (&out)[2][4], const float (&gate)[2]) {
#pragma unroll
  for (int hh = 0; hh < 2; ++hh) {
    const float l = st.accL[hh][0];
    const float sc = (l > 0.f) ? gate[hh] / l : 0.f;
#pragma unroll
    for (int dm = 0; dm < 4; ++dm) out[hh][dm] += st.acc[hh][dm] * sc;
  }
}

__device__ __forceinline__ void phase_nsa_cmp(const Params& p, u16* sm) {
  const int tid = threadIdx.x, lane = tid & 63, wave = tid >> 6, fr = lane & 15, fq = lane >> 4;
  const int wq = wave & 3, qh = wave >> 2;
  u16* sKall = sm; u16* sVall = sm + 4 * 64 * LDSP;
  unsigned* PsumU = (unsigned*)(sm + 8 * 64 * LDSP);
  float* Imp = (float*)(PsumU + 32 * 260);
  const int ntiles = 16 * 128;
  for (int tile = blockIdx.x; tile < ntiles; tile += gridDim.x) {
    int qb = 127 - (tile >> 4), bg = tile & 15;
    if (gridDim.x == 256) {
      const int k = 7 - (tile >> 8), r = (int)blockIdx.x >> 4;
      qb = 32 * (k >> 1) + ((k & 1) ? 31 - r : r);
      bg = (int)blockIdx.x & 15;
    }
    const int b = bg >> 1, g = bg & 1;
    const int t0 = qb * 32, myt = t0 + 16 * qh + fr;
    const size_t tokbase = (size_t)b * SEQ;
    const int hA = g * 8 + wq * 2;
    bf16x8 qf[2][2];
#pragma unroll
    for (int hh = 0; hh < 2; ++hh)
#pragma unroll
      for (int ks = 0; ks < 2; ++ks)
        qf[hh][ks] = *(const bf16x8*)(p.qn + (tokbase + myt) * DM + (hA + hh) * 64 + ks * 32 + fq * 8);
    float gate0[2];
#pragma unroll
    for (int hh = 0; hh < 2; ++hh) gate0[hh] = p.gbuf[(tokbase + myt) * 48 + (hA + hh) * 3 + 0];

#pragma unroll
    for (int i = 0; i < 17; ++i) { int idx = tid + 512 * i; if (idx < 32 * 260) PsumU[idx] = 0u; }

    const u16* kcb = p.kc + (size_t)(b * 2 + g) * 256 * 64;
    const u16* vcb = p.vcT + (size_t)(b * 2 + g) * 64 * 256;
    const int ncmp = (t0 >> 4) + 1;
    const int nct = (ncmp + 63) >> 6;
    NsaState st;
    f32x4 s[2][4];
    for (int kt = 0; kt < nct; ++kt) {
      load_tile64(sKall + kt * 64 * LDSP, kcb + (size_t)kt * 64 * 64, 64, true);
      load_tile64(sVall + kt * 64 * LDSP, vcb + kt * 64, 256, false);
    }
    __syncthreads();
    nsa_reset(st);
    for (int kt = 0; kt < nct; ++kt) {
      const u16* sK = sKall + kt * 64 * LDSP;
      nsa_qk(s, sK, qf, fr, fq);
      unsigned vmask = 0;
#pragma unroll
      for (int mt = 0; mt < 4; ++mt)
#pragma unroll
        for (int j = 0; j < 4; ++j) {
          const int c = kt * 64 + 32 * (mt >> 1) + 8 * fq + 4 * (mt & 1) + j;
          vmask |= ((16 * c + 31 <= myt) ? 1u : 0u) << (mt * 4 + j);
        }
#pragma unroll
      for (int hh = 0; hh < 2; ++hh) {
        float tmax = -1e30f;
#pragma unroll
        for (int mt = 0; mt < 4; ++mt)
#pragma unroll
          for (int j = 0; j < 4; ++j) {
            const float sc = ((vmask >> (mt * 4 + j)) & 1u) ? s[hh][mt][j] * 0.125f : -1e30f;
            s[hh][mt][j] = sc; tmax = fmaxf(tmax, sc);
          }
        tmax = fmaxf(tmax, __shfl_xor(tmax, 16));
        tmax = fmaxf(tmax, __shfl_xor(tmax, 32));
        const float mnew = fmaxf(st.m[hh], tmax);
        float psum = 0.f;
#pragma unroll
        for (int mt = 0; mt < 4; ++mt)
#pragma unroll
          for (int j = 0; j < 4; ++j) psum += ((vmask >> (mt * 4 + j)) & 1u) ? __expf(s[hh][mt][j] - mnew) : 0.f;
        st.l[hh] = st.l[hh] * __expf(st.m[hh] - mnew) + psum;
        st.m[hh] = mnew;
      }
    }
    float invl[2];
#pragma unroll
    for (int hh = 0; hh < 2; ++hh) {
      float l = st.l[hh];
      l += __shfl_xor(l, 16);
      l += __shfl_xor(l, 32);
      invl[hh] = (l > 0.f) ? 1.f / l : 0.f;
    }
    for (int kt = 0; kt < nct; ++kt) {
      const u16* sK = sKall + kt * 64 * LDSP;
      const u16* sV = sVall + kt * 64 * LDSP;
      nsa_qk(s, sK, qf, fr, fq);
      bf16x8 pf[2][2];
      float pp[4][4];
#pragma unroll
      for (int mt = 0; mt < 4; ++mt)
#pragma unroll
        for (int j = 0; j < 4; ++j) pp[mt][j] = 0.f;
#pragma unroll
      for (int hh = 0; hh < 2; ++hh) {
#pragma unroll
        for (int k2 = 0; k2 < 2; ++k2) {
          uint32_t pw[4];
#pragma unroll
          for (int e2 = 0; e2 < 4; ++e2) {
            const int mt = 2 * k2 + (e2 >> 1), j = (e2 & 1) * 2;
            const int c0 = kt * 64 + 32 * (mt >> 1) + 8 * fq + 4 * (mt & 1) + j;
            float p0 = (16 * c0 + 31 <= myt) ? __expf(s[hh][mt][j] * 0.125f - st.m[hh]) * invl[hh] : 0.f;
            float p1 = (16 * (c0 + 1) + 31 <= myt) ? __expf(s[hh][mt][j + 1] * 0.125f - st.m[hh]) * invl[hh] : 0.f;
            pp[mt][j] += p0; pp[mt][j + 1] += p1;
            pw[e2] = pack2(p0, p1);
          }
          pf[hh][k2] = mk_frag(pw[0], pw[1], pw[2], pw[3]);
        }
#pragma unroll
        for (int k2 = 0; k2 < 2; ++k2)
#pragma unroll
          for (int dm = 0; dm < 4; ++dm) {
            const bf16x8 vf = *(const bf16x8*)(sV + (dm * 16 + fr) * LDSP + k2 * 32 + fq * 8);
            st.acc[hh][dm] = mfma16(vf, pf[hh][k2], st.acc[hh][dm]);
          }
      }
#pragma unroll
      for (int mt = 0; mt < 4; ++mt)
#pragma unroll
        for (int j = 0; j < 4; ++j) {
          const int c = kt * 64 + 32 * (mt >> 1) + 8 * fq + 4 * (mt & 1) + j;
          atomicAdd(&PsumU[(16 * qh + fr) * 260 + c], (unsigned)(pp[mt][j] * 268435456.f + 0.5f));
        }
    }
#pragma unroll
    for (int hh = 0; hh < 2; ++hh)
#pragma unroll
      for (int dm = 0; dm < 4; ++dm)
        *(uint2*)(p.ocp + (tokbase + myt) * DM + (hA + hh) * 64 + dm * 16 + fq * 4) = pack4(st.acc[hh][dm] * gate0[hh]);
    __syncthreads();
#pragma unroll
    for (int e = 0; e < 4; ++e) {
      const int idx = tid + 512 * e, q = idx >> 6, n = idx & 63;
      const unsigned* Pq = PsumU + q * 260 + 4 * n;
      const float sc28 = 1.f / 268435456.f;
      float v = ((float)Pq[0] + (float)Pq[1] + (float)Pq[2] + 0.5f * ((float)Pq[3] + (n > 0 ? (float)Pq[-1] : 0.f))) * sc28;
      Imp[q * 64 + n] = v;
    }
    __syncthreads();
#pragma unroll
    for (int qi = 0; qi < 4; ++qi) {
      const int q = wave * 4 + qi, tq = t0 + q, cur = tq >> 6, n = lane;
      const bool causal = (n <= cur);
      const bool forced = (n == 0) || (n == cur) || (n == cur - 1);
      const float sc = causal ? (Imp[q * 64 + n] + (forced ? 1e4f : 0.f)) : -1e30f;
      int rank = 0;
      Imp[q * 64 + n] = sc;
      __builtin_amdgcn_wave_barrier();
#pragma unroll 8
      for (int n2 = 0; n2 < 64; ++n2) {
        const float s2 = Imp[q * 64 + n2];
        rank += ((s2 > sc) || (s2 == sc && n2 < n)) ? 1 : 0;
      }
      const unsigned long long mk = __ballot(causal && rank < 16);
      if (lane == 0) p.msk[(size_t)(b * 2 + g) * SEQ + tq] = mk;
    }
    __syncthreads();
  }
}

__device__ __forceinline__ void phase_nsa_sw(const Params& p, u16* sm) {
  const int tid = threadIdx.x, lane = tid & 63, wave = tid >> 6, fr = lane & 15, fq = lane >> 4;
  const int wq = wave & 3, qh = wave >> 2;
  u16* sK = sm; u16* sV = sm + 64 * LDSP;
  int* lst = (int*)(sm + 4 * 64 * LDSP);
  uint2* selL = (uint2*)(sm + 4 * 64 * LDSP + 256) + wave * 512 + lane;
  const int ntiles = 16 * 128;
  for (int tile = blockIdx.x; tile < ntiles; tile += gridDim.x) {
    int qb = 127 - (tile >> 4), bg = tile & 15;
    if (gridDim.x == 256) {
      const int k = 7 - (tile >> 8), r = (int)blockIdx.x >> 4;
      qb = 32 * (k >> 1) + ((k & 1) ? 31 - r : r);
      bg = (int)blockIdx.x & 15;
    }
    const int b = bg >> 1, g = bg & 1;
    const int t0 = qb * 32, myt = t0 + 16 * qh + fr;
    const size_t tokbase = (size_t)b * SEQ;
    const int hA = g * 8 + wq * 2;
    bf16x8 qf[2][2];
#pragma unroll
    for (int hh = 0; hh < 2; ++hh)
#pragma unroll
      for (int ks = 0; ks < 2; ++ks)
        qf[hh][ks] = *(const bf16x8*)(p.qn + (tokbase + myt) * DM + (hA + hh) * 64 + ks * 32 + fq * 8);
    float gates[2][3];
#pragma unroll
    for (int hh = 0; hh < 2; ++hh)
#pragma unroll
      for (int r = 0; r < 3; ++r) gates[hh][r] = p.gbuf[(tokbase + myt) * 48 + (hA + hh) * 3 + r];
    NsaState st;
    f32x4 s[2][4];
    const unsigned long long* mskp = p.msk + (size_t)(b * 2 + g) * SEQ + t0;
    const unsigned long long mymask = mskp[16 * qh + fr];
    unsigned long long um = 0;
#pragma unroll
    for (int q = 0; q < 32; ++q) um |= mskp[q];
    const u16* ksb = p.ksb + tokbase * 128 + g * 64;
    const u16* vsb = p.vsT + (size_t)(b * 2 + g) * 64 * SEQ;
    const u16* kwb = p.kwb + tokbase * 128 + g * 64;
    const u16* vwb = p.vwT + (size_t)(b * 2 + g) * 64 * SEQ;
    const int kt_lo = (t0 >= 511) ? ((t0 - 511) >> 6) : 0, kt_hi = (t0 + 31) >> 6;
    const int nsel = __popcll(um), ntl = nsel + (kt_hi - kt_lo + 1);
    if (tid < 64) {
      if ((um >> tid) & 1ull) lst[__popcll(um & ((1ull << tid) - 1ull))] = tid;
      if (tid <= kt_hi - kt_lo) lst[nsel + tid] = 64 + kt_lo + tid;
    }
    __syncthreads();
    const int pc = tid & 7, pr = tid >> 3, prl = rho_row(pr);
    uint4 rkA, rvA;
#define NSA_FETCH(rk, rv, e) do { const int v_ = lst[(e)]; \
      const u16* kp_ = (v_ < 64) ? ksb + (size_t)v_ * 64 * 128 : kwb + (size_t)(v_ - 64) * 64 * 128; \
      const u16* vp_ = (v_ < 64) ? vsb + v_ * 64 : vwb + (v_ - 64) * 64; \
      rk = *(const uint4*)(kp_ + (size_t)pr * 128 + pc * 8); rv = *(const uint4*)(vp_ + (size_t)pr * SEQ + pc * 8); } while (0)
#define NSA_PUT(rk, rv, buf) do { *(uint4*)(sK + (buf) * 2 * 64 * LDSP + prl * LDSP + pc * 8) = rk; \
      *(uint4*)(sV + (buf) * 2 * 64 * LDSP + pr * LDSP + pc * 8) = rv; } while (0)
    NSA_FETCH(rkA, rvA, 0);
    NSA_PUT(rkA, rvA, 0);
    if (ntl > 1) NSA_FETCH(rkA, rvA, 1);
    nsa_reset(st);
    for (int i = 0; i < ntl; ++i) {
      __syncthreads();
      const int v = lst[i];
      const u16* cK = sK + (i & 1) * 2 * 64 * LDSP;
      const u16* cV = sV + (i & 1) * 2 * 64 * LDSP;
      if (i == nsel) {
        f32x4 tmp[2][4];
#pragma unroll
        for (int hh = 0; hh < 2; ++hh)
#pragma unroll
          for (int dm = 0; dm < 4; ++dm) tmp[hh][dm] = (f32x4){0.f, 0.f, 0.f, 0.f};
        const float gg[2] = {gates[0][1], gates[1][1]};
        nsa_finish(st, tmp, gg);
#pragma unroll
        for (int hh = 0; hh < 2; ++hh)
#pragma unroll
          for (int dm = 0; dm < 4; ++dm) selL[(hh * 4 + dm) * 64] = pack4(tmp[hh][dm]);
        nsa_reset(st);
      }
      nsa_qk(s, cK, qf, fr, fq);
      {
        const bool is_sel = (v < 64);
        const int kt = is_sel ? v : v - 64;
        const bool lv = is_sel ? (bool)((mymask >> v) & 1ull) : true;
        const bool masked = is_sel ? (v == (t0 >> 6)) : !((64 * kt + 63 <= t0) && (64 * kt >= t0 - 480));
        if (masked) {
          const int wnd = is_sel ? (1 << 30) : 512;
          unsigned vmask = 0;
#pragma unroll
          for (int mt = 0; mt < 4; ++mt)
#pragma unroll
            for (int j = 0; j < 4; ++j) {
              const int key = kt * 64 + 32 * (mt >> 1) + 8 * fq + 4 * (mt & 1) + j;
              const int diff = myt - key;
              vmask |= ((lv && diff >= 0 && diff < wnd) ? 1u : 0u) << (mt * 4 + j);
            }
          nsa_online_step<true>(st, s, vmask, true, cV, fr, fq);
        } else {
          nsa_online_step<false>(st, s, 0u, lv, cV, fr, fq);
        }
      }
      if (i + 1 < ntl) NSA_PUT(rkA, rvA, (i + 1) & 1);
      if (i + 2 < ntl) NSA_FETCH(rkA, rvA, i + 2);
    }
#undef NSA_FETCH
#undef NSA_PUT
    f32x4 out[2][4];
#pragma unroll
    for (int hh = 0; hh < 2; ++hh)
#pragma unroll
      for (int dm = 0; dm < 4; ++dm) {
        const uint2 pv = *(const uint2*)(p.ocp + (tokbase + myt) * DM + (hA + hh) * 64 + dm * 16 + fq * 4);
        const uint2 sv = selL[(hh * 4 + dm) * 64];
        out[hh][dm] = (f32x4){bf2f((u16)(pv.x & 0xffff)) + bf2f((u16)(sv.x & 0xffff)), bf2f((u16)(pv.x >> 16)) + bf2f((u16)(sv.x >> 16)),
                              bf2f((u16)(pv.y & 0xffff)) + bf2f((u16)(sv.y & 0xffff)), bf2f((u16)(pv.y >> 16)) + bf2f((u16)(sv.y >> 16))};
      }
    {
      const float gg[2] = {gates[0][2], gates[1][2]};
      nsa_finish(st, out, gg);
    }
#pragma unroll
    for (int hh = 0; hh < 2; ++hh)
#pragma unroll
      for (int dm = 0; dm < 4; ++dm)
        *(uint2*)(p.ob + (tokbase + myt) * DM + (hA + hh) * 64 + dm * 16 + fq * 4) = pack4(out[hh][dm]);
    __syncthreads();
  }
}

__device__ __forceinline__ void phase_final_scale(const Params& p) {
  const unsigned long long* rs3 = p.rowss + 3 * NTOK;
  for (int it = blockIdx.x * NTHR + threadIdx.x; it < NTOK * (DM / 8); it += gridDim.x * NTHR) {
    const int row = it >> 7, c8 = (it & 127) * 8;
    const uint4 pk = *(const uint4*)(p.xb + (size_t)row * DM + c8);
    const float rs = rsqrtf((float)rs3[row] * (1.f / (SS_FIX * DM)) + 1e-6f);
    const float4 g0 = *(const float4*)(p.norm_final + c8), g1 = *(const float4*)(p.norm_final + c8 + 4);
    float4 o0, o1;
    o0.x = __uint_as_float(pk.x << 16) * rs * g0.x; o0.y = __uint_as_float(pk.x & 0xffff0000u) * rs * g0.y;
    o0.z = __uint_as_float(pk.y << 16) * rs * g0.z; o0.w = __uint_as_float(pk.y & 0xffff0000u) * rs * g0.w;
    o1.x = __uint_as_float(pk.z << 16) * rs * g1.x; o1.y = __uint_as_float(pk.z & 0xffff0000u) * rs * g1.y;
    o1.z = __uint_as_float(pk.w << 16) * rs * g1.z; o1.w = __uint_as_float(pk.w & 0xffff0000u) * rs * g1.w;
    __builtin_nontemporal_store((f32x4){o0.x, o0.y, o0.z, o0.w}, (f32x4*)(p.out + (size_t)row * DM + c8));
    __builtin_nontemporal_store((f32x4){o1.x, o1.y, o1.z, o1.w}, (f32x4*)(p.out + (size_t)row * DM + c8 + 4));
  }
}

__device__ __forceinline__ void run_phase(const Params& p, const int ph, u16* sm) {
  switch (ph) {
    case 0: phase_prep(p, sm); break;
    case 1: { EpiSbaQkv e; e.qb = p.qb; e.kb = p.kb; e.vT = p.vT; run_gemm(sm, p.hn, p.wt_sba_in, NTOK, 3072, DM, e); } break;
    case 2: phase_sba_attn(p, sm); break;
    case 3: { EpiResidB<true> e; e.resid32 = p.x; e.xb = p.xb; e.rowss = p.rowss; run_gemm(sm, p.ob, p.wt_sba_out, NTOK, DM, DM, e); } break;
    case 5: { EpiUpConv e; e.act = p.act; e.ub = p.ub; e.rowss = p.rowss; e.cw = p.conv_w; e.cb = p.conv_b; run_gemm(sm, p.xb, p.wt_up0, NTOK, NUP, DM, e); } break;
    case 6: phase_ffn_fix(p, 0); break;
    case 7: { EpiResidB<false> e; e.resid32 = nullptr; e.xb = p.xb; e.rowss = p.rowss + NTOK; run_gemm(sm, p.act, p.wt_down0, NTOK, DM, DFF, e); } break;
    case 12: { EpiNsaIn e; e.qn = p.qn; e.cbuf = p.cbuf; e.ksb = p.ksb; e.kwb = p.kwb; e.vsT = p.vsT; e.vwT = p.vwT; e.gbuf = p.gbuf; e.rope = p.rope; e.rowss = p.rowss + NTOK;
               run_gemm(sm, p.xb, p.wt_nsa_in, NTOK, NSAWP, DM, e); } break;
    case 13: phase_compress(p, sm); break;
    case 14: phase_nsa_cmp(p, sm); break;
    case 15: phase_nsa_sw(p, sm); break;
    case 16: { EpiResidB<false> e; e.resid32 = nullptr; e.xb = p.xb; e.rowss = p.rowss + 2 * NTOK; run_gemm(sm, p.ob, p.wt_nsa_out, NTOK, DM, DM, e); } break;
    case 18: { EpiUpConv e; e.act = p.act; e.ub = p.ub; e.rowss = p.rowss + 2 * NTOK; e.cw = p.conv_w + (size_t)3 * NUP; e.cb = p.conv_b + NUP; run_gemm(sm, p.xb, p.wt_up1, NTOK, NUP, DM, e); } break;
    case 19: phase_ffn_fix(p, 1); break;
    case 20: { EpiResidB<false> e; e.resid32 = nullptr; e.xb = p.xb; e.rowss = p.rowss + 3 * NTOK; run_gemm(sm, p.act, p.wt_down1, NTOK, DM, DFF, e); } break;
    case 24: phase_final_scale(p); break;
    default: break;
  }
}

#ifndef PROBE_REP
#define PROBE_REP 0u
#endif
#define GRID_BAR() grid_barrier((unsigned*)(ka.ws + O_BAR), (volatile LAS unsigned*)&xb_words, bar_k++)
#define PHASE_SEQ(n) if (p.phase_lo <= (n) && (n) <= p.phase_hi) { \
    if ((PROBE_REP >> (n)) & 1u) { run_phase(p, (n), sm); GRID_BAR(); } \
    run_phase(p, (n), sm); if ((n) < p.phase_hi) { if ((n) == 0) { cg::this_grid().sync(); if (threadIdx.x == 0) xb_census((unsigned*)(ka.ws + O_BAR), (volatile LAS unsigned*)&xb_words); __syncthreads(); } else GRID_BAR(); } }
__global__ void __launch_bounds__(512, 2) hybrid_megakernel(KArgs ka) {
  const Params p = make_params(ka);
  __shared__ __attribute__((aligned(16))) u16 sm[SMEM_BYTES / 2];
  unsigned bar_k = 0;
  __shared__ uint4 xb_words;
  if (threadIdx.x == 0 && p.phase_lo < p.phase_hi) xb_post((unsigned*)(ka.ws + O_BAR));
  PHASE_SEQ(0) PHASE_SEQ(1) PHASE_SEQ(2) PHASE_SEQ(3) PHASE_SEQ(5) PHASE_SEQ(6) PHASE_SEQ(7)
  PHASE_SEQ(12) PHASE_SEQ(13) PHASE_SEQ(14) PHASE_SEQ(15)
  PHASE_SEQ(16) PHASE_SEQ(18) PHASE_SEQ(19) PHASE_SEQ(20)
  PHASE_SEQ(24)
}

extern "C" void kernel_launch(void* const* d_in, const int* in_sizes, int n_in, void* d_out, int out_size, void* d_ws,
                              size_t ws_size, hipStream_t stream) {
  KArgs p;
  memset(&p, 0, sizeof(p));
  for (int i = 0; i < 19; ++i) p.in[i] = d_in[i];
  p.out = (float*)d_out;
  p.ws = (char*)d_ws;
  if (ws_size < WS_NEEDED) fprintf(stderr, "workspace too small: %zu < %zu\n", ws_size, (size_t)WS_NEEDED);

  static int grid_blocks = 0;
  if (!grid_blocks) {
    int dev = 0, cus = 0, per_cu = 0;
    hipGetDevice(&dev);
    hipDeviceGetAttribute(&cus, hipDeviceAttributeMultiprocessorCount, dev);
    hipOccupancyMaxActiveBlocksPerMultiprocessor(&per_cu, hybrid_megakernel, NTHR, 0);
    if (per_cu > 1) per_cu = 1;
    if (per_cu < 1) per_cu = 1;
    grid_blocks = cus * per_cu;
  }
#if ONE_LAUNCH
  p.phase_lo = 0; p.phase_hi = NPHASE - 1;
  hipMemsetAsync((char*)d_ws + O_BAR, 0, XCD_BAR_WORDS * 4, stream);
  void* args[] = {&p};
  hipError_t e = hipLaunchCooperativeKernel((void*)hybrid_megakernel, dim3(grid_blocks), dim3(NTHR), args, 0, stream);
  if (e != hipSuccess) fprintf(stderr, "cooperative launch failed: %s (grid %d)\n", hipGetErrorString(e), grid_blocks);
#else
  for (int ph = 0; ph < NPHASE; ++ph) {
    p.phase_lo = ph; p.phase_hi = ph;
    hipLaunchKernelGGL(hybrid_megakernel, dim3(grid_blocks), dim3(NTHR), 0, stream, p);
  }
#endif
}
```
